# Optimizing an MI355X kernel written in HIP

```python
import jax
import jax.numpy as jnp
from jax import lax
import numpy as np

D_MODEL = 1024
BATCH = 8
SEQ = 2048
DEPTH = 4
DEC_BATCH = 128
DEC_SEQ = 8
PAST_LEN = 16384
PAGE_SIZE = 128

N_META = 16
D_POOL = D_MODEL
POOL_WINDOWS = (2, 4, 8, 16)
N_POOL_GROUPS = len(POOL_WINDOWS)
POOL_GROUP_DIM = D_POOL // N_POOL_GROUPS
POOL_BUF = max(POOL_WINDOWS) - 1
D_INNER = 2 * D_MODEL
SSD_HEAD_DIM = 64
SSD_HEADS = D_INNER // SSD_HEAD_DIM
SSD_GROUPS = 4
HEADS_PER_GROUP = SSD_HEADS // SSD_GROUPS
D_STATE = 128
CONV_WIDTH = 4
CONV_DIM = D_INNER + 2 * SSD_GROUPS * D_STATE
CHUNK = 128
D_FF = 2816
FFN_CONV_WIDTH = 3
EPS = 1e-6
OFF_U = 0
OFF_Z = OFF_U + D_POOL
OFF_XBC = OFF_Z + D_INNER
OFF_DT = OFF_XBC + CONV_DIM
OFF_GA = OFF_DT + SSD_HEADS
OFF_GB = OFF_GA + D_MODEL
D_IN_TOTAL = OFF_GB + D_MODEL

kernel_name = 'hybrid_pool_ssd_convffn_step'


def rmsnorm(x, w):
    xf = x.astype(jnp.float32)
    y = xf * lax.rsqrt(jnp.mean(xf * xf, axis=-1, keepdims=True) + EPS)
    return (y * w.astype(jnp.float32)).astype(x.dtype)


def causal_dwconv(u, prefix, w, b):
    width = w.shape[0]
    L = u.shape[1]
    ext = jnp.concatenate([prefix.astype(u.dtype), u], axis=1)
    out = b
    for k in range(width):
        out = out + ext[:, k:k + L] * w[k]
    return out, ext[:, -(width - 1):]


def pool_mix(u, prefix, start_pos, pool_w, pool_scale):
    b, L, _ = u.shape
    ext = jnp.concatenate([prefix.astype(u.dtype), u], axis=1)
    cs = jnp.concatenate([jnp.zeros((b, 1, D_POOL), jnp.float32),
                          jnp.cumsum(ext.astype(jnp.float32), axis=1)], axis=1)
    pos = start_pos + jnp.arange(L, dtype=jnp.int32)
    uf = u.astype(jnp.float32)
    outs = []
    for g, win in enumerate(POOL_WINDOWS):
        c0, c1 = g * POOL_GROUP_DIM, (g + 1) * POOL_GROUP_DIM
        hi = cs[:, POOL_BUF + 1:POOL_BUF + 1 + L, c0:c1]
        lo = cs[:, POOL_BUF + 1 - win:POOL_BUF + 1 - win + L, c0:c1]
        count = jnp.minimum(pos + 1, win).astype(jnp.float32)[None, :, None]
        outs.append((hi - lo) / count - uf[:, :, c0:c1])
    d = jnp.stack(outs, axis=2).astype(u.dtype)
    mixed = jnp.einsum('blgc,gcd->blgd', d, pool_w).reshape(b, L, D_POOL) * pool_scale
    return mixed, ext[:, -POOL_BUF:]


def ssd_scan(xh, dt, a, bm, cm, h0):
    b, L = xh.shape[0], xh.shape[1]
    q = CHUNK if L % CHUNK == 0 else L
    nc = L // q

    def chunks(t):
        return jnp.moveaxis(t.reshape((b, nc, q) + t.shape[2:]), 1, 0)

    x_c = chunks(xh.astype(jnp.float32).reshape(b, L, SSD_GROUPS, HEADS_PER_GROUP, SSD_HEAD_DIM))
    dt_c = chunks(dt.reshape(b, L, SSD_GROUPS, HEADS_PER_GROUP))
    b_c = chunks(bm.astype(jnp.float32))
    c_c = chunks(cm.astype(jnp.float32))
    a_g = a.reshape(SSD_GROUPS, HEADS_PER_GROUP)
    causal = jnp.tril(jnp.ones((q, q), dtype=bool))[None, :, :, None, None]

    def step(h, inp):
        x, d, bc, cc = inp
        cum = jnp.cumsum(d * a_g, axis=1)
        seg = cum[:, :, None] - cum[:, None]
        decay = jnp.where(causal, jnp.exp(jnp.where(causal, seg, 0.0)), 0.0)
        xdt = x * d[..., None]
        scores = jnp.einsum('btgn,bsgn->btsg', cc, bc)
        m = scores[..., None] * decay
        y = jnp.einsum('btsgh,bsghp->btghp', m, xdt)
        y = y + jnp.einsum('btgn,bghpn->btghp', cc, h) * jnp.exp(cum)[..., None]
        last = cum[:, -1]
        xw = xdt * jnp.exp(last[:, None] - cum)[..., None]
        h = h * jnp.exp(last)[..., None, None] + jnp.einsum('bsgn,bsghp->bghpn', bc, xw)
        return h, y

    h_init = h0.astype(jnp.float32).reshape(b, SSD_GROUPS, HEADS_PER_GROUP, SSD_HEAD_DIM, D_STATE)
    h, y = lax.scan(step, h_init, (x_c, dt_c, b_c, c_c))
    y = jnp.moveaxis(y, 0, 1).reshape(b, L, SSD_HEADS, SSD_HEAD_DIM)
    return y, h.reshape(b, SSD_HEADS, SSD_HEAD_DIM, D_STATE)


def ssd(xh, dt, a, bm, cm, h0, n_lead):
    if n_lead > 0:
        y0, h = ssd_scan(xh[:, :n_lead], dt[:, :n_lead], a, bm[:, :n_lead], cm[:, :n_lead], h0)
        y1, h = ssd_scan(xh[:, n_lead:], dt[:, n_lead:], a, bm[:, n_lead:], cm[:, n_lead:], h)
        return jnp.concatenate([y0, y1], axis=1), h
    return ssd_scan(xh, dt, a, bm, cm, h0)


def gated_rmsnorm(y, z, w):
    yf = y.astype(jnp.float32) * jax.nn.silu(z.astype(jnp.float32))
    yg = yf.reshape(yf.shape[:-1] + (SSD_GROUPS, D_INNER // SSD_GROUPS))
    yg = yg * lax.rsqrt(jnp.mean(yg * yg, axis=-1, keepdims=True) + EPS)
    return (yg.reshape(yf.shape) * w.astype(jnp.float32)).astype(z.dtype)


def hybrid_layer(x, n_lead, start_pos, pool_buf, conv_buf, ssm_h0, ffn_buf,
                 norm1_w, w_in, pool_w, pool_scale, w_pool_out, conv_w, conv_b,
                 dt_bias, a_log, d_skip, ssd_norm_w, w_ssd_out, w_o,
                 norm2_w, w_up, ffn_conv_w, ffn_conv_b, w_down):
    b, L, _ = x.shape
    hn = rmsnorm(x, norm1_w)
    proj = hn @ w_in
    u = proj[..., OFF_U:OFF_Z]
    z = proj[..., OFF_Z:OFF_XBC]
    xbc = proj[..., OFF_XBC:OFF_DT]
    dt_raw = proj[..., OFF_DT:OFF_GA]
    g_a = proj[..., OFF_GA:OFF_GB]
    g_b = proj[..., OFF_GB:D_IN_TOTAL]
    pooled, pool_new = pool_mix(u, pool_buf, start_pos, pool_w, pool_scale)
    a_out = pooled @ w_pool_out
    xbc_c, conv_new = causal_dwconv(xbc, conv_buf, conv_w, conv_b)
    xbc_c = jax.nn.silu(xbc_c)
    xs = xbc_c[..., :D_INNER]
    bm = xbc_c[..., D_INNER:D_INNER + SSD_GROUPS * D_STATE].reshape(b, L, SSD_GROUPS, D_STATE)
    cm = xbc_c[..., D_INNER + SSD_GROUPS * D_STATE:].reshape(b, L, SSD_GROUPS, D_STATE)
    dt = jax.nn.softplus(dt_raw.astype(jnp.float32) + dt_bias.astype(jnp.float32))
    a = -jnp.exp(a_log.astype(jnp.float32))
    xh = xs.reshape(b, L, SSD_HEADS, SSD_HEAD_DIM)
    y, h_new = ssd(xh, dt, a, bm, cm, ssm_h0, n_lead)
    y = y + d_skip.astype(jnp.float32)[:, None] * xh.astype(jnp.float32)
    y = gated_rmsnorm(y.reshape(b, L, D_INNER), z, ssd_norm_w).astype(x.dtype)
    b_out = y @ w_ssd_out
    merged = jax.nn.sigmoid(g_a) * a_out + jax.nn.sigmoid(g_b) * b_out
    x = x + merged @ w_o
    hn2 = rmsnorm(x, norm2_w)
    up, ffn_new = causal_dwconv(hn2 @ w_up, ffn_buf, ffn_conv_w, ffn_conv_b)
    x = x + (jax.nn.silu(up[..., :D_FF]) * up[..., D_FF:]) @ w_down
    return x, pool_new, conv_new, h_new, ffn_new


def setup_inputs(seed: int = 0) -> dict:
    key = jax.random.key(seed)
    ks = jax.random.split(key, 32)
    f32 = jnp.float32

    def nrm(k, shape, scale):
        return jax.random.normal(k, shape, f32) * scale

    dt_init = jnp.exp(jax.random.uniform(ks[12], (DEPTH, SSD_HEADS), f32, np.log(1e-3), np.log(1e-1)))
    dt_bias = dt_init + jnp.log(-jnp.expm1(-dt_init))
    return {
        'x_prompt': nrm(ks[0], (BATCH, SEQ, D_MODEL), 1.0),
        'x_sample': nrm(ks[1], (DEC_BATCH, DEC_SEQ, D_MODEL), 1.0),
        'state_pool': nrm(ks[2], (DEPTH, DEC_BATCH, POOL_BUF, D_POOL), 1.0),
        'state_conv': nrm(ks[3], (DEPTH, DEC_BATCH, CONV_WIDTH - 1, CONV_DIM), 1.0),
        'state_ssm': nrm(ks[4], (DEPTH, DEC_BATCH, SSD_HEADS, SSD_HEAD_DIM, D_STATE), 0.1),
        'state_ffn': nrm(ks[5], (DEPTH, DEC_BATCH, FFN_CONV_WIDTH - 1, 2 * D_FF), 1.0),
        'meta_tokens': nrm(ks[6], (N_META, D_MODEL), 1.0),
        'norm1_w': 1.0 + nrm(ks[7], (DEPTH, D_MODEL), 0.01),
        'w_in': nrm(ks[8], (DEPTH, D_MODEL, D_IN_TOTAL), D_MODEL ** -0.5),
        'pool_w': nrm(ks[9], (DEPTH, N_POOL_GROUPS, POOL_GROUP_DIM, POOL_GROUP_DIM), POOL_GROUP_DIM ** -0.5),
        'pool_scale': 1.0 + nrm(ks[10], (DEPTH, D_POOL), 0.01),
        'w_pool_out': nrm(ks[11], (DEPTH, D_POOL, D_MODEL), D_POOL ** -0.5),
        'conv_w': nrm(ks[13], (DEPTH, CONV_WIDTH, CONV_DIM), CONV_WIDTH ** -0.5),
        'conv_b': nrm(ks[14], (DEPTH, CONV_DIM), 0.01),
        'dt_bias': dt_bias,
        'a_log': jnp.log(jax.random.uniform(ks[15], (DEPTH, SSD_HEADS), f32, 1.0, 16.0)),
        'd_skip': 1.0 + nrm(ks[16], (DEPTH, SSD_HEADS), 0.1),
        'ssd_norm_w': 1.0 + nrm(ks[17], (DEPTH, D_INNER), 0.01),
        'w_ssd_out': nrm(ks[18], (DEPTH, D_INNER, D_MODEL), D_INNER ** -0.5),
        'w_o': nrm(ks[19], (DEPTH, D_MODEL, D_MODEL), D_MODEL ** -0.5),
        'norm2_w': 1.0 + nrm(ks[20], (DEPTH, D_MODEL), 0.01),
        'w_up': nrm(ks[21], (DEPTH, D_MODEL, 2 * D_FF), D_MODEL ** -0.5),
        'ffn_conv_w': nrm(ks[22], (DEPTH, FFN_CONV_WIDTH, 2 * D_FF), FFN_CONV_WIDTH ** -0.5),
        'ffn_conv_b': nrm(ks[23], (DEPTH, 2 * D_FF), 0.01),
        'w_down': nrm(ks[24], (DEPTH, D_FF, D_MODEL), D_FF ** -0.5),
        'final_norm_w': 1.0 + nrm(ks[25], (D_MODEL,), 0.01),
    }


def reference(x_prompt, x_sample, state_pool, state_conv, state_ssm, state_ffn,
              meta_tokens, norm1_w, w_in, pool_w, pool_scale, w_pool_out, conv_w, conv_b,
              dt_bias, a_log, d_skip, ssd_norm_w, w_ssd_out, w_o, norm2_w, w_up,
              ffn_conv_w, ffn_conv_b, w_down, final_norm_w):
    b_p = x_prompt.shape[0]
    dt_ = x_prompt.dtype
    meta = jnp.broadcast_to(meta_tokens.astype(dt_)[None], (b_p, N_META, D_MODEL))
    xp = jnp.concatenate([meta, x_prompt], axis=1)
    xs = x_sample
    pp, pc, ph, pf = [], [], [], []
    sp, sc, sh, sf = [], [], [], []
    for l in range(DEPTH):
        params = (norm1_w[l], w_in[l], pool_w[l], pool_scale[l], w_pool_out[l], conv_w[l], conv_b[l],
                  dt_bias[l], a_log[l], d_skip[l], ssd_norm_w[l], w_ssd_out[l], w_o[l],
                  norm2_w[l], w_up[l], ffn_conv_w[l], ffn_conv_b[l], w_down[l])
        xp, p_pool, p_conv, p_h, p_ffn = hybrid_layer(
            xp, N_META, 0,
            jnp.zeros((b_p, POOL_BUF, D_POOL), dt_),
            jnp.zeros((b_p, CONV_WIDTH - 1, CONV_DIM), dt_),
            jnp.zeros((b_p, SSD_HEADS, SSD_HEAD_DIM, D_STATE), jnp.float32),
            jnp.zeros((b_p, FFN_CONV_WIDTH - 1, 2 * D_FF), dt_),
            *params)
        xs, s_pool, s_conv, s_h, s_ffn = hybrid_layer(
            xs, 0, PAST_LEN, state_pool[l], state_conv[l], state_ssm[l], state_ffn[l], *params)
        pp.append(p_pool); pc.append(p_conv); ph.append(p_h); pf.append(p_ffn)
        sp.append(s_pool); sc.append(s_conv); sh.append(s_h); sf.append(s_ffn)
    y_prompt = rmsnorm(xp, final_norm_w)[:, N_META:]
    y_sample = rmsnorm(xs, final_norm_w)
    return (y_prompt, y_sample,
            jnp.stack(pp), jnp.stack(pc), jnp.stack(ph), jnp.stack(pf),
            jnp.stack(sp), jnp.stack(sc), jnp.stack(sh), jnp.stack(sf))
```

```cpp
#include <hip/hip_runtime.h>
#include <hip/hip_cooperative_groups.h>
#include <cstdio>
#include <cstdint>
namespace cg = cooperative_groups;

#define LAS __attribute__((address_space(3)))
typedef unsigned short bf16_t;
typedef short bf16x8 __attribute__((ext_vector_type(8)));
typedef float f32x4 __attribute__((ext_vector_type(4)));
typedef unsigned u32x4 __attribute__((ext_vector_type(4)));
typedef unsigned u32x2 __attribute__((ext_vector_type(2)));

constexpr int DM = 1024, NBATCH = 8, SEQ = 2048, NMETA = 16, LP = SEQ + NMETA, DEPTH = 4, DB = 128, DS = 8;
constexpr int MPROMPT = NBATCH * LP;
constexpr int MREAL = MPROMPT + DB * DS;
constexpr int MP = 17664;
constexpr int NH = 32, HD = 64, NG = 4, NST = 128, CONVD = 3072, DFF = 2816, DUP = 5632, DINNER = 2048;
constexpr int NPROJ = 8448;
constexpr int PC_U = 0, PC_Z = 1024, PC_XBC = 3072, PC_GA = 6144, PC_GB = 7168, PC_DT = 8192;
constexpr float EPS = 1e-6f;
constexpr int NTHREADS = 512, NWAVES = 8;
constexpr int LDS_BYTES = 147456;
constexpr int LDS_ST_OFF = LDS_BYTES - 16;

constexpr size_t al256(size_t x) { return (x + 255) & ~(size_t)255; }
constexpr size_t WS_W1T = 0;
constexpr size_t WS_PWT = WS_W1T + al256((size_t)DEPTH * NPROJ * 1024 * 2);
constexpr size_t WS_WPOT = WS_PWT + al256((size_t)DEPTH * 1024 * 256 * 2);
constexpr size_t WS_WSOT = WS_WPOT + al256((size_t)DEPTH * 1024 * 1024 * 2);
constexpr size_t WS_WOT = WS_WSOT + al256((size_t)DEPTH * 1024 * 2048 * 2);
constexpr size_t WS_WUPT = WS_WOT + al256((size_t)DEPTH * 1024 * 1024 * 2);
constexpr size_t WS_WDT = WS_WUPT + al256((size_t)DEPTH * DUP * 1024 * 2);
constexpr size_t WS_X = WS_WDT + al256((size_t)DEPTH * 1024 * DFF * 2);
constexpr size_t WS_XB = WS_X + al256((size_t)MP * 1024 * 4);
constexpr size_t WS_RSS = WS_XB + al256((size_t)MP * 1024 * 2);
constexpr size_t WS_PROJ = WS_RSS + al256((size_t)MP * 16 * 4);
constexpr size_t WS_DT = WS_PROJ + al256((size_t)MP * NPROJ * 2);
constexpr size_t WS_DBUF = WS_DT + al256((size_t)MP * 32 * 4);
constexpr size_t WS_POOLED = WS_DBUF + al256((size_t)MP * 1024 * 2);
constexpr size_t WS_YN = WS_POOLED + al256((size_t)MP * 1024 * 2);
constexpr size_t WS_SSQ = WS_YN + al256((size_t)MP * 2048 * 2);
constexpr size_t WS_MERGED = WS_SSQ + al256((size_t)MP * 32 * 4);
constexpr size_t WS_UP = WS_MERGED + al256((size_t)MP * 1024 * 2);
constexpr size_t WS_ACT = WS_UP + al256((size_t)MP * DUP * 2);
constexpr size_t WS_XBCC = WS_ACT + al256((size_t)MP * DFF * 2);
constexpr size_t WS_DTS = WS_XBCC + al256((size_t)MP * CONVD * 2);
constexpr size_t WS_CTL = WS_DTS + al256((size_t)MP * 32 * 4);
constexpr size_t WS_CTL_BYTES = 16384;
constexpr size_t WS_END = WS_CTL + WS_CTL_BYTES;

constexpr size_t O_YP = 0;
constexpr size_t O_YS = O_YP + (size_t)NBATCH * SEQ * DM;
constexpr size_t O_PPOOL = O_YS + (size_t)DB * DS * DM;
constexpr size_t O_PCONV = O_PPOOL + (size_t)DEPTH * NBATCH * 15 * 1024;
constexpr size_t O_PSSM = O_PCONV + (size_t)DEPTH * NBATCH * 3 * CONVD;
constexpr size_t O_PFFN = O_PSSM + (size_t)DEPTH * NBATCH * NH * HD * NST;
constexpr size_t O_SPOOL = O_PFFN + (size_t)DEPTH * NBATCH * 2 * DUP;
constexpr size_t O_SCONV = O_SPOOL + (size_t)DEPTH * DB * 15 * 1024;
constexpr size_t O_SSSM = O_SCONV + (size_t)DEPTH * DB * 3 * CONVD;
constexpr size_t O_SFFN = O_SSSM + (size_t)DEPTH * DB * NH * HD * NST;
constexpr size_t O_END = O_SFFN + (size_t)DEPTH * DB * 2 * DUP;

__device__ __forceinline__ unsigned cvt_pk_bf16(float lo, float hi) { unsigned r; asm("v_cvt_pk_bf16_f32 %0, %1, %2" : "=v"(r) : "v"(lo), "v"(hi)); return r; }
__device__ __forceinline__ unsigned f2bf(float f) { return cvt_pk_bf16(f, f) & 0xffffu; }
__device__ __forceinline__ unsigned pk2(float lo, float hi) { return cvt_pk_bf16(lo, hi); }
__device__ __forceinline__ float bflo(unsigned w) { return __builtin_bit_cast(float, w << 16); }
__device__ __forceinline__ float bfhi(unsigned w) { return __builtin_bit_cast(float, w & 0xffff0000u); }
__device__ __forceinline__ float bf1(bf16_t h) { return __builtin_bit_cast(float, ((unsigned)h) << 16); }
__device__ __forceinline__ float sigmoidf_(float x) { return __builtin_amdgcn_rcpf(1.0f + __expf(-x)); }
__device__ __forceinline__ float siluf_(float x) { return x * sigmoidf_(x); }
__device__ __forceinline__ void unpack8(const u32x4 w, float (&o)[8]) {
    o[0] = bflo(w.x); o[1] = bfhi(w.x); o[2] = bflo(w.y); o[3] = bfhi(w.y); o[4] = bflo(w.z); o[5] = bfhi(w.z); o[6] = bflo(w.w); o[7] = bfhi(w.w);
}
__device__ __forceinline__ u32x4 pack8(const float (&o)[8]) {
    u32x4 w; w.x = pk2(o[0], o[1]); w.y = pk2(o[2], o[3]); w.z = pk2(o[4], o[5]); w.w = pk2(o[6], o[7]); return w;
}
__device__ __forceinline__ float shx(float v, int m, int lane) { return __builtin_bit_cast(float, __builtin_amdgcn_ds_bpermute((lane ^ m) << 2, __builtin_bit_cast(int, v))); }
__device__ __forceinline__ float shup(float v, int d, int lane) { return __builtin_bit_cast(float, __builtin_amdgcn_ds_bpermute((lane - d) << 2, __builtin_bit_cast(int, v))); }
__device__ __forceinline__ float shidx(float v, int src) { return __builtin_bit_cast(float, __builtin_amdgcn_ds_bpermute(src << 2, __builtin_bit_cast(int, v))); }
__device__ __forceinline__ float wave_sum(float v) {
#pragma unroll
    for (int o = 1; o < 64; o <<= 1) v += __shfl_xor(v, o);
    return v;
}
__device__ __forceinline__ u32x4 pack8v(const f32x4 a, const f32x4 b) { u32x4 w; w.x = pk2(a.x, a.y); w.y = pk2(a.z, a.w); w.z = pk2(b.x, b.y); w.w = pk2(b.z, b.w); return w; }
#define LDS_WAIT() asm volatile("s_waitcnt lgkmcnt(0)" ::: "memory")
#define LBAR() do { asm volatile("s_waitcnt lgkmcnt(0)" ::: "memory"); __builtin_amdgcn_s_barrier(); asm volatile("" ::: "memory"); } while (0)

namespace pg8 {
constexpr int BM = 256, BK = 64, HALF = 128, HTB = HALF * BK * 2, STAGE_BYTES = 8 * HTB, NXCD = 8, WGM = 8;
__host__ __device__ __forceinline__ int lds_byte(int r, int c) { const int st = (r >> 4) * 2 + (c >> 5), rr = r & 15, cc = c & 31, ob = rr * 64 + cc * 2; return st * 1024 + (ob ^ (((ob >> 9) & 1) << 5)); }
__host__ __device__ __forceinline__ void stage_rc(int b, int& R, int& C) { const int st = b / 1024, sb = b % 1024, swz = sb ^ (((sb >> 9) & 1) << 5); R = (st >> 1) * 16 + swz / 64; C = (st & 1) * 32 + (swz % 64) / 2; }
__host__ __device__ __forceinline__ int perm32(int rho) { const int n = rho >> 4, i = rho & 15; return 8 * (i >> 2) + 4 * n + (i & 3); }

struct Unit { int pm, pn; };
struct Gemm { const bf16_t* A; const bf16_t* Bt; int lda, ldb, K, a_pn_off; };

struct StaticOrder {
    int nM, nN, nwg, G, c;
    __device__ void init(int M, int N, int G_, int c_) { nM = M / BM; nN = N / BM; nwg = nM * nN; G = G_; c = c_; }
    __device__ bool next(int i, Unit& u) const {
        const long L = (long)i * G + c; if (L >= nwg) return false;
        int wgid = (int)L; { const int q = nwg / NXCD, r = nwg % NXCD, xcd = wgid % NXCD, off = wgid / NXCD; wgid = (xcd < r ? xcd * (q + 1) : r * (q + 1) + (xcd - r) * q) + off; }
        const int nig = WGM * nN, gid = wgid / nig, fm = gid * WGM, gsz = (nM - fm) < WGM ? (nM - fm) : WGM;
        u.pm = fm + ((wgid % nig) % gsz); u.pn = (wgid % nig) / gsz; return true;
    }
};


struct EpiScale {
    bf16_t* O; int ldc; const float* rss; float* dtf; int dt_pn;
    __device__ __forceinline__ void operator()(const f32x4 (&acc)[2][2][4][2], const Unit& u, int wr, int wc, int fr, int fq) const {
        const int row0 = u.pm * BM + wr * 64 + fr, col0 = u.pn * BM + wc * 32 + 8 * fq;
#pragma unroll
        for (int ai = 0; ai < 2; ++ai) {
            float sc[4] = {1.f, 1.f, 1.f, 1.f};
            if (rss) {
                f32x4 pr[4][4];
#pragma unroll
                for (int m = 0; m < 4; ++m) { const f32x4* p = (const f32x4*)(rss + (size_t)(row0 + ai * HALF + m * 16) * 16);
#pragma unroll
                    for (int i = 0; i < 4; ++i) pr[m][i] = p[i]; }
#pragma unroll
                for (int m = 0; m < 4; ++m) { const f32x4 a = pr[m][0], b = pr[m][1], c = pr[m][2], d = pr[m][3];
                    const float sm = ((a.x + a.y) + (a.z + a.w)) + ((b.x + b.y) + (b.z + b.w)) + ((c.x + c.y) + (c.z + c.w)) + ((d.x + d.y) + (d.z + d.w));
                    sc[m] = rsqrtf(sm * (1.0f / 1024.0f) + EPS); }
            }
#pragma unroll
            for (int m = 0; m < 4; ++m) {
                const int row = row0 + ai * HALF + m * 16;
                bf16_t* rowp = O + (size_t)row * ldc + col0;
#pragma unroll
                for (int bj = 0; bj < 2; ++bj) { const f32x4 v0 = acc[ai][bj][m][0] * sc[m], v1 = acc[ai][bj][m][1] * sc[m];
                    u32x4 w; w.x = cvt_pk_bf16(v0[0], v0[1]); w.y = cvt_pk_bf16(v0[2], v0[3]); w.z = cvt_pk_bf16(v1[0], v1[1]); w.w = cvt_pk_bf16(v1[2], v1[3]);
                    *(u32x4*)(rowp + bj * HALF) = w;
                    if (bj == 0 && dtf != nullptr && u.pn == dt_pn && wc == 0) { float* dp = dtf + (size_t)row * 32 + 8 * fq; *(f32x4*)dp = v0; *(f32x4*)(dp + 4) = v1; } }
            }
        }
    }
};
template <int MODE> struct EpiGate {
    bf16_t* O; int ldc; const bf16_t* gate; int ldg;
    struct Pre { u32x2 gw, ow; };
    __device__ __forceinline__ Pre tail4_pre(int row, int col) const { Pre p; p.gw = *(const u32x2*)(gate + (size_t)row * ldg + col); p.ow = (u32x2){0u, 0u};
        if (MODE == 1) p.ow = *(const u32x2*)(O + (size_t)row * ldc + col); return p; }
    __device__ __forceinline__ void tail4(const f32x4 v, const Pre& pre, int row, int col, int l16) const {
        const u32x2 gw = pre.gw;
        float v0 = sigmoidf_(bflo(gw.x)) * v[0], v1 = sigmoidf_(bfhi(gw.x)) * v[1], v2 = sigmoidf_(bflo(gw.y)) * v[2], v3 = sigmoidf_(bfhi(gw.y)) * v[3];
        bf16_t* op = O + (size_t)row * ldc + col;
        if (MODE == 1) { const u32x2 ow = pre.ow; v0 += bflo(ow.x); v1 += bfhi(ow.x); v2 += bflo(ow.y); v3 += bfhi(ow.y); }
        u32x2 w; w.x = cvt_pk_bf16(v0, v1); w.y = cvt_pk_bf16(v2, v3);
        *(u32x2*)op = w;
    }
    __device__ __forceinline__ void operator()(const f32x4 (&acc)[2][2][4][2], const Unit& u, int wr, int wc, int fr, int fq) const {
        const int row0 = u.pm * BM + wr * 64 + fr, col0 = u.pn * BM + wc * 32 + 8 * fq;
#pragma unroll
        for (int ai = 0; ai < 2; ++ai) {
            u32x4 gwv[4][2], owv[4][2];
#pragma unroll
            for (int m = 0; m < 4; ++m)
#pragma unroll
                for (int bj = 0; bj < 2; ++bj) { const size_t row = (size_t)(row0 + ai * HALF + m * 16);
                    gwv[m][bj] = *(const u32x4*)(gate + row * ldg + col0 + bj * HALF);
                    if (MODE == 1) owv[m][bj] = *(const u32x4*)(O + row * ldc + col0 + bj * HALF); }
#pragma unroll
            for (int m = 0; m < 4; ++m) {
                bf16_t* rowp = O + (size_t)(row0 + ai * HALF + m * 16) * ldc + col0;
#pragma unroll
                for (int bj = 0; bj < 2; ++bj) {
                    float g[8]; unpack8(gwv[m][bj], g);
                    const f32x4 a0 = acc[ai][bj][m][0], a1 = acc[ai][bj][m][1];
                    float v[8];
                    v[0] = sigmoidf_(g[0]) * a0[0]; v[1] = sigmoidf_(g[1]) * a0[1]; v[2] = sigmoidf_(g[2]) * a0[2]; v[3] = sigmoidf_(g[3]) * a0[3];
                    v[4] = sigmoidf_(g[4]) * a1[0]; v[5] = sigmoidf_(g[5]) * a1[1]; v[6] = sigmoidf_(g[6]) * a1[2]; v[7] = sigmoidf_(g[7]) * a1[3];
                    if (MODE == 1) { float o[8]; unpack8(owv[m][bj], o);
#pragma unroll
                        for (int e = 0; e < 8; ++e) v[e] += o[e]; }
                    u32x4 w; w.x = cvt_pk_bf16(v[0], v[1]); w.y = cvt_pk_bf16(v[2], v[3]); w.z = cvt_pk_bf16(v[4], v[5]); w.w = cvt_pk_bf16(v[6], v[7]);
                    *(u32x4*)(rowp + bj * HALF) = w; }
            }
        }
    }
};
struct EpiResid {
    float* X; bf16_t* XB; float* rss;
    struct Pre { f32x4 x; };
    __device__ __forceinline__ Pre tail4_pre(int row, int col) const { Pre p; p.x = *(const f32x4*)(X + (size_t)row * DM + col); return p; }
    __device__ __forceinline__ void tail4(const f32x4 v, const Pre& pre, int row, int col, int l16) const {
        float* xp = X + (size_t)row * DM + col;
        f32x4 x0 = pre.x; x0 += v; *(f32x4*)xp = x0;
        float ss = (x0[0] * x0[0] + x0[1] * x0[1]) + (x0[2] * x0[2] + x0[3] * x0[3]);
        u32x2 w; w.x = cvt_pk_bf16(x0[0], x0[1]); w.y = cvt_pk_bf16(x0[2], x0[3]);
        *(u32x2*)(XB + (size_t)row * DM + col) = w;
        ss += shx(ss, 1, l16); ss += shx(ss, 2, l16); ss += shx(ss, 4, l16); ss += shx(ss, 8, l16);
        if ((l16 & 15) == 0) rss[(size_t)row * 16 + (col >> 6)] = ss;
    }
    __device__ __forceinline__ void operator()(const f32x4 (&acc)[2][2][4][2], const Unit& u, int wr, int wc, int fr, int fq) const {
        const int row0 = u.pm * BM + wr * 64 + fr, col0 = u.pn * BM + wc * 32 + 8 * fq;
#pragma unroll
        for (int ai = 0; ai < 2; ++ai)
#pragma unroll
            for (int mp = 0; mp < 2; ++mp) {
                f32x4 xv[2][2][2];
#pragma unroll
                for (int mm = 0; mm < 2; ++mm)
#pragma unroll
                    for (int bj = 0; bj < 2; ++bj) { const float* xp = X + (size_t)(row0 + ai * HALF + (2 * mp + mm) * 16) * DM + col0 + bj * HALF;
                        xv[mm][bj][0] = *(const f32x4*)xp; xv[mm][bj][1] = *(const f32x4*)(xp + 4); }
#pragma unroll
                for (int mm = 0; mm < 2; ++mm) {
                    const int m = 2 * mp + mm, row = row0 + ai * HALF + m * 16;
                    float* xp = X + (size_t)row * DM + col0; bf16_t* bp = XB + (size_t)row * DM + col0;
                    float ss = 0.f;
#pragma unroll
                    for (int bj = 0; bj < 2; ++bj) {
                        f32x4 x0 = xv[mm][bj][0], x1 = xv[mm][bj][1];
                        x0 += acc[ai][bj][m][0]; x1 += acc[ai][bj][m][1];
                        *(f32x4*)(xp + bj * HALF) = x0; *(f32x4*)(xp + bj * HALF + 4) = x1;
                        ss += (x0[0] * x0[0] + x0[1] * x0[1]) + (x0[2] * x0[2] + x0[3] * x0[3]) + (x1[0] * x1[0] + x1[1] * x1[1]) + (x1[2] * x1[2] + x1[3] * x1[3]);
                        u32x4 w; w.x = cvt_pk_bf16(x0[0], x0[1]); w.y = cvt_pk_bf16(x0[2], x0[3]); w.z = cvt_pk_bf16(x1[0], x1[1]); w.w = cvt_pk_bf16(x1[2], x1[3]);
                        *(u32x4*)(bp + bj * HALF) = w; }
                    ss += shx(ss, 16, fq * 16 + fr); ss += shx(ss, 32, fq * 16 + fr);
                    if (fq == 0) rss[(size_t)row * 16 + u.pn * 4 + wc] = ss;
                }
            }
    }
};

template <class Epi>
__device__ __forceinline__ void gemm_phase(LAS unsigned char* lds_in, int wave_in, const Gemm g, const StaticOrder& S, const Epi& E) {
    int lane = (int)__builtin_amdgcn_mbcnt_hi(~0u, __builtin_amdgcn_mbcnt_lo(~0u, 0u)); asm volatile("" : "+v"(lane));
    int wid = wave_in; asm volatile("" : "+s"(wid));
    const int tid = wid * 64 + lane;
    LAS unsigned char* lds = lds_in; asm volatile("" : "+s"(lds));
    const int wr = wid >> 2, wc = wid & 3, fr = lane & 15, fq = lane >> 4;
    const int K = g.K, nt = K / BK;
    unsigned voffA[2], voffB[2];
#pragma unroll
    for (int i = 0; i < 2; ++i) { int R, C; stage_rc(tid * 16 + i * 8192, R, C); const int Rb = (R & ~31) + perm32(R & 31);
        voffA[i] = (unsigned)(R * g.lda + C) * 2u; voffB[i] = (unsigned)(Rb * g.ldb + C) * 2u; }
    const size_t kstep = (size_t)(BK * 2);
    const size_t hstepA = (size_t)HALF * g.lda * 2, hstepB = (size_t)HALF * g.ldb * 2;
    const size_t tstepA = 2 * hstepA, tstepB = 2 * hstepB;
    const unsigned ldsw = (unsigned)wid * 1024u;
    const int aoff = lds_byte(wr * 64 + fr, fq * 8), boff = lds_byte(wc * 32 + fr, fq * 8);
#define PG8_SA(b, h) (((b) * 2 + (h)) * HTB)
#define PG8_SB(b, h) ((4 + (b) * 2 + (h)) * HTB)
#define PG8_STAGE(bufoff, gbase, voff) do { _Pragma("unroll") for (int _i = 0; _i < 2; ++_i) \
        __builtin_amdgcn_global_load_lds((const unsigned*)((const char*)(gbase) + (voff)[_i]), (LAS unsigned*)(lds + (bufoff) + ldsw + _i * 8192), 16, 0, 0); } while (0)
#define PG8_LDA(dst, b, h) do { _Pragma("unroll") for (int m = 0; m < 4; ++m) _Pragma("unroll") for (int k = 0; k < 2; ++k) dst[m][k] = *(const LAS bf16x8*)(lds + PG8_SA(b, h) + aoff + m * 2048 + k * 1024); } while (0)
#define PG8_LDB(dst, b, h) do { _Pragma("unroll") for (int n = 0; n < 2; ++n) _Pragma("unroll") for (int k = 0; k < 2; ++k) dst[n][k] = *(const LAS bf16x8*)(lds + PG8_SB(b, h) + boff + n * 2048 + k * 1024); } while (0)
#define PG8_MMA(ai, bj, At, Bt) do { __builtin_amdgcn_s_setprio(1); _Pragma("unroll") for (int m = 0; m < 4; ++m) _Pragma("unroll") for (int n = 0; n < 2; ++n) _Pragma("unroll") for (int k = 0; k < 2; ++k) \
        acc[ai][bj][m][n] = __builtin_amdgcn_mfma_f32_16x16x32_bf16(Bt[n][k], At[m][k], acc[ai][bj][m][n], 0, 0, 0); __builtin_amdgcn_s_setprio(0); } while (0)
#define PG8_WAIT_V(n) asm volatile("s_waitcnt vmcnt(" #n ")" ::: "memory")
#define PG8_WAIT_L(n) asm volatile("s_waitcnt lgkmcnt(" #n ")" ::: "memory")
#define PG8_BAR __builtin_amdgcn_s_barrier()
#define PG8_SCHED __builtin_amdgcn_sched_barrier(0)
    Unit cur, nxt; int ui = 0;
    if (!S.next(0, cur)) return;
    f32x4 acc[2][2][4][2];
#pragma unroll
    for (int a = 0; a < 2; ++a)
#pragma unroll
        for (int b = 0; b < 2; ++b)
#pragma unroll
            for (int m = 0; m < 4; ++m)
#pragma unroll
                for (int n = 0; n < 2; ++n) acc[a][b][m][n] = (f32x4){0.f, 0.f, 0.f, 0.f};
    bf16x8 At[4][2], B0[2][2], B1[2][2];
    const char* cA = (const char*)g.A + (size_t)cur.pm * tstepA + (size_t)cur.pn * g.a_pn_off * 2; const char* cB = (const char*)g.Bt + (size_t)cur.pn * tstepB;
    PG8_STAGE(PG8_SB(0, 0), cB, voffB); PG8_STAGE(PG8_SB(0, 1), cB + hstepB, voffB); PG8_STAGE(PG8_SA(0, 0), cA, voffA); PG8_STAGE(PG8_SA(0, 1), cA + hstepA, voffA);
    if (wr == 1) PG8_BAR;
    PG8_WAIT_V(2); PG8_BAR;
    PG8_STAGE(PG8_SB(1, 0), cB + kstep, voffB); PG8_STAGE(PG8_SA(1, 0), cA + kstep, voffA); PG8_STAGE(PG8_SB(1, 1), cB + hstepB + kstep, voffB);
    PG8_WAIT_V(6); PG8_BAR;
    for (;;) {
        const bool has_next = S.next(ui + 1, nxt);
        const char* nA = has_next ? (const char*)g.A + (size_t)nxt.pm * tstepA + (size_t)nxt.pn * g.a_pn_off * 2 : cA; const char* nB = has_next ? (const char*)g.Bt + (size_t)nxt.pn * tstepB : cB;
        for (int t = 0; t < nt; t += 2) {
            const bool last = (t == nt - 2);
            const char* a1 = cA + (size_t)(t + 1) * kstep;
            const char* a2 = last ? nA : cA + (size_t)(t + 2) * kstep; const char* b2 = last ? nB : cB + (size_t)(t + 2) * kstep;
            const char* a3 = a2 + kstep; const char* b3 = b2 + kstep;
            PG8_LDB(B0, 0, 0); PG8_LDB(B1, 0, 1); PG8_SCHED; PG8_LDA(At, 0, 0); PG8_STAGE(PG8_SA(1, 1), a1 + hstepA, voffA);
            PG8_WAIT_V(8); PG8_WAIT_L(0); PG8_BAR; PG8_MMA(0, 0, At, B0); PG8_MMA(0, 1, At, B1); PG8_BAR; PG8_SCHED;
            PG8_LDA(At, 0, 1); PG8_STAGE(PG8_SB(0, 0), b2, voffB); PG8_STAGE(PG8_SB(0, 1), b2 + hstepB, voffB); PG8_STAGE(PG8_SA(0, 0), a2, voffA);
            PG8_WAIT_V(8); PG8_WAIT_L(0); PG8_BAR; PG8_MMA(1, 0, At, B0); PG8_MMA(1, 1, At, B1); PG8_BAR; PG8_SCHED;
            PG8_LDB(B0, 1, 0); PG8_LDB(B1, 1, 1); PG8_SCHED; PG8_LDA(At, 1, 0); PG8_STAGE(PG8_SA(0, 1), a2 + hstepA, voffA);
            PG8_WAIT_V(8); PG8_WAIT_L(0); PG8_BAR; PG8_MMA(0, 0, At, B0); PG8_MMA(0, 1, At, B1); PG8_BAR; PG8_SCHED;
            PG8_LDA(At, 1, 1); PG8_STAGE(PG8_SB(1, 0), b3, voffB); PG8_STAGE(PG8_SB(1, 1), b3 + hstepB, voffB); PG8_STAGE(PG8_SA(1, 0), a3, voffA);
            PG8_WAIT_V(8); PG8_WAIT_L(0); PG8_BAR; PG8_MMA(1, 0, At, B0); PG8_MMA(1, 1, At, B1); PG8_BAR; PG8_SCHED;
        }
        if (wr == 0) PG8_BAR;
        E(acc, cur, wr, wc, fr, fq);
        if (!has_next) break;
#pragma unroll
        for (int a = 0; a < 2; ++a)
#pragma unroll
            for (int b = 0; b < 2; ++b)
#pragma unroll
                for (int m = 0; m < 4; ++m)
#pragma unroll
                    for (int n = 0; n < 2; ++n) acc[a][b][m][n] = (f32x4){0.f, 0.f, 0.f, 0.f};
        cur = nxt; cA = nA; cB = nB; ++ui;
        if (wr == 1) PG8_BAR;
    }
    PG8_WAIT_V(0);
    PG8_BAR;
#undef PG8_SA
#undef PG8_SB
#undef PG8_STAGE
#undef PG8_LDA
#undef PG8_LDB
#undef PG8_MMA
#undef PG8_WAIT_V
#undef PG8_WAIT_L
#undef PG8_BAR
#undef PG8_SCHED
}

constexpr int MTAIL0 = 16384;
template <class Epi>
__device__ __forceinline__ void gemm_tail(LAS unsigned char* lds_in, int wave_in, const Gemm g, const Epi& E) {
    int lane = (int)__builtin_amdgcn_mbcnt_hi(~0u, __builtin_amdgcn_mbcnt_lo(~0u, 0u)); asm volatile("" : "+v"(lane));
    int wid = wave_in; asm volatile("" : "+s"(wid));
    LAS unsigned char* lds = lds_in; asm volatile("" : "+s"(lds));
    int G = gridDim.x, bid = blockIdx.x; asm volatile("" : "+s"(G)); asm volatile("" : "+s"(bid));
    const int r = lane & 15, q = lane >> 4;
    constexpr int NRT = (MREAL - MTAIL0) / 32, NCT = 1024 / 64;
    const int klen = g.K / 8, kbeg = wid * klen;
    const int nx = (G % 8 == 0) ? 8 : 1, x = (nx == 8) ? (bid & 7) : 0, j = (nx == 8) ? (bid >> 3) : bid, nj = G / nx;
    const int ct_per = NCT / nx, ntile = NRT * ct_per;
    LAS float* red = (LAS float*)lds;
    const size_t a16 = (size_t)16 * g.lda, b16 = (size_t)16 * g.ldb;
    bf16x8 pa[4][2], pb[4][4];
#define TAIL_PTRS(tt_, rt_, ct_, row0_, col0_, ap_, bp_) const int rt_ = (tt_) % NRT, ct_ = x * ct_per + (tt_) / NRT, row0_ = MTAIL0 + 32 * rt_, col0_ = 64 * ct_; \
        const bf16_t* ap_ = g.A + (size_t)(row0_ + r) * g.lda + 8 * q + kbeg + (size_t)(col0_ >> 8) * g.a_pn_off; const bf16_t* bp_ = g.Bt + (size_t)(col0_ + r) * g.ldb + 8 * q + kbeg; (void)rt_; (void)ct_;
#define TAIL_PF(ap_, bp_) do { _Pragma("unroll") for (int s_ = 0; s_ < 4; ++s_) { _Pragma("unroll") for (int i = 0; i < 2; ++i) pa[s_][i] = *(const bf16x8*)((ap_) + i * a16 + 32 * s_); \
        _Pragma("unroll") for (int f = 0; f < 4; ++f) pb[s_][f] = *(const bf16x8*)((bp_) + f * b16 + 32 * s_); } } while (0)
    if (j < ntile) { TAIL_PTRS(j, rt0, ct0, row00, col00, ap0, bp0); (void)row00; TAIL_PF(ap0, bp0); }
    for (int tt = j; tt < ntile; tt += nj) {
        TAIL_PTRS(tt, rt, ct, row0, col0, ap, bp);
        const int rr = 4 * wid + (lane >> 4), cc = 4 * (lane & 15);
        const typename Epi::Pre pre = E.tail4_pre(row0 + rr, col0 + cc);
        f32x4 acc[2][4];
#pragma unroll
        for (int i = 0; i < 2; ++i)
#pragma unroll
            for (int f = 0; f < 4; ++f) acc[i][f] = (f32x4){0.f, 0.f, 0.f, 0.f};
#pragma unroll
        for (int s_ = 0; s_ < 4; ++s_)
#pragma unroll
            for (int i = 0; i < 2; ++i)
#pragma unroll
                for (int f = 0; f < 4; ++f) acc[i][f] = __builtin_amdgcn_mfma_f32_16x16x32_bf16(pb[s_][f], pa[s_][i], acc[i][f], 0, 0, 0);
#pragma unroll 4
        for (int k0 = 128; k0 < klen; k0 += 32) {
            bf16x8 a[2], b[4];
#pragma unroll
            for (int i = 0; i < 2; ++i) a[i] = *(const bf16x8*)(ap + i * a16 + k0);
#pragma unroll
            for (int f = 0; f < 4; ++f) b[f] = *(const bf16x8*)(bp + f * b16 + k0);
#pragma unroll
            for (int i = 0; i < 2; ++i)
#pragma unroll
                for (int f = 0; f < 4; ++f) acc[i][f] = __builtin_amdgcn_mfma_f32_16x16x32_bf16(b[f], a[i], acc[i][f], 0, 0, 0);
        }
        __builtin_amdgcn_sched_barrier(0);
        if (tt + nj < ntile) { TAIL_PTRS(tt + nj, rtn, ctn, row0n, col0n, apn, bpn); (void)row0n; TAIL_PF(apn, bpn); }
        __builtin_amdgcn_sched_barrier(0);
#pragma unroll
        for (int i = 0; i < 2; ++i)
#pragma unroll
            for (int f = 0; f < 4; ++f) *(LAS f32x4*)(red + wid * 2048 + (16 * i + r) * 64 + 16 * f + 4 * q) = acc[i][f];
        LBAR();
        {
            f32x4 v = (f32x4){0.f, 0.f, 0.f, 0.f};
#pragma unroll
            for (int w = 0; w < 8; ++w) v += *(const LAS f32x4*)(red + w * 2048 + rr * 64 + cc);
            E.tail4(v, pre, row0 + rr, col0 + cc, lane);
        }
        LBAR();
    }
#undef TAIL_PTRS
#undef TAIL_PF
}
}

struct Params { const float* in[26]; float* out; unsigned char* ws; };

typedef const Params __attribute__((address_space(4)))* KP;
__device__ __forceinline__ KP kparams() { KP p = (KP)__builtin_amdgcn_kernarg_segment_ptr(); asm volatile("" : "+s"(p)); return p; }
struct Ctx { int tid, lane, wave, G, bid; };
__device__ __forceinline__ Ctx get_ids(int wave_in) { Ctx I;
    int ln = (int)__builtin_amdgcn_mbcnt_hi(~0u, __builtin_amdgcn_mbcnt_lo(~0u, 0u)); asm volatile("" : "+v"(ln));
    int wv = wave_in; asm volatile("" : "+s"(wv));
    int gg = gridDim.x, bb = blockIdx.x; asm volatile("" : "+s"(gg)); asm volatile("" : "+s"(bb));
    I.lane = ln; I.wave = wv; I.tid = wv * 64 + ln; I.G = gg; I.bid = bb; return I; }

#define XB_TMO      128
#define XB_XCNT(j)  (256  + 64 * (j))
#define XB_XSUB(j)  (1280 + 64 * (j))
#define XB_XGEN(j)  (2304 + 64 * (j))
#define XB_TOP      3328
#define XB_TOPGEN   3392
#define XCD_BAR_WORDS 3456
#define XB_SPIN_CAP (1u << 20)
__device__ __forceinline__ unsigned xb_ld(unsigned* p)              { return __hip_atomic_load(p, __ATOMIC_RELAXED, __HIP_MEMORY_SCOPE_AGENT); }
__device__ __forceinline__ unsigned xb_add(unsigned* p, unsigned v) { return __hip_atomic_fetch_add(p, v, __ATOMIC_RELAXED, __HIP_MEMORY_SCOPE_AGENT); }
__device__ __forceinline__ unsigned xb_xcc_id() { return (unsigned)__builtin_amdgcn_s_getreg((3 << 11) | 20) & 0xFu; }
#define XB_SPIN(cond, bar) do { unsigned _sp = 0; while (cond) { __builtin_amdgcn_s_sleep(1); \
    if ((++_sp & 255u) == 0u) { if (xb_ld(&(bar)[XB_TMO])) break; if (_sp > XB_SPIN_CAP) { atomicAdd(&(bar)[XB_TMO], 1u); break; } } } } while (0)
__device__ __forceinline__ void xcd_barrier_complete(unsigned* bar, unsigned x, unsigned& nloc, unsigned& nx) {
    const unsigned G = gridDim.x;
    unsigned sum, cnt, mine, sp = 0u;
    for (;;) {
        sum = 0u; cnt = 0u; mine = 0u;
#pragma unroll
        for (unsigned j = 0; j < 16; ++j) { const unsigned c = xb_ld(&bar[XB_XCNT(j)]); sum += c; cnt += (c > 0u) ? 1u : 0u; mine = (j == x) ? c : mine; }
        if (sum == G) break;
        __builtin_amdgcn_s_sleep(1);
        if ((++sp & 255u) == 0u) { if (xb_ld(&bar[XB_TMO])) break; if (sp > XB_SPIN_CAP) { atomicAdd(&bar[XB_TMO], 1u); break; } }
    }
    nloc = mine > 0u ? mine : 1u; nx = cnt > 0u ? cnt : 1u;
}
__device__ __forceinline__ void grid_barrier(unsigned char* ws, LAS unsigned char* lds_in, int wave_in) {
    const Ctx C = get_ids(wave_in);
    unsigned* bar = (unsigned*)(ws + WS_CTL);
    volatile LAS unsigned* st = (volatile LAS unsigned*)(lds_in + LDS_ST_OFF);
    asm volatile("s_waitcnt vmcnt(0)" ::: "memory");
    __syncthreads();
    if (C.tid == 0) {
        __builtin_amdgcn_s_waitcnt(0);
        const unsigned x = xb_xcc_id();
        unsigned nloc = st[0], nx = st[1];
        if (nloc == 0u) { xcd_barrier_complete(bar, x, nloc, nx); st[0] = nloc; st[1] = nx; }
        const unsigned old = xb_add(&bar[XB_XSUB(x)], 1u);
        const unsigned gen = old / nloc;
        if (old + 1u == (gen + 1u) * nloc) {
            __builtin_amdgcn_fence(__ATOMIC_RELEASE, "agent");
            asm volatile("s_waitcnt vmcnt(0)" ::: "memory");
            const unsigned og = xb_add(&bar[XB_TOP], 1u);
            const unsigned tg = og / nx;
            if (og + 1u == (tg + 1u) * nx) xb_add(&bar[XB_TOPGEN], 1u);
            else XB_SPIN(xb_ld(&bar[XB_TOPGEN]) == tg, bar);
            __builtin_amdgcn_fence(__ATOMIC_ACQUIRE, "agent");
            xb_add(&bar[XB_XGEN(x)], 1u);
            asm volatile("s_waitcnt vmcnt(0)" ::: "memory");
        } else {
            XB_SPIN(xb_ld(&bar[XB_XGEN(x)]) == gen, bar);
            __builtin_amdgcn_fence(__ATOMIC_ACQUIRE, "agent");
            asm volatile("s_waitcnt vmcnt(0)" ::: "memory");
        }
    }
    __syncthreads();
}

#define IN_(i) (kp->in[i])
#define WSP(T, off) ((T*)(ws + (off)))

__device__ __forceinline__ void transpose_item(const float* W, int ldw, int col0, int k0, bf16_t* WT, int ldk, const float* ks, const float* ns, int ncol_valid, LAS float* scr, int lane) {
    const int c4 = (lane & 15) * 4, rsub = lane >> 4;
    const bool cv = c4 < ncol_valid;
    f32x4 nsv = (f32x4){1.f, 1.f, 1.f, 1.f}; if (ns && cv) nsv = *(const f32x4*)(ns + c4);
    f32x4 v[16];
#pragma unroll
    for (int i = 0; i < 16; ++i) v[i] = cv ? *(const f32x4*)(W + (size_t)(k0 + i * 4 + rsub) * ldw + col0 + c4) : (f32x4){0.f, 0.f, 0.f, 0.f};
#pragma unroll
    for (int i = 0; i < 16; ++i) { const int kk = i * 4 + rsub; f32x4 x = v[i] * nsv; if (ks) x = x * ks[k0 + kk];
        LAS float* d = scr + kk * 65 + c4; d[0] = x.x; d[1] = x.y; d[2] = x.z; d[3] = x.w; }
    LDS_WAIT(); asm volatile("" ::: "memory");
    const int c = lane & 7;
#pragma unroll
    for (int j = 0; j < 8; ++j) { const int n = (lane >> 3) + 8 * j; const LAS float* s = scr + (8 * c) * 65 + n;
        u32x4 o; o.x = pk2(s[0 * 65], s[1 * 65]); o.y = pk2(s[2 * 65], s[3 * 65]); o.z = pk2(s[4 * 65], s[5 * 65]); o.w = pk2(s[6 * 65], s[7 * 65]);
        *(u32x4*)(WT + (size_t)n * ldk + k0 + 8 * c) = o; }
    LDS_WAIT(); asm volatile("" ::: "memory");
}

__device__ __forceinline__ void prologue(const Ctx& C_, LAS unsigned char* lds) {
    const Ctx C = get_ids(C_.wave);
    KP kp = kparams(); unsigned char* ws = kp->ws; (void)ws;
    const float* const L_x_prompt = kp->in[0];
    const float* const L_x_sample = kp->in[1];
    const float* const L_meta = kp->in[6];
    const float* const L_norm1_w = kp->in[7];
    const float* const L_w_in = kp->in[8];
    const float* const L_pool_w = kp->in[9];
    const float* const L_pool_scale = kp->in[10];
    const float* const L_w_pool_out = kp->in[11];
    const float* const L_ssd_norm_w = kp->in[17];
    const float* const L_w_ssd_out = kp->in[18];
    const float* const L_w_o = kp->in[19];
    const float* const L_norm2_w = kp->in[20];
    const float* const L_w_up = kp->in[21];
    const float* const L_w_down = kp->in[24];
    bf16_t* const L_W1T = (bf16_t*)(ws + WS_W1T);
    bf16_t* const L_PWT = (bf16_t*)(ws + WS_PWT);
    bf16_t* const L_WPOT = (bf16_t*)(ws + WS_WPOT);
    bf16_t* const L_WSOT = (bf16_t*)(ws + WS_WSOT);
    bf16_t* const L_WOT = (bf16_t*)(ws + WS_WOT);
    bf16_t* const L_WUPT = (bf16_t*)(ws + WS_WUPT);
    bf16_t* const L_WDT = (bf16_t*)(ws + WS_WDT);
    bf16_t* const L_XB = (bf16_t*)(ws + WS_XB);
    float* const L_X = (float*)(ws + WS_X);
    float* const L_RSS = (float*)(ws + WS_RSS);
    LAS float* scr = (LAS float*)(lds + C.wave * 16640);
    const int gw = C.bid * NWAVES + C.wave, NGW = C.G * NWAVES, lane = C.lane;
    constexpr int NB1 = NPROJ / 64;
    constexpr int I_W1 = 16 * NB1, I_PW = 4 * 4 * 4, I_PO = 16 * 16, I_SO = 32 * 16, I_O = 16 * 16, I_UP = 16 * (DUP / 64), I_D = (DFF / 64) * 16;
    constexpr int I_LAYER = I_W1 + I_PW + I_PO + I_SO + I_O + I_UP + I_D;
    for (int it = gw; it < DEPTH * I_LAYER; it += NGW) {
        const int l = it / I_LAYER; int r = it - l * I_LAYER;
        if (r < I_W1) {
            const int nb = r % NB1, kb = r / NB1, n0 = nb * 64, k0 = kb * 64;
            bf16_t* dst = L_W1T + ((size_t)l * NPROJ + n0) * 1024;
            if (n0 >= PC_DT + 64) {
                const int c = lane & 7;
#pragma unroll
                for (int j = 0; j < 8; ++j) { const int n = (lane >> 3) + 8 * j; *(u32x4*)(dst + (size_t)n * 1024 + k0 + 8 * c) = (u32x4){0u, 0u, 0u, 0u}; }
            } else {
                int sc, nv = 64;
                if (n0 < PC_GA) sc = n0; else if (n0 < PC_GB) sc = 6176 + (n0 - PC_GA); else if (n0 < PC_DT) sc = 7200 + (n0 - PC_GB); else { sc = 6144; nv = 32; }
                transpose_item(L_w_in + (size_t)l * 1024 * 8224, 8224, sc, k0, dst, 1024, L_norm1_w + l * 1024, nullptr, nv, scr, lane);
            }
            continue;
        }
        r -= I_W1;
        if (r < I_PW) {
            const int g = r / 16, rr = r % 16, kb = rr / 4, nb = rr % 4;
            transpose_item(L_pool_w + ((size_t)(l * 4 + g) * 256) * 256, 256, nb * 64, kb * 64, L_PWT + ((size_t)l * 1024 + g * 256 + nb * 64) * 256, 256, nullptr, L_pool_scale + l * 1024 + g * 256 + nb * 64, 64, scr, lane);
            continue;
        }
        r -= I_PW;
        if (r < I_PO) { const int kb = r / 16, nb = r % 16;
            transpose_item(L_w_pool_out + (size_t)l * 1024 * 1024, 1024, nb * 64, kb * 64, L_WPOT + ((size_t)l * 1024 + nb * 64) * 1024, 1024, nullptr, nullptr, 64, scr, lane); continue; }
        r -= I_PO;
        if (r < I_SO) { const int kb = r / 16, nb = r % 16;
            transpose_item(L_w_ssd_out + (size_t)l * 2048 * 1024, 1024, nb * 64, kb * 64, L_WSOT + ((size_t)l * 1024 + nb * 64) * 2048, 2048, L_ssd_norm_w + l * 2048, nullptr, 64, scr, lane); continue; }
        r -= I_SO;
        if (r < I_O) { const int kb = r / 16, nb = r % 16;
            transpose_item(L_w_o + (size_t)l * 1024 * 1024, 1024, nb * 64, kb * 64, L_WOT + ((size_t)l * 1024 + nb * 64) * 1024, 1024, nullptr, nullptr, 64, scr, lane); continue; }
        r -= I_O;
        if (r < I_UP) { const int kb = r / (DUP / 64), nb = r % (DUP / 64);
            transpose_item(L_w_up + (size_t)l * 1024 * DUP, DUP, nb * 64, kb * 64, L_WUPT + ((size_t)l * DUP + nb * 64) * 1024, 1024, L_norm2_w + l * 1024, nullptr, 64, scr, lane); continue; }
        r -= I_UP;
        { const int kb = r / 16, nb = r % 16;
            transpose_item(L_w_down + (size_t)l * DFF * 1024, 1024, nb * 64, kb * 64, L_WDT + ((size_t)l * 1024 + nb * 64) * DFF, DFF, nullptr, nullptr, 64, scr, lane); }
    }
    for (int m = gw; m < MP; m += NGW) {
        const float* src = nullptr;
        if (m < MPROMPT) { const int b = m / LP, t = m - b * LP; src = (t < NMETA) ? L_meta + (size_t)t * DM : L_x_prompt + ((size_t)b * SEQ + (t - NMETA)) * DM; }
        else if (m < MREAL) src = L_x_sample + (size_t)(m - MPROMPT) * DM;
        float ss = 0.f;
#pragma unroll
        for (int j = 0; j < 4; ++j) {
            f32x4 v = src ? ((const f32x4*)src)[lane + 64 * j] : (f32x4){0.f, 0.f, 0.f, 0.f};
            ss += (v.x * v.x + v.y * v.y) + (v.z * v.z + v.w * v.w);
            ((f32x4*)(L_X + (size_t)m * DM))[lane + 64 * j] = v;
            u32x2 w; w.x = pk2(v.x, v.y); w.y = pk2(v.z, v.w);
            ((u32x2*)(L_XB + (size_t)m * DM))[lane + 64 * j] = w;
        }
        ss = wave_sum(ss);
        if (lane < 16) L_RSS[(size_t)m * 16 + lane] = (lane == 0) ? ss : 0.f;
    }
}

__device__ __forceinline__ void conv_pass(const Ctx& C_, int l) {
    const Ctx C = get_ids(C_.wave);
    KP kp = kparams(); unsigned char* ws = kp->ws;
    const float* const L_state_conv = kp->in[3];
    const float* const L_conv_w = kp->in[12];
    const float* const L_conv_b = kp->in[13];
    const float* const L_dt_bias = kp->in[14];
    const bf16_t* const L_PROJ = (const bf16_t*)(ws + WS_PROJ);
    bf16_t* const L_XBCC = (bf16_t*)(ws + WS_XBCC);
    const float* const L_DT = (const float*)(ws + WS_DT);
    float* const L_DTS = (float*)(ws + WS_DTS);
    const int gtid = C.bid * NTHREADS + C.tid, NT = C.G * NTHREADS;
    constexpr int NV = CONVD / 8, NSTRIP = MREAL / 8;
    for (int it = gtid; it < NSTRIP * NV; it += NT) {
        const int strip = it / NV, v = it - strip * NV, ch = v * 8, m0 = strip * 8;
        const bool sample = m0 >= MPROMPT;
        const int t0 = sample ? 0 : (m0 % LP), b = sample ? (m0 - MPROMPT) / DS : 0;
        const bf16_t* rb = L_PROJ + ((size_t)m0 - 3) * NPROJ + PC_XBC + ch;
        u32x4 raw[11];
#pragma unroll
        for (int i = 0; i < 11; ++i) raw[i] = *(const u32x4*)(rb + (size_t)((t0 + i - 3 >= 0) ? i : 3) * NPROJ);
        if (t0 < 3) {
#pragma unroll
            for (int i = 0; i < 3; ++i) if (t0 + i - 3 < 0) {
                u32x4 rv = (u32x4){0u, 0u, 0u, 0u};
                if (sample) { const float* pp = L_state_conv + ((size_t)(l * DB + b) * 3 + i) * CONVD + ch; rv = pack8v(*(const f32x4*)pp, *(const f32x4*)(pp + 4)); }
                raw[i] = rv; }
        }
        f32x4 cw[4][2], cbias[2];
#pragma unroll
        for (int k = 0; k < 4; ++k) { cw[k][0] = *(const f32x4*)(L_conv_w + ((size_t)l * 4 + k) * CONVD + ch); cw[k][1] = *(const f32x4*)(L_conv_w + ((size_t)l * 4 + k) * CONVD + ch + 4); }
        cbias[0] = *(const f32x4*)(L_conv_b + (size_t)l * CONVD + ch); cbias[1] = *(const f32x4*)(L_conv_b + (size_t)l * CONVD + ch + 4);
        float oacc[4][8];
#pragma unroll
        for (int i = 0; i < 11; ++i) {
            float xv[8]; unpack8(raw[i], xv);
            if (i < 8) {
#pragma unroll
                for (int e = 0; e < 8; ++e) oacc[i & 3][e] = 0.f;
            }
#pragma unroll
            for (int k = 0; k < 4; ++k) { const int j = i - k;
                if (j >= 0 && j < 8) { float* o = oacc[j & 3];
                    o[0] += cw[k][0].x * xv[0]; o[1] += cw[k][0].y * xv[1]; o[2] += cw[k][0].z * xv[2]; o[3] += cw[k][0].w * xv[3];
                    o[4] += cw[k][1].x * xv[4]; o[5] += cw[k][1].y * xv[5]; o[6] += cw[k][1].z * xv[6]; o[7] += cw[k][1].w * xv[7]; } }
            if (i >= 3) {
                const int j = i - 3; const float* oa = oacc[j & 3];
                float o[8];
                o[0] = siluf_(oa[0] + cbias[0].x); o[1] = siluf_(oa[1] + cbias[0].y); o[2] = siluf_(oa[2] + cbias[0].z); o[3] = siluf_(oa[3] + cbias[0].w);
                o[4] = siluf_(oa[4] + cbias[1].x); o[5] = siluf_(oa[5] + cbias[1].y); o[6] = siluf_(oa[6] + cbias[1].z); o[7] = siluf_(oa[7] + cbias[1].w);
                *(u32x4*)(L_XBCC + (size_t)(m0 + j) * CONVD + ch) = pack8(o);
            }
        }
    }
    for (int idx = gtid; idx < MREAL * NH; idx += NT) {
        const float rw = L_DT[idx] + L_dt_bias[l * NH + (idx & 31)];
        L_DTS[(size_t)(idx & 31) * MP + (idx >> 5)] = rw > 20.f ? rw : __logf(1.0f + __expf(rw));
    }
}

constexpr int LD128 = 136, LD64 = 72;
constexpr int S_C = 0, S_CS = 17408, S_B = 34816, S_BWT = 52224, S_XDT = 70656, S_XS = 79872, S_M = 89088, S_H = 98304, S_Z = 115712  , S_DTV = 124928, S_CUM = 125440, S_SSQ = 125952;

#define SSD_PREFETCH(r0_, ntok_, h_, xoff_, zoff_, boff_, c0n) do { \
    const int nqn_ = ((ntok_) - (c0n)) < 64 ? ((ntok_) - (c0n)) : 64; \
    const bf16_t* xb_ = L_XBCC + (size_t)((r0_) + (c0n)) * CONVD; \
    { unsigned z_ = 0u; asm volatile("" : "+v"(z_)); rx = (u32x4){z_, z_, z_, z_}; } zraw = rx; rB[0] = rx; rB[1] = rx; rC[0] = rx; rC[1] = rx;     \
    if (zt < nqn_) zraw = *(const u32x4*)(L_PROJ + (size_t)((r0_) + (c0n)) * NPROJ + (zoff_)); \
    if (zt < nqn_) rx = *(const u32x4*)(xb_ + (xoff_)); \
    _Pragma("unroll") for (int i_ = 0; i_ < 2; ++i_) if (bt + 32 * i_ < nqn_) { rB[i_] = *(const u32x4*)(xb_ + (boff_) + (size_t)i_ * 32 * CONVD); rC[i_] = *(const u32x4*)(xb_ + (boff_) + 512 + (size_t)i_ * 32 * CONVD); } \
    dtraw = (lane < nqn_) ? L_DTS[(size_t)(h_) * MP + (unsigned)((r0_) + (c0n) + lane)] : 0.f; \
} while (0)
#define SSD_UNIT(u_, smp_, b_, h_, r0_, ntok_, xoff_, zoff_, boff_) do { \
    smp_ = (u_) >= NBATCH * NH; const int k_ = smp_ ? (u_) - NBATCH * NH : (u_); b_ = k_ / NH; h_ = k_ - b_ * NH; \
    r0_ = smp_ ? MPROMPT + b_ * DS : b_ * LP; ntok_ = smp_ ? DS : LP; \
    xoff_ = (unsigned)zt * CONVD + h_ * 64 + zv * 8; zoff_ = (unsigned)zt * NPROJ + PC_Z + h_ * 64 + zv * 8; boff_ = (unsigned)bt * CONVD + 2048 + (h_ >> 3) * 128 + bv * 8; \
} while (0)

__device__ __forceinline__ void ssd_phase(const Ctx& C_, LAS unsigned char* lds_in, int l) {
    const Ctx C = get_ids(C_.wave);
    LAS unsigned char* lds = lds_in; asm volatile("" : "+s"(lds));
    KP kp = kparams(); unsigned char* ws = kp->ws;
    const float* const L_state_ssm = kp->in[4];
    float* const L_out = kp->out;
    const bf16_t* const L_PROJ = (const bf16_t*)(ws + WS_PROJ);
    const bf16_t* const L_XBCC = (const bf16_t*)(ws + WS_XBCC);
    bf16_t* const L_YN = (bf16_t*)(ws + WS_YN);
    const float* const L_DTS = (const float*)(ws + WS_DTS);
    float* const L_SSQ = (float*)(ws + WS_SSQ);
    const float* const L_a_log = kp->in[15] + l * NH; const float* const L_d_skip = kp->in[16] + l * NH;
    const int tid = C.tid, lane = C.lane, wave = C.wave, r = lane & 15, q = lane >> 4;
    LAS bf16_t* sC = (LAS bf16_t*)(lds + S_C); LAS bf16_t* sCs = (LAS bf16_t*)(lds + S_CS); LAS bf16_t* sB = (LAS bf16_t*)(lds + S_B);
    LAS bf16_t* sBwT = (LAS bf16_t*)(lds + S_BWT); LAS bf16_t* sXdT = (LAS bf16_t*)(lds + S_XDT); LAS bf16_t* sXs = (LAS bf16_t*)(lds + S_XS);
    LAS bf16_t* sM = (LAS bf16_t*)(lds + S_M); LAS bf16_t* sH = (LAS bf16_t*)(lds + S_H); LAS bf16_t* sZ = (LAS bf16_t*)(lds + S_Z);
    LAS float* scum = (LAS float*)(lds + S_CUM); LAS float* sssq = (LAS float*)(lds + S_SSQ);
    const int zt = tid >> 3, zv = tid & 7, bt = tid >> 4, bv = tid & 15;
    const int pjs = wave & 3, ni0 = (wave >> 2) * 4;
    const int NU = NBATCH * NH;
    int u = C.bid; if (u >= NU) return;
    bool sample; int b, h, r0, ntok; unsigned xoff, zoff, boff;
    SSD_UNIT(u, sample, b, h, r0, ntok, xoff, zoff, boff);
    u32x4 rx, zraw, rB[2], rC[2]; float dtraw = 0.f;
    SSD_PREFETCH(r0, ntok, h, xoff, zoff, boff, 0);
    if (tid < 64) sssq[tid] = 0.f;
  for (;;) {
    const float a_h = -__expf(L_a_log[h]), dsk = L_d_skip[h];
    f32x4 H[4];
    if (sample) { const float* h0 = L_state_ssm + ((size_t)(l * DB + b) * NH + h) * (HD * NST);
#pragma unroll
        for (int j = 0; j < 4; ++j) H[j] = *(const f32x4*)(h0 + (16 * pjs + r) * NST + 16 * (ni0 + j) + 4 * q);
    } else {
        float z_ = 0.f; asm volatile("" : "+v"(z_));
#pragma unroll
        for (int j = 0; j < 4; ++j) H[j] = (f32x4){z_, z_, z_, z_};
    }
    const int un = u + C.G; const bool has_next = un < NU;
    LBAR();

    int par = 0;
    for (int c0 = 0; c0 < ntok; c0 += 64, par ^= 1) {
        const int nq = (ntok - c0) < 64 ? (ntok - c0) : 64;
        const bool more = (c0 + 64) < ntok;
        const LAS float* cumc = scum;
        const float d = dtraw;
        float cs = d * a_h;
#pragma unroll
        for (int o_ = 1; o_ < 64; o_ <<= 1) { const float v_ = shup(cs, o_, lane); if (lane >= o_) cs += v_; }
        const float clast = shidx(cs, 63);
        if (wave == 7) scum[lane] = cs;
#define SWZ(row_, tok_) ((row_) * LD64 + (((((tok_) >> 3) ^ (((row_) >> 3) & 7)) << 3) | ((tok_) & 7)))
        {
            const float dz = shidx(d, zt), wcs0 = shidx(cs, bt), wcs1 = shidx(cs, bt + 32);
            float xv[8]; unpack8(rx, xv);
            *(LAS u32x4*)(sXs + zt * LD64 + zv * 8) = rx;
            *(LAS u32x4*)(sZ + zt * LD64 + zv * 8) = zraw;
#pragma unroll
            for (int e = 0; e < 8; ++e) sXdT[SWZ(zv * 8 + e, zt)] = (bf16_t)f2bf(xv[e] * dz);
#pragma unroll
            for (int i = 0; i < 2; ++i) {
                const int st = bt + 32 * i; const float csx = i == 0 ? wcs0 : wcs1;
                const float wb = __expf(clast - csx), wc = __expf(csx);
                float bvv[8]; unpack8(rB[i], bvv);
                *(LAS u32x4*)(sB + st * LD128 + bv * 8) = rB[i];
#pragma unroll
                for (int e = 0; e < 8; ++e) sBwT[SWZ(bv * 8 + e, st)] = (bf16_t)f2bf(bvv[e] * wb);
                float cvv[8]; unpack8(rC[i], cvv);
                *(LAS u32x4*)(sC + st * LD128 + bv * 8) = rC[i];
#pragma unroll
                for (int e = 0; e < 8; ++e) cvv[e] *= wc;
                *(LAS u32x4*)(sCs + st * LD128 + bv * 8) = pack8(cvv);
            }
        }
        __builtin_amdgcn_sched_barrier(0);
        if (more) { SSD_PREFETCH(r0, ntok, h, xoff, zoff, boff, c0 + 64); }
        else if (has_next) {
            bool sample_n; int b_n, h_n, r0_n, ntok_n; unsigned xoff_n, zoff_n, boff_n;
            SSD_UNIT(un, sample_n, b_n, h_n, r0_n, ntok_n, xoff_n, zoff_n, boff_n);
            SSD_PREFETCH(r0_n, ntok_n, h_n, xoff_n, zoff_n, boff_n, 0);
        }
        LBAR();
        {
            const int ti = wave >> 1, sj0 = (wave & 1) * 2;
            if (16 * ti < nq) {
                bf16x8 fa[4], fb[2][4];
#pragma unroll
                for (int kk = 0; kk < 4; ++kk) {
                    fa[kk] = *(const LAS bf16x8*)(sC + (16 * ti + r) * LD128 + kk * 32 + q * 8);
                    fb[0][kk] = *(const LAS bf16x8*)(sB + (16 * sj0 + r) * LD128 + kk * 32 + q * 8);
                    fb[1][kk] = *(const LAS bf16x8*)(sB + (16 * (sj0 + 1) + r) * LD128 + kk * 32 + q * 8);
                }
                const int t = 16 * ti + r; const float ctv = cumc[t];
                const f32x4 cs0 = *(const LAS f32x4*)(cumc + 16 * sj0 + 4 * q), cs1 = *(const LAS f32x4*)(cumc + 16 * (sj0 + 1) + 4 * q);
                __builtin_amdgcn_sched_barrier(0);
                f32x4 S0 = (f32x4){0.f, 0.f, 0.f, 0.f}, S1 = S0;
#pragma unroll
                for (int kk = 0; kk < 4; ++kk) { S0 = __builtin_amdgcn_mfma_f32_16x16x32_bf16(fb[0][kk], fa[kk], S0, 0, 0, 0); S1 = __builtin_amdgcn_mfma_f32_16x16x32_bf16(fb[1][kk], fa[kk], S1, 0, 0, 0); }
                {
                    float m0[4], m1[4];
#pragma unroll
                    for (int jj = 0; jj < 4; ++jj) {
                        const int s0 = 16 * sj0 + 4 * q + jj, s1 = s0 + 16;
                        m0[jj] = (s0 <= t) ? S0[jj] * __expf(fminf(ctv - cs0[jj], 0.f)) : 0.f;
                        m1[jj] = (s1 <= t) ? S1[jj] * __expf(fminf(ctv - cs1[jj], 0.f)) : 0.f;
                    }
                    u32x2 w0, w1; w0.x = pk2(m0[0], m0[1]); w0.y = pk2(m0[2], m0[3]); w1.x = pk2(m1[0], m1[1]); w1.y = pk2(m1[2], m1[3]);
                    *(LAS u32x2*)(sM + t * LD64 + 16 * sj0 + 4 * q) = w0; *(LAS u32x2*)(sM + t * LD64 + 16 * (sj0 + 1) + 4 * q) = w1;
                }
            }
        }
        if (c0 == 0) {
#pragma unroll
            for (int j = 0; j < 4; ++j) { u32x2 w; w.x = pk2(H[j][0], H[j][1]); w.y = pk2(H[j][2], H[j][3]); *(LAS u32x2*)(sH + (16 * pjs + r) * LD128 + 16 * (ni0 + j) + 4 * q) = w; }
        }
        LBAR();
        {
            const int ti = wave >> 1, pj0 = (wave & 1) * 2;
            const bool yv = 16 * ti < nq;
            bf16x8 sA[4][2], sBf[2];
            f32x4 Y[2];
            Y[0] = (f32x4){0.f, 0.f, 0.f, 0.f}; Y[1] = Y[0];
            if (yv) {
                {
                    bf16x8 aM[2], bX[2][2];
#pragma unroll
                    for (int kk = 0; kk < 2; ++kk) { aM[kk] = *(const LAS bf16x8*)(sM + (16 * ti + r) * LD64 + kk * 32 + q * 8);
                        bX[0][kk] = *(const LAS bf16x8*)(sXdT + SWZ(16 * pj0 + r, kk * 32 + q * 8)); bX[1][kk] = *(const LAS bf16x8*)(sXdT + SWZ(16 * (pj0 + 1) + r, kk * 32 + q * 8)); }
                    __builtin_amdgcn_sched_barrier(0);
#pragma unroll
                    for (int kk = 0; kk < 2; ++kk) { Y[0] = __builtin_amdgcn_mfma_f32_16x16x32_bf16(bX[0][kk], aM[kk], Y[0], 0, 0, 0); Y[1] = __builtin_amdgcn_mfma_f32_16x16x32_bf16(bX[1][kk], aM[kk], Y[1], 0, 0, 0); }
                }
                __builtin_amdgcn_sched_barrier(0);
                {
                    bf16x8 aC[4], bH[2][4];
#pragma unroll
                    for (int kk = 0; kk < 4; ++kk) { aC[kk] = *(const LAS bf16x8*)(sCs + (16 * ti + r) * LD128 + kk * 32 + q * 8);
                        bH[0][kk] = *(const LAS bf16x8*)(sH + (16 * pj0 + r) * LD128 + kk * 32 + q * 8); bH[1][kk] = *(const LAS bf16x8*)(sH + (16 * (pj0 + 1) + r) * LD128 + kk * 32 + q * 8); }
                    __builtin_amdgcn_sched_barrier(0);
#pragma unroll
                    for (int kk = 0; kk < 4; ++kk) { Y[0] = __builtin_amdgcn_mfma_f32_16x16x32_bf16(bH[0][kk], aC[kk], Y[0], 0, 0, 0); Y[1] = __builtin_amdgcn_mfma_f32_16x16x32_bf16(bH[1][kk], aC[kk], Y[1], 0, 0, 0); }
                }
            }
            __builtin_amdgcn_sched_barrier(0);
#pragma unroll
            for (int kk = 0; kk < 2; ++kk) { sBf[kk] = *(const LAS bf16x8*)(sXdT + SWZ(16 * pjs + r, kk * 32 + q * 8));
#pragma unroll
                for (int j = 0; j < 4; ++j) sA[j][kk] = *(const LAS bf16x8*)(sBwT + SWZ(16 * (ni0 + j) + r, kk * 32 + q * 8)); }
            __builtin_amdgcn_sched_barrier(0);
            {
                const float dec = __expf(clast);
#pragma unroll
                for (int j = 0; j < 4; ++j) H[j] = H[j] * dec;
#pragma unroll
                for (int kk = 0; kk < 2; ++kk)
#pragma unroll
                    for (int j = 0; j < 4; ++j) H[j] = __builtin_amdgcn_mfma_f32_16x16x32_bf16(sA[j][kk], sBf[kk], H[j], 0, 0, 0);
            }
            if (yv) {
                const int t = 16 * ti + r;
                float ss = 0.f;
#pragma unroll
                for (int j = 0; j < 2; ++j) {
                    const int p0 = 16 * (pj0 + j) + 4 * q;
                    const u32x2 xw = *(const LAS u32x2*)(sXs + t * LD64 + p0), zw = *(const LAS u32x2*)(sZ + t * LD64 + p0);
                    const float y0 = (Y[j][0] + dsk * bflo(xw.x)) * siluf_(bflo(zw.x)), y1 = (Y[j][1] + dsk * bfhi(xw.x)) * siluf_(bfhi(zw.x));
                    const float y2 = (Y[j][2] + dsk * bflo(xw.y)) * siluf_(bflo(zw.y)), y3 = (Y[j][3] + dsk * bfhi(xw.y)) * siluf_(bfhi(zw.y));
                    ss += (y0 * y0 + y1 * y1) + (y2 * y2 + y3 * y3);
                    u32x2 w; w.x = pk2(y0, y1); w.y = pk2(y2, y3);
                    *(LAS u32x2*)(sZ + t * LD64 + p0) = w;
                }
                ss += shx(ss, 16, lane); ss += shx(ss, 32, lane);
                if (q == 0 && t < nq) (void)__hip_atomic_fetch_add(sssq + t, ss, __ATOMIC_RELAXED, __HIP_MEMORY_SCOPE_WORKGROUP);
            }
        }
        LBAR();
#pragma unroll
        for (int j = 0; j < 4; ++j) { u32x2 w; w.x = pk2(H[j][0], H[j][1]); w.y = pk2(H[j][2], H[j][3]); *(LAS u32x2*)(sH + (16 * pjs + r) * LD128 + 16 * (ni0 + j) + 4 * q) = w; }
        if (zt < nq) *(u32x4*)(L_YN + (size_t)(r0 + c0 + zt) * DINNER + h * 64 + zv * 8) = *(const LAS u32x4*)(sZ + zt * LD64 + zv * 8);
        if (tid < 64) { if (tid < nq) L_SSQ[(size_t)(r0 + c0 + tid) * 32 + h] = sssq[tid]; sssq[tid] = 0.f; }
        __builtin_amdgcn_sched_barrier(0);
    }
    float* so = L_out + (sample ? O_SSSM + ((size_t)(l * DB + b) * NH + h) * (HD * NST) : O_PSSM + ((size_t)(l * NBATCH + b) * NH + h) * (HD * NST));
#pragma unroll
    for (int j = 0; j < 4; ++j) *(f32x4*)(so + (16 * pjs + r) * NST + 16 * (ni0 + j) + 4 * q) = H[j];
    if (!has_next) break;
    u = un; SSD_UNIT(u, sample, b, h, r0, ntok, xoff, zoff, boff);
  }
    LBAR();
}

constexpr int SMP_WAVE_LDS = 14592;
__device__ __forceinline__ void ssd_sample(const Ctx& C_, LAS unsigned char* lds_in, int l) {
    const Ctx C = get_ids(C_.wave);
    LAS unsigned char* lds = lds_in; asm volatile("" : "+s"(lds));
    KP kp = kparams(); unsigned char* ws = kp->ws;
    const float* const L_state_ssm = kp->in[4];
    float* const L_out = kp->out;
    const bf16_t* const L_PROJ = (const bf16_t*)(ws + WS_PROJ);
    const bf16_t* const L_XBCC = (const bf16_t*)(ws + WS_XBCC);
    bf16_t* const L_YN = (bf16_t*)(ws + WS_YN);
    const float* const L_DTS = (const float*)(ws + WS_DTS);
    float* const L_SSQ = (float*)(ws + WS_SSQ);
    const float* const L_a_log = kp->in[15] + l * NH; const float* const L_d_skip = kp->in[16] + l * NH;
    const int lane = C.lane, wave = C.wave, r = lane & 15, q = lane >> 4;
    LAS float* sBf = (LAS float*)(lds + wave * SMP_WAVE_LDS); LAS float* sCf = sBf + 1024; LAS float* sXf = sBf + 2048; LAS float* sZf = sBf + 2560; LAS float* sY2 = sBf + 3072;
    LAS float* sdt = sBf + 3584; LAS float* sdA = sBf + 3592;
    for (int k = C.bid * NWAVES + wave; k < DB * NH; k += C.G * NWAVES) {
        const int b = k / NH, h = k - b * NH, g = h >> 3, r0 = MPROMPT + b * DS;
        const float a_h = -__expf(L_a_log[h]), dsk = L_d_skip[h];
        int ln = lane; asm volatile("" : "+v"(ln));
#pragma unroll 1
        for (int i = 0; i < 5; ++i) {
            const int idx = ln + 64 * i, t = idx / 40, v = idx - t * 40;
            int ch; LAS float* dst;
            if (v < 8) { ch = h * 64 + v * 8; dst = sXf + t * 64 + v * 8; } else if (v < 24) { ch = 2048 + g * 128 + (v - 8) * 8; dst = sBf + t * 128 + (v - 8) * 8; } else { ch = 2560 + g * 128 + (v - 24) * 8; dst = sCf + t * 128 + (v - 24) * 8; }
            const u32x4 w = *(const u32x4*)(L_XBCC + (size_t)(r0 + t) * CONVD + ch); float o[8]; unpack8(w, o);
            *(LAS f32x4*)dst = (f32x4){o[0], o[1], o[2], o[3]}; *(LAS f32x4*)(dst + 4) = (f32x4){o[4], o[5], o[6], o[7]};
        }
        { const int t = ln >> 3, v = ln & 7;
            const u32x4 w = *(const u32x4*)(L_PROJ + (size_t)(r0 + t) * NPROJ + PC_Z + h * 64 + v * 8); float o[8]; unpack8(w, o);
            *(LAS f32x4*)(sZf + t * 64 + v * 8) = (f32x4){o[0], o[1], o[2], o[3]}; *(LAS f32x4*)(sZf + t * 64 + v * 8 + 4) = (f32x4){o[4], o[5], o[6], o[7]}; }
        if (ln < 8) { const float dtv = L_DTS[(size_t)h * MP + r0 + ln]; sdt[ln] = dtv; sdA[ln] = __expf(dtv * a_h); }
        const float* h0 = L_state_ssm + ((size_t)(l * DB + b) * NH + h) * (HD * NST);
        f32x4 hs[4][4][2];
        unsigned hoff = (unsigned)(r * NST + 8 * q); asm volatile("" : "+v"(hoff));
#pragma unroll
        for (int pj = 0; pj < 4; ++pj)
#pragma unroll
            for (int kk = 0; kk < 4; ++kk) { const float* p = h0 + hoff + (16 * pj * NST + 32 * kk); hs[pj][kk][0] = *(const f32x4*)p; hs[pj][kk][1] = *(const f32x4*)(p + 4); }
        LDS_WAIT(); asm volatile("" ::: "memory");
#pragma unroll 1
        for (int t = 0; t < DS; ++t) {
            const float dt = sdt[t], dA = sdA[t];
            float xd[4], y[4];
#pragma unroll
            for (int pj = 0; pj < 4; ++pj) { xd[pj] = sXf[t * 64 + 16 * pj + r] * dt; y[pj] = 0.f; }
#pragma unroll
            for (int kk = 0; kk < 4; ++kk) {
                const f32x4 B0 = *(const LAS f32x4*)(sBf + t * 128 + 32 * kk + 8 * q), B1 = *(const LAS f32x4*)(sBf + t * 128 + 32 * kk + 8 * q + 4);
                const f32x4 C0 = *(const LAS f32x4*)(sCf + t * 128 + 32 * kk + 8 * q), C1 = *(const LAS f32x4*)(sCf + t * 128 + 32 * kk + 8 * q + 4);
#pragma unroll
                for (int pj = 0; pj < 4; ++pj) {
                    f32x4 h0v = hs[pj][kk][0] * dA + B0 * xd[pj], h1v = hs[pj][kk][1] * dA + B1 * xd[pj];
                    hs[pj][kk][0] = h0v; hs[pj][kk][1] = h1v;
                    const f32x4 m0 = C0 * h0v, m1 = C1 * h1v;
                    y[pj] += ((m0.x + m0.y) + (m0.z + m0.w)) + ((m1.x + m1.y) + (m1.z + m1.w));
                }
            }
#pragma unroll
            for (int pj = 0; pj < 4; ++pj) { y[pj] += shx(y[pj], 16, lane); y[pj] += shx(y[pj], 32, lane); }
            const float yv = q == 0 ? y[0] : (q == 1 ? y[1] : (q == 2 ? y[2] : y[3]));
            const float yg = (yv + dsk * sXf[t * 64 + lane]) * siluf_(sZf[t * 64 + lane]);
            L_YN[(size_t)(r0 + t) * DINNER + h * 64 + lane] = (bf16_t)f2bf(yg);
            sY2[t * 64 + lane] = yg * yg;
        }
        LDS_WAIT(); asm volatile("" ::: "memory");
        {
            const LAS float* p = sY2 + (lane >> 3) * 64 + (lane & 7) * 8;
            const f32x4 a = *(const LAS f32x4*)p, c = *(const LAS f32x4*)(p + 4);
            float ss = ((a.x + a.y) + (a.z + a.w)) + ((c.x + c.y) + (c.z + c.w));
            ss += shx(ss, 1, lane); ss += shx(ss, 2, lane); ss += shx(ss, 4, lane);
            if ((lane & 7) == 0) L_SSQ[(size_t)(r0 + (lane >> 3)) * 32 + h] = ss;
        }
        float* so = L_out + O_SSSM + ((size_t)(l * DB + b) * NH + h) * (HD * NST);
#pragma unroll
        for (int pj = 0; pj < 4; ++pj)
#pragma unroll
            for (int kk = 0; kk < 4; ++kk) { float* p = so + hoff + (16 * pj * NST + 32 * kk); *(f32x4*)p = hs[pj][kk][0]; *(f32x4*)(p + 4) = hs[pj][kk][1]; }
        LDS_WAIT(); asm volatile("" ::: "memory");
    }
}

__device__ __forceinline__ void row_bf16_to_f32(const bf16_t* src, float* dst, int ncol, int lane) {
    for (int v = lane; v < ncol / 8; v += 64) { const u32x4 w = *(const u32x4*)(src + v * 8); float o[8]; unpack8(w, o);
        *(f32x4*)(dst + v * 8) = (f32x4){o[0], o[1], o[2], o[3]}; *(f32x4*)(dst + v * 8 + 4) = (f32x4){o[4], o[5], o[6], o[7]}; }
}
__device__ __forceinline__ void row_f32_copy(const float* src, float* dst, int ncol, int lane) {
    for (int v = lane; v < ncol / 4; v += 64) *(f32x4*)(dst + v * 4) = *(const f32x4*)(src + v * 4);
}

template <int MAXW>
__device__ __forceinline__ void pool_load(const bf16_t* PROJ, const float* state_pool, int l, int m, bool sample, int b, int t, int ch, int win, u32x4 (&rw)[MAXW]) {
#pragma unroll
    for (int j = 0; j < MAXW; ++j) { const bool need = (j < win) && (t - j >= 0);
        const u32x4 rv = *(const u32x4*)(PROJ + (size_t)(m - (need ? j : 0)) * NPROJ + PC_U + ch);
        rw[j] = need ? rv : (u32x4){0u, 0u, 0u, 0u}; }
    if (sample && t < win - 1) {
#pragma unroll
        for (int j = 1; j < MAXW; ++j) if (j < win && t - j < 0) {
            const float* pp = state_pool + ((size_t)(l * DB + b) * 15 + (15 + t - j)) * 1024 + ch; rw[j] = pack8v(*(const f32x4*)pp, *(const f32x4*)(pp + 4)); }
    }
}
template <int MAXW>
__device__ __forceinline__ void pool_finish(bf16_t* DBUF, int m, bool sample, int t, int ch, int win, const u32x4 (&rw)[MAXW]) {
    float acc[8], u0[8];
    unpack8(rw[0], u0);
#pragma unroll
    for (int e = 0; e < 8; ++e) acc[e] = u0[e];
#pragma unroll
    for (int j = 1; j < MAXW; ++j) { float xv[8]; unpack8(rw[j], xv);
#pragma unroll
        for (int e = 0; e < 8; ++e) acc[e] += xv[e]; }
    const int cnt = sample ? win : ((t + 1) < win ? (t + 1) : win);
    const float inv = 1.0f / (float)cnt;
    float d[8];
#pragma unroll
    for (int e = 0; e < 8; ++e) d[e] = acc[e] * inv - u0[e];
    *(u32x4*)(DBUF + (size_t)m * 1024 + ch) = pack8(d);
}

__device__ __forceinline__ void mixer_elementwise(const Ctx& C_, int l) {
    const Ctx C = get_ids(C_.wave);
    KP kp = kparams(); unsigned char* ws = kp->ws;
    const float* const L_state_pool = kp->in[2];
    float* const L_out = kp->out;
    const bf16_t* const L_PROJ = (const bf16_t*)(ws + WS_PROJ);
    bf16_t* const L_DBUF = (bf16_t*)(ws + WS_DBUF);
    const int gw = C.bid * NWAVES + C.wave, NGW = C.G * NWAVES, lane = C.lane;
    for (int m = gw; m < MREAL; m += NGW) {
        const bool sample = m >= MPROMPT;
        int b, t; if (sample) { b = (m - MPROMPT) / DS; t = (m - MPROMPT) - b * DS; } else { b = m / LP; t = m - b * LP; }
        const int chA = lane * 8, chB = (lane + 64) * 8, winA = 2 << (chA >> 8), winB = 2 << (chB >> 8);
        u32x4 rwA[4], rwB[16];
        pool_load<4>(L_PROJ, L_state_pool, l, m, sample, b, t, chA, winA, rwA);
        pool_load<16>(L_PROJ, L_state_pool, l, m, sample, b, t, chB, winB, rwB);
        pool_finish<4>(L_DBUF, m, sample, t, chA, winA, rwA);
        pool_finish<16>(L_DBUF, m, sample, t, chB, winB, rwB);
    }
    for (int it = gw; it < (NBATCH + DB) * 15; it += NGW) {
        if (it < NBATCH * 15) { const int b = it / 15, i = it - b * 15;
            row_bf16_to_f32(L_PROJ + (size_t)(b * LP + LP - 15 + i) * NPROJ + PC_U, L_out + O_PPOOL + ((size_t)(l * NBATCH + b) * 15 + i) * 1024, 1024, lane);
        } else { const int k = it - NBATCH * 15, b = k / 15, i = k - b * 15;
            float* dst = L_out + O_SPOOL + ((size_t)(l * DB + b) * 15 + i) * 1024;
            if (i < 7) row_f32_copy(L_state_pool + ((size_t)(l * DB + b) * 15 + 8 + i) * 1024, dst, 1024, lane);
            else row_bf16_to_f32(L_PROJ + (size_t)(MPROMPT + b * DS + (i - 7)) * NPROJ + PC_U, dst, 1024, lane); }
    }
    for (int it = gw; it < (NBATCH + DB) * 3; it += NGW) {
        if (it < NBATCH * 3) { const int b = it / 3, i = it - b * 3;
            row_bf16_to_f32(L_PROJ + (size_t)(b * LP + LP - 3 + i) * NPROJ + PC_XBC, L_out + O_PCONV + ((size_t)(l * NBATCH + b) * 3 + i) * CONVD, CONVD, lane);
        } else { const int k = it - NBATCH * 3, b = k / 3, i = k - b * 3;
            row_bf16_to_f32(L_PROJ + (size_t)(MPROMPT + b * DS + 5 + i) * NPROJ + PC_XBC, L_out + O_SCONV + ((size_t)(l * DB + b) * 3 + i) * CONVD, CONVD, lane); }
    }
}

__device__ __forceinline__ void yn_normalize(const Ctx& C_) {
    const Ctx C = get_ids(C_.wave);
    KP kp = kparams(); unsigned char* ws = kp->ws; (void)ws;
    bf16_t* const L_YN = (bf16_t*)(ws + WS_YN);
    float* const L_SSQ = (float*)(ws + WS_SSQ);
    const int gw = C.bid * NWAVES + C.wave, NGW = C.G * NWAVES, lane = C.lane;
    for (int m = gw; m < MREAL; m += NGW) {
        const f32x4* sp = (const f32x4*)(L_SSQ + (size_t)m * 32);
        float rs[4];
#pragma unroll
        for (int gi = 0; gi < 4; ++gi) { const f32x4 a = sp[2 * gi], b = sp[2 * gi + 1]; rs[gi] = rsqrtf((((a.x + a.y) + (a.z + a.w)) + ((b.x + b.y) + (b.z + b.w))) * (1.0f / 512.0f) + EPS); }
        u32x4 rawv[4];
#pragma unroll
        for (int i = 0; i < 4; ++i) rawv[i] = *(const u32x4*)(L_YN + (size_t)m * DINNER + (lane + 64 * i) * 8);
#pragma unroll
        for (int i = 0; i < 4; ++i) {
            const int v = lane + 64 * i;
            float o[8]; unpack8(rawv[i], o);
            const float s = rs[i];
#pragma unroll
            for (int e = 0; e < 8; ++e) o[e] *= s;
            *(u32x4*)(L_YN + (size_t)m * DINNER + v * 8) = pack8(o);
        }
    }
}

__device__ __forceinline__ void ffn_half(const bf16_t* UP, const float* state_ffn, const float* fw, const float* fb, int l, int m0, int t0, bool sample, int b, int col, float (&res)[8][8]) {
    u32x4 raw[10];
#pragma unroll
    for (int i = 0; i < 10; ++i) raw[i] = *(const u32x4*)(UP + (size_t)(m0 + ((t0 + i - 2 >= 0) ? i - 2 : 0)) * DUP + col);
    if (t0 < 2) {
#pragma unroll
        for (int i = 0; i < 2; ++i) if (t0 + i - 2 < 0) {
            u32x4 rv = (u32x4){0u, 0u, 0u, 0u};
            if (sample) { const float* pp = state_ffn + ((size_t)(l * DB + b) * 2 + i) * DUP + col; rv = pack8v(*(const f32x4*)pp, *(const f32x4*)(pp + 4)); }
            raw[i] = rv; }
    }
    f32x4 w[3][2], bs[2];
#pragma unroll
    for (int k = 0; k < 3; ++k) { w[k][0] = *(const f32x4*)(fw + (size_t)k * DUP + col); w[k][1] = *(const f32x4*)(fw + (size_t)k * DUP + col + 4); }
    bs[0] = *(const f32x4*)(fb + col); bs[1] = *(const f32x4*)(fb + col + 4);
#pragma unroll
    for (int j = 0; j < 8; ++j) { res[j][0] = bs[0].x; res[j][1] = bs[0].y; res[j][2] = bs[0].z; res[j][3] = bs[0].w; res[j][4] = bs[1].x; res[j][5] = bs[1].y; res[j][6] = bs[1].z; res[j][7] = bs[1].w; }
#pragma unroll
    for (int i = 0; i < 10; ++i) {
        float xv[8]; unpack8(raw[i], xv);
#pragma unroll
        for (int k = 0; k < 3; ++k) { const int j = i - k;
            if (j >= 0 && j < 8) {
                res[j][0] += w[k][0].x * xv[0]; res[j][1] += w[k][0].y * xv[1]; res[j][2] += w[k][0].z * xv[2]; res[j][3] += w[k][0].w * xv[3];
                res[j][4] += w[k][1].x * xv[4]; res[j][5] += w[k][1].y * xv[5]; res[j][6] += w[k][1].z * xv[6]; res[j][7] += w[k][1].w * xv[7]; } }
    }
}

__device__ __forceinline__ void ffn_elementwise(const Ctx& C_, int l) {
    const Ctx C = get_ids(C_.wave);
    KP kp = kparams(); unsigned char* ws = kp->ws;
    const float* const L_state_ffn = kp->in[5];
    float* const L_out = kp->out;
    const bf16_t* const L_UP = (const bf16_t*)(ws + WS_UP);
    bf16_t* const L_ACT = (bf16_t*)(ws + WS_ACT);
    const float* fw = kp->in[22] + (size_t)l * 3 * DUP; const float* fb = kp->in[23] + (size_t)l * DUP;
    const int gtid = C.bid * NTHREADS + C.tid, NT = C.G * NTHREADS;
    constexpr int NV = DFF / 8, NSTRIP = MREAL / 8;
    for (int it = gtid; it < NSTRIP * NV; it += NT) {
        const int strip = it / NV, v = it - strip * NV, m0 = strip * 8;
        const bool sample = m0 >= MPROMPT;
        const int t0 = sample ? 0 : (m0 % LP), b = sample ? (m0 - MPROMPT) / DS : 0;
        float gate[8][8], val[8][8];
        ffn_half(L_UP, L_state_ffn, fw, fb, l, m0, t0, sample, b, v * 8, gate);
#pragma unroll
        for (int j = 0; j < 8; ++j)
#pragma unroll
            for (int e = 0; e < 8; ++e) gate[j][e] = siluf_(gate[j][e]);
        ffn_half(L_UP, L_state_ffn, fw, fb, l, m0, t0, sample, b, DFF + v * 8, val);
#pragma unroll
        for (int j = 0; j < 8; ++j) { float a[8];
#pragma unroll
            for (int e = 0; e < 8; ++e) a[e] = gate[j][e] * val[j][e];
            *(u32x4*)(L_ACT + (size_t)(m0 + j) * DFF + v * 8) = pack8(a); }
    }
    const int gw = C.bid * NWAVES + C.wave, NGW = C.G * NWAVES, lane = C.lane;
    for (int it = gw; it < (NBATCH + DB) * 2; it += NGW) {
        if (it < NBATCH * 2) { const int b = it / 2, i = it - b * 2;
            row_bf16_to_f32(L_UP + (size_t)(b * LP + LP - 2 + i) * DUP, L_out + O_PFFN + ((size_t)(l * NBATCH + b) * 2 + i) * DUP, DUP, lane);
        } else { const int k = it - NBATCH * 2, b = k / 2, i = k - b * 2;
            row_bf16_to_f32(L_UP + (size_t)(MPROMPT + b * DS + 6 + i) * DUP, L_out + O_SFFN + ((size_t)(l * DB + b) * 2 + i) * DUP, DUP, lane); }
    }
}

__device__ __forceinline__ void final_norm(const Ctx& C_) {
    const Ctx C = get_ids(C_.wave);
    KP kp = kparams(); unsigned char* ws = kp->ws; (void)ws;
    const float* const L_final_norm_w = kp->in[25];
    float* const L_X = (float*)(ws + WS_X);
    float* const L_RSS = (float*)(ws + WS_RSS);
    float* const L_out = kp->out;
    const int gw = C.bid * NWAVES + C.wave, NGW = C.G * NWAVES, lane = C.lane;
    for (int m = gw; m < MREAL; m += NGW) {
        float* dst;
        if (m < MPROMPT) { const int b = m / LP, t = m - b * LP; if (t < NMETA) continue; dst = L_out + O_YP + ((size_t)b * SEQ + (t - NMETA)) * DM; }
        else dst = L_out + O_YS + (size_t)(m - MPROMPT) * DM;
        const f32x4* p = (const f32x4*)(L_RSS + (size_t)m * 16); const f32x4 a = p[0], b4 = p[1], c = p[2], d = p[3];
        const float s = ((a.x + a.y) + (a.z + a.w)) + ((b4.x + b4.y) + (b4.z + b4.w)) + ((c.x + c.y) + (c.z + c.w)) + ((d.x + d.y) + (d.z + d.w));
        const float rstd = rsqrtf(s * (1.0f / 1024.0f) + EPS);
#pragma unroll
        for (int j = 0; j < 4; ++j) { const f32x4 x = ((const f32x4*)(L_X + (size_t)m * DM))[lane + 64 * j], w = ((const f32x4*)L_final_norm_w)[lane + 64 * j];
            ((f32x4*)dst)[lane + 64 * j] = x * rstd * w; }
    }
}

__global__ void __launch_bounds__(NTHREADS, 2) hybrid_fwd(Params P) {
    extern __shared__ __attribute__((aligned(16))) unsigned char lds_raw[];
    LAS unsigned char* lds = (LAS unsigned char*)lds_raw;
    Ctx C;
    {
        const int t0 = threadIdx.x;
        C.tid = t0; C.lane = t0 & 63; C.wave = __builtin_amdgcn_readfirstlane(t0 >> 6); C.G = gridDim.x; C.bid = blockIdx.x;
        if (t0 < 4) ((LAS unsigned*)(lds + LDS_ST_OFF))[t0] = 0u;
        if (t0 == 0) { KP kp0 = kparams(); (void)xb_add((unsigned*)(kp0->ws + WS_CTL) + XB_XCNT(xb_xcc_id()), 1u); }
        __syncthreads();
        cg::this_grid().sync();
    }
#define LG_(x) ({ int v_ = (x); asm volatile("" : "+s"(v_)); v_; })
#define GRID_SYNC() do { KP kpb_ = kparams(); grid_barrier(kpb_->ws, lds, C.wave); } while (0)
    prologue(C, lds);
    GRID_SYNC();

    for (int l = 0; l < DEPTH; ++l) {
        { KP kp = kparams(); unsigned char* ws = kp->ws; pg8::StaticOrder S;
          pg8::Gemm g{WSP(bf16_t, WS_XB), WSP(bf16_t, WS_W1T) + (size_t)l * NPROJ * 1024, 1024, 1024, 1024, 0}; S.init(MP, NPROJ, LG_(C.G), LG_(C.bid));
          pg8::EpiScale E{WSP(bf16_t, WS_PROJ), NPROJ, WSP(float, WS_RSS), WSP(float, WS_DT), PC_DT / 256};
          pg8::gemm_phase(lds, C.wave, g, S, E); }
        GRID_SYNC();
        conv_pass(C, l);
        mixer_elementwise(C, l);
        GRID_SYNC();
        ssd_phase(C, lds, l);
        ssd_sample(C, lds, l);
        __syncthreads();
        { KP kp = kparams(); unsigned char* ws = kp->ws; pg8::StaticOrder S;
          pg8::Gemm g{WSP(bf16_t, WS_DBUF), WSP(bf16_t, WS_PWT) + (size_t)l * 1024 * 256, 1024, 256, 256, 256}; S.init(MP, 1024, LG_(C.G), LG_(C.bid));
          pg8::EpiScale E{WSP(bf16_t, WS_POOLED), 1024, nullptr, nullptr, -1};
          pg8::gemm_phase(lds, C.wave, g, S, E); }
        GRID_SYNC();
        yn_normalize(C);
        { KP kp = kparams(); unsigned char* ws = kp->ws; pg8::StaticOrder S;
          pg8::Gemm g{WSP(bf16_t, WS_POOLED), WSP(bf16_t, WS_WPOT) + (size_t)l * 1024 * 1024, 1024, 1024, 1024, 0}; S.init(pg8::MTAIL0, 1024, LG_(C.G), LG_(C.bid));
          pg8::EpiGate<0> E{WSP(bf16_t, WS_MERGED), 1024, WSP(bf16_t, WS_PROJ) + PC_GA, NPROJ};
          pg8::gemm_phase(lds, C.wave, g, S, E); pg8::gemm_tail(lds, C.wave, g, E); }
        GRID_SYNC();
        { KP kp = kparams(); unsigned char* ws = kp->ws; pg8::StaticOrder S;
          pg8::Gemm g{WSP(bf16_t, WS_YN), WSP(bf16_t, WS_WSOT) + (size_t)l * 1024 * 2048, 2048, 2048, 2048, 0}; S.init(pg8::MTAIL0, 1024, LG_(C.G), LG_(C.bid));
          pg8::EpiGate<1> E{WSP(bf16_t, WS_MERGED), 1024, WSP(bf16_t, WS_PROJ) + PC_GB, NPROJ};
          pg8::gemm_phase(lds, C.wave, g, S, E); pg8::gemm_tail(lds, C.wave, g, E); }
        GRID_SYNC();
        { KP kp = kparams(); unsigned char* ws = kp->ws; pg8::StaticOrder S;
          pg8::Gemm g{WSP(bf16_t, WS_MERGED), WSP(bf16_t, WS_WOT) + (size_t)l * 1024 * 1024, 1024, 1024, 1024, 0}; S.init(pg8::MTAIL0, 1024, LG_(C.G), LG_(C.bid));
          pg8::EpiResid E{WSP(float, WS_X), WSP(bf16_t, WS_XB), WSP(float, WS_RSS)};
          pg8::gemm_phase(lds, C.wave, g, S, E); pg8::gemm_tail(lds, C.wave, g, E); }
        GRID_SYNC();
        { KP kp = kparams(); unsigned char* ws = kp->ws; pg8::StaticOrder S;
          pg8::Gemm g{WSP(bf16_t, WS_XB), WSP(bf16_t, WS_WUPT) + (size_t)l * DUP * 1024, 1024, 1024, 1024, 0}; S.init(MP, DUP, LG_(C.G), LG_(C.bid));
          pg8::EpiScale E{WSP(bf16_t, WS_UP), DUP, WSP(float, WS_RSS), nullptr, -1};
          pg8::gemm_phase(lds, C.wave, g, S, E); }
        GRID_SYNC();
        ffn_elementwise(C, l);
        GRID_SYNC();
        { KP kp = kparams(); unsigned char* ws = kp->ws; pg8::StaticOrder S;
          pg8::Gemm g{WSP(bf16_t, WS_ACT), WSP(bf16_t, WS_WDT) + (size_t)l * 1024 * DFF, DFF, DFF, DFF, 0}; S.init(pg8::MTAIL0, 1024, LG_(C.G), LG_(C.bid));
          pg8::EpiResid E{WSP(float, WS_X), WSP(bf16_t, WS_XB), WSP(float, WS_RSS)};
          pg8::gemm_phase(lds, C.wave, g, S, E); pg8::gemm_tail(lds, C.wave, g, E); }
        GRID_SYNC();
    }
    final_norm(C);
}

extern "C" void kernel_launch(void* const* d_in, const int* in_sizes, int n_in, void* d_out, int out_size, void* d_ws, size_t ws_size, hipStream_t stream) {
    static int grid_blocks = 0;
    if (grid_blocks == 0) {
        if (n_in != 26 || (size_t)out_size != O_END || ws_size < WS_END) {
            fprintf(stderr, "kernel_launch: unexpected shapes: n_in %d out %d (want %zu) ws %zu (want %zu)\n", n_in, out_size, (size_t)O_END, ws_size, (size_t)WS_END); grid_blocks = -1; return; }
        int dev = 0, cus = 0, per_cu = 0;
        hipGetDevice(&dev);
        hipDeviceGetAttribute(&cus, hipDeviceAttributeMultiprocessorCount, dev);
        if (hipFuncSetAttribute((const void*)hybrid_fwd, hipFuncAttributeMaxDynamicSharedMemorySize, LDS_BYTES) != hipSuccess) { fprintf(stderr, "kernel_launch: hipFuncSetAttribute failed\n"); grid_blocks = -1; return; }
        if (hipOccupancyMaxActiveBlocksPerMultiprocessor(&per_cu, (const void*)hybrid_fwd, NTHREADS, LDS_BYTES) != hipSuccess || per_cu < 1) { fprintf(stderr, "kernel_launch: occupancy query gave %d\n", per_cu); per_cu = 1; }
        (void)hipGetLastError();
        grid_blocks = cus * per_cu;
    }
    if (grid_blocks < 0) return;
    if (hipMemsetAsync((char*)d_ws + WS_CTL, 0, WS_CTL_BYTES, stream) != hipSuccess) { fprintf(stderr, "kernel_launch: memset of barrier words failed\n"); return; }
    Params p{};
    for (int i = 0; i < 26; ++i) p.in[i] = (const float*)d_in[i];
    p.out = (float*)d_out; p.ws = (unsigned char*)d_ws;
    void* args[] = {&p};
    hipError_t e = hipLaunchCooperativeKernel((const void*)hybrid_fwd, dim3(grid_blocks), dim3(NTHREADS), args, LDS_BYTES, stream);
    if (e != hipSuccess) fprintf(stderr, "cooperative launch failed: %s (grid %d)\n", hipGetErrorString(e), grid_blocks);
}
```

```cpp
#include <hip/hip_runtime.h>
#include <hip/hip_cooperative_groups.h>
#include <cstdio>
#include <cstdint>
namespace cg = cooperative_groups;

#define LAS __attribute__((address_space(3)))
typedef unsigned short bf16_t;
typedef short bf16x8 __attribute__((ext_vector_type(8)));
typedef float f32x4 __attribute__((ext_vector_type(4)));
typedef unsigned u32x4 __attribute__((ext_vector_type(4)));
typedef unsigned u32x2 __attribute__((ext_vector_type(2)));

constexpr int DM = 1024, NBATCH = 8, SEQ = 2048, NMETA = 16, LP = SEQ + NMETA, DEPTH = 4, DB = 128, DS = 8;
constexpr int MPROMPT = NBATCH * LP;
constexpr int MREAL = MPROMPT + DB * DS;
constexpr int MP = 17664;
constexpr int NH = 32, HD = 64, NG = 4, NST = 128, CONVD = 3072, DFF = 2816, DUP = 5632, DINNER = 2048;
constexpr int NPROJ = 8448;
constexpr int PC_U = 0, PC_Z = 1024, PC_XBC = 3072, PC_GA = 6144, PC_GB = 7168, PC_DT = 8192;
constexpr float EPS = 1e-6f;
constexpr int NTHREADS = 512, NWAVES = 8;
constexpr int LDS_BYTES = 147456;
constexpr int LDS_ST_OFF = LDS_BYTES - 16;

constexpr size_t al256(size_t x) { return (x + 255) & ~(size_t)255; }
constexpr size_t WS_W1T = 0;
constexpr size_t WS_PWT = WS_W1T + al256((size_t)DEPTH * NPROJ * 1024 * 2);
constexpr size_t WS_WPOT = WS_PWT + al256((size_t)DEPTH * 1024 * 256 * 2);
constexpr size_t WS_WSOT = WS_WPOT + al256((size_t)DEPTH * 1024 * 1024 * 2);
constexpr size_t WS_WOT = WS_WSOT + al256((size_t)DEPTH * 1024 * 2048 * 2);
constexpr size_t WS_WUPT = WS_WOT + al256((size_t)DEPTH * 1024 * 1024 * 2);
constexpr size_t WS_WDT = WS_WUPT + al256((size_t)DEPTH * DUP * 1024 * 2);
constexpr size_t WS_X = WS_WDT + al256((size_t)DEPTH * 1024 * DFF * 2);
constexpr size_t WS_XB = WS_X + al256((size_t)MP * 1024 * 4);
constexpr size_t WS_RSS = WS_XB + al256((size_t)MP * 1024 * 2);
constexpr size_t WS_PROJ = WS_RSS + al256((size_t)MP * 16 * 4);
constexpr size_t WS_DT = WS_PROJ + al256((size_t)MP * NPROJ * 2);
constexpr size_t WS_DBUF = WS_DT + al256((size_t)MP * 32 * 4);
constexpr size_t WS_POOLED = WS_DBUF + al256((size_t)MP * 1024 * 2);
constexpr size_t WS_YN = WS_POOLED + al256((size_t)MP * 1024 * 2);
constexpr size_t WS_SSQ = WS_YN + al256((size_t)MP * 2048 * 2);
constexpr size_t WS_MERGED = WS_SSQ + al256((size_t)MP * 32 * 4);
constexpr size_t WS_UP = WS_MERGED + al256((size_t)MP * 1024 * 2);
constexpr size_t WS_ACT = WS_UP + al256((size_t)MP * DUP * 2);
constexpr size_t WS_XBCC = WS_ACT + al256((size_t)MP * DFF * 2);
constexpr size_t WS_DTS = WS_XBCC + al256((size_t)MP * CONVD * 2);
constexpr size_t WS_CTL = WS_DTS + al256((size_t)MP * 32 * 4);
constexpr size_t WS_CTL_BYTES = 16384;
constexpr size_t WS_END = WS_CTL + WS_CTL_BYTES;

constexpr size_t O_YP = 0;
constexpr size_t O_YS = O_YP + (size_t)NBATCH * SEQ * DM;
constexpr size_t O_PPOOL = O_YS + (size_t)DB * DS * DM;
constexpr size_t O_PCONV = O_PPOOL + (size_t)DEPTH * NBATCH * 15 * 1024;
constexpr size_t O_PSSM = O_PCONV + (size_t)DEPTH * NBATCH * 3 * CONVD;
constexpr size_t O_PFFN = O_PSSM + (size_t)DEPTH * NBATCH * NH * HD * NST;
constexpr size_t O_SPOOL = O_PFFN + (size_t)DEPTH * NBATCH * 2 * DUP;
constexpr size_t O_SCONV = O_SPOOL + (size_t)DEPTH * DB * 15 * 1024;
constexpr size_t O_SSSM = O_SCONV + (size_t)DEPTH * DB * 3 * CONVD;
constexpr size_t O_SFFN = O_SSSM + (size_t)DEPTH * DB * NH * HD * NST;
constexpr size_t O_END = O_SFFN + (size_t)DEPTH * DB * 2 * DUP;

__device__ __forceinline__ unsigned cvt_pk_bf16(float lo, float hi) { unsigned r; asm("v_cvt_pk_bf16_f32 %0, %1, %2" : "=v"(r) : "v"(lo), "v"(hi)); return r; }
__device__ __forceinline__ unsigned f2bf(float f) { return cvt_pk_bf16(f, f) & 0xffffu; }
__device__ __forceinline__ unsigned pk2(float lo, float hi) { return cvt_pk_bf16(lo, hi); }
__device__ __forceinline__ float bflo(unsigned w) { return __builtin_bit_cast(float, w << 16); }
__device__ __forceinline__ float bfhi(unsigned w) { return __builtin_bit_cast(float, w & 0xffff0000u); }
__device__ __forceinline__ float bf1(bf16_t h) { return __builtin_bit_cast(float, ((unsigned)h) << 16); }
__device__ __forceinline__ float sigmoidf_(float x) { return __builtin_amdgcn_rcpf(1.0f + __expf(-x)); }
__device__ __forceinline__ float siluf_(float x) { return x * sigmoidf_(x); }
__device__ __forceinline__ void unpack8(const u32x4 w, float (&o)[8]) {
    o[0] = bflo(w.x); o[1] = bfhi(w.x); o[2] = bflo(w.y); o[3] = bfhi(w.y); o[4] = bflo(w.z); o[5] = bfhi(w.z); o[6] = bflo(w.w); o[7] = bfhi(w.w);
}
__device__ __forceinline__ u32x4 pack8(const float (&o)[8]) {
    u32x4 w; w.x = pk2(o[0], o[1]); w.y = pk2(o[2], o[3]); w.z = pk2(o[4], o[5]); w.w = pk2(o[6], o[7]); return w;
}
__device__ __forceinline__ float shx(float v, int m, int lane) { return __builtin_bit_cast(float, __builtin_amdgcn_ds_bpermute((lane ^ m) << 2, __builtin_bit_cast(int, v))); }
__device__ __forceinline__ float shup(float v, int d, int lane) { return __builtin_bit_cast(float, __builtin_amdgcn_ds_bpermute((lane - d) << 2, __builtin_bit_cast(int, v))); }
__device__ __forceinline__ float shidx(float v, int src) { return __builtin_bit_cast(float, __builtin_amdgcn_ds_bpermute(src << 2, __builtin_bit_cast(int, v))); }
__device__ __forceinline__ float wave_sum(float v) {
#pragma unroll
    for (int o = 1; o < 64; o <<= 1) v += __shfl_xor(v, o);
    return v;
}
__device__ __forceinline__ u32x4 pack8v(const f32x4 a, const f32x4 b) { u32x4 w; w.x = pk2(a.x, a.y); w.y = pk2(a.z, a.w); w.z = pk2(b.x, b.y); w.w = pk2(b.z, b.w); return w; }
#define LDS_WAIT() asm volatile("s_waitcnt lgkmcnt(0)" ::: "memory")
#define LBAR() do { asm volatile("s_waitcnt lgkmcnt(0)" ::: "memory"); __builtin_amdgcn_s_barrier(); asm volatile("" ::: "memory"); } while (0)

namespace pg8 {
constexpr int BM = 256, BK = 64, HALF = 128, HTB = HALF * BK * 2, STAGE_BYTES = 8 * HTB, NXCD = 8, WGM = 8;
__host__ __device__ __forceinline__ int lds_byte(int r, int c) { const int st = (r >> 4) * 2 + (c >> 5), rr = r & 15, cc = c & 31, ob = rr * 64 + cc * 2; return st * 1024 + (ob ^ (((ob >> 9) & 1) << 5)); }
__host__ __device__ __forceinline__ void stage_rc(int b, int& R, int& C) { const int st = b / 1024, sb = b % 1024, swz = sb ^ (((sb >> 9) & 1) << 5); R = (st >> 1) * 16 + swz / 64; C = (st & 1) * 32 + (swz % 64) / 2; }
__host__ __device__ __forceinline__ int perm32(int rho) { const int n = rho >> 4, i = rho & 15; return 8 * (i >> 2) + 4 * n + (i & 3); }

struct Unit { int pm, pn; };
struct Gemm { const bf16_t* A; const bf16_t* Bt; int lda, ldb, K, a_pn_off; };

struct StaticOrder {
    int nM, nN, nwg, G, c;
    __device__ void init(int M, int N, int G_, int c_) { nM = M / BM; nN = N / BM; nwg = nM * nN; G = G_; c = c_; }
    __device__ bool next(int i, Unit& u) const {
        const long L = (long)i * G + c; if (L >= nwg) return false;
        int wgid = (int)L; { const int q = nwg / NXCD, r = nwg % NXCD, xcd = wgid % NXCD, off = wgid / NXCD; wgid = (xcd < r ? xcd * (q + 1) : r * (q + 1) + (xcd - r) * q) + off; }
        const int nig = WGM * nN, gid = wgid / nig, fm = gid * WGM, gsz = (nM - fm) < WGM ? (nM - fm) : WGM;
        u.pm = fm + ((wgid % nig) % gsz); u.pn = (wgid % nig) / gsz; return true;
    }
};


struct EpiScale {
    bf16_t* O; int ldc; const float* rss; float* dtf; int dt_pn;
    __device__ __forceinline__ void operator()(const f32x4 (&acc)[2][2][4][2], const Unit& u, int wr, int wc, int fr, int fq) const {
        const int row0 = u.pm * BM + wr * 64 + fr, col0 = u.pn * BM + wc * 32 + 8 * fq;
#pragma unroll
        for (int ai = 0; ai < 2; ++ai)
#pragma unroll
            for (int m = 0; m < 4; ++m) {
                const int row = row0 + ai * HALF + m * 16;
                float sc = 1.f;
                if (rss) { const f32x4* p = (const f32x4*)(rss + (size_t)row * 16); const f32x4 a = p[0], b = p[1], c = p[2], d = p[3];
                    const float s = ((a.x + a.y) + (a.z + a.w)) + ((b.x + b.y) + (b.z + b.w)) + ((c.x + c.y) + (c.z + c.w)) + ((d.x + d.y) + (d.z + d.w));
                    sc = rsqrtf(s * (1.0f / 1024.0f) + EPS); }
                bf16_t* rowp = O + (size_t)row * ldc + col0;
#pragma unroll
                for (int bj = 0; bj < 2; ++bj) { const f32x4 v0 = acc[ai][bj][m][0] * sc, v1 = acc[ai][bj][m][1] * sc;
                    u32x4 w; w.x = cvt_pk_bf16(v0[0], v0[1]); w.y = cvt_pk_bf16(v0[2], v0[3]); w.z = cvt_pk_bf16(v1[0], v1[1]); w.w = cvt_pk_bf16(v1[2], v1[3]);
                    *(u32x4*)(rowp + bj * HALF) = w;
                    if (bj == 0 && dtf != nullptr && u.pn == dt_pn && wc == 0) { float* dp = dtf + (size_t)row * 32 + 8 * fq; *(f32x4*)dp = v0; *(f32x4*)(dp + 4) = v1; } }
            }
    }
};
template <int MODE> struct EpiGate {
    bf16_t* O; int ldc; const bf16_t* gate; int ldg;
    struct Pre { u32x2 gw, ow; };
    __device__ __forceinline__ Pre tail4_pre(int row, int col) const { Pre p; p.gw = *(const u32x2*)(gate + (size_t)row * ldg + col); p.ow = (u32x2){0u, 0u};
        if (MODE == 1) p.ow = *(const u32x2*)(O + (size_t)row * ldc + col); return p; }
    __device__ __forceinline__ void tail4(const f32x4 v, const Pre& pre, int row, int col, int l16) const {
        const u32x2 gw = pre.gw;
        float v0 = sigmoidf_(bflo(gw.x)) * v[0], v1 = sigmoidf_(bfhi(gw.x)) * v[1], v2 = sigmoidf_(bflo(gw.y)) * v[2], v3 = sigmoidf_(bfhi(gw.y)) * v[3];
        bf16_t* op = O + (size_t)row * ldc + col;
        if (MODE == 1) { const u32x2 ow = pre.ow; v0 += bflo(ow.x); v1 += bfhi(ow.x); v2 += bflo(ow.y); v3 += bfhi(ow.y); }
        u32x2 w; w.x = cvt_pk_bf16(v0, v1); w.y = cvt_pk_bf16(v2, v3);
        *(u32x2*)op = w;
    }
    __device__ __forceinline__ void operator()(const f32x4 (&acc)[2][2][4][2], const Unit& u, int wr, int wc, int fr, int fq) const {
        const int row0 = u.pm * BM + wr * 64 + fr, col0 = u.pn * BM + wc * 32 + 8 * fq;
#pragma unroll
        for (int ai = 0; ai < 2; ++ai) {
            u32x4 gwv[4][2], owv[4][2];
#pragma unroll
            for (int m = 0; m < 4; ++m)
#pragma unroll
                for (int bj = 0; bj < 2; ++bj) { const size_t row = (size_t)(row0 + ai * HALF + m * 16);
                    gwv[m][bj] = *(const u32x4*)(gate + row * ldg + col0 + bj * HALF);
                    if (MODE == 1) owv[m][bj] = *(const u32x4*)(O + row * ldc + col0 + bj * HALF); }
#pragma unroll
            for (int m = 0; m < 4; ++m) {
                bf16_t* rowp = O + (size_t)(row0 + ai * HALF + m * 16) * ldc + col0;
#pragma unroll
                for (int bj = 0; bj < 2; ++bj) {
                    float g[8]; unpack8(gwv[m][bj], g);
                    const f32x4 a0 = acc[ai][bj][m][0], a1 = acc[ai][bj][m][1];
                    float v[8];
                    v[0] = sigmoidf_(g[0]) * a0[0]; v[1] = sigmoidf_(g[1]) * a0[1]; v[2] = sigmoidf_(g[2]) * a0[2]; v[3] = sigmoidf_(g[3]) * a0[3];
                    v[4] = sigmoidf_(g[4]) * a1[0]; v[5] = sigmoidf_(g[5]) * a1[1]; v[6] = sigmoidf_(g[6]) * a1[2]; v[7] = sigmoidf_(g[7]) * a1[3];
                    if (MODE == 1) { float o[8]; unpack8(owv[m][bj], o);
#pragma unroll
                        for (int e = 0; e < 8; ++e) v[e] += o[e]; }
                    u32x4 w; w.x = cvt_pk_bf16(v[0], v[1]); w.y = cvt_pk_bf16(v[2], v[3]); w.z = cvt_pk_bf16(v[4], v[5]); w.w = cvt_pk_bf16(v[6], v[7]);
                    *(u32x4*)(rowp + bj * HALF) = w; }
            }
        }
    }
};
struct EpiResid {
    float* X; bf16_t* XB; float* rss;
    struct Pre { f32x4 x; };
    __device__ __forceinline__ Pre tail4_pre(int row, int col) const { Pre p; p.x = *(const f32x4*)(X + (size_t)row * DM + col); return p; }
    __device__ __forceinline__ void tail4(const f32x4 v, const Pre& pre, int row, int col, int l16) const {
        float* xp = X + (size_t)row * DM + col;
        f32x4 x0 = pre.x; x0 += v; *(f32x4*)xp = x0;
        float ss = (x0[0] * x0[0] + x0[1] * x0[1]) + (x0[2] * x0[2] + x0[3] * x0[3]);
        u32x2 w; w.x = cvt_pk_bf16(x0[0], x0[1]); w.y = cvt_pk_bf16(x0[2], x0[3]);
        *(u32x2*)(XB + (size_t)row * DM + col) = w;
        ss += shx(ss, 1, l16); ss += shx(ss, 2, l16); ss += shx(ss, 4, l16); ss += shx(ss, 8, l16);
        if ((l16 & 15) == 0) rss[(size_t)row * 16 + (col >> 6)] = ss;
    }
    __device__ __forceinline__ void operator()(const f32x4 (&acc)[2][2][4][2], const Unit& u, int wr, int wc, int fr, int fq) const {
        const int row0 = u.pm * BM + wr * 64 + fr, col0 = u.pn * BM + wc * 32 + 8 * fq;
#pragma unroll
        for (int ai = 0; ai < 2; ++ai)
#pragma unroll
            for (int mp = 0; mp < 2; ++mp) {
                f32x4 xv[2][2][2];
#pragma unroll
                for (int mm = 0; mm < 2; ++mm)
#pragma unroll
                    for (int bj = 0; bj < 2; ++bj) { const float* xp = X + (size_t)(row0 + ai * HALF + (2 * mp + mm) * 16) * DM + col0 + bj * HALF;
                        xv[mm][bj][0] = *(const f32x4*)xp; xv[mm][bj][1] = *(const f32x4*)(xp + 4); }
#pragma unroll
                for (int mm = 0; mm < 2; ++mm) {
                    const int m = 2 * mp + mm, row = row0 + ai * HALF + m * 16;
                    float* xp = X + (size_t)row * DM + col0; bf16_t* bp = XB + (size_t)row * DM + col0;
                    float ss = 0.f;
#pragma unroll
                    for (int bj = 0; bj < 2; ++bj) {
                        f32x4 x0 = xv[mm][bj][0], x1 = xv[mm][bj][1];
                        x0 += acc[ai][bj][m][0]; x1 += acc[ai][bj][m][1];
                        *(f32x4*)(xp + bj * HALF) = x0; *(f32x4*)(xp + bj * HALF + 4) = x1;
                        ss += (x0[0] * x0[0] + x0[1] * x0[1]) + (x0[2] * x0[2] + x0[3] * x0[3]) + (x1[0] * x1[0] + x1[1] * x1[1]) + (x1[2] * x1[2] + x1[3] * x1[3]);
                        u32x4 w; w.x = cvt_pk_bf16(x0[0], x0[1]); w.y = cvt_pk_bf16(x0[2], x0[3]); w.z = cvt_pk_bf16(x1[0], x1[1]); w.w = cvt_pk_bf16(x1[2], x1[3]);
                        *(u32x4*)(bp + bj * HALF) = w; }
                    ss += shx(ss, 16, fq * 16 + fr); ss += shx(ss, 32, fq * 16 + fr);
                    if (fq == 0) rss[(size_t)row * 16 + u.pn * 4 + wc] = ss;
                }
            }
    }
};

template <class Epi>
__device__ __forceinline__ void gemm_phase(LAS unsigned char* lds_in, int wave_in, const Gemm g, const StaticOrder& S, const Epi& E) {
    int lane = (int)__builtin_amdgcn_mbcnt_hi(~0u, __builtin_amdgcn_mbcnt_lo(~0u, 0u)); asm volatile("" : "+v"(lane));
    int wid = wave_in; asm volatile("" : "+s"(wid));
    const int tid = wid * 64 + lane;
    LAS unsigned char* lds = lds_in; asm volatile("" : "+s"(lds));
    const int wr = wid >> 2, wc = wid & 3, fr = lane & 15, fq = lane >> 4;
    const int K = g.K, nt = K / BK;
    unsigned voffA[2], voffB[2];
#pragma unroll
    for (int i = 0; i < 2; ++i) { int R, C; stage_rc(tid * 16 + i * 8192, R, C); const int Rb = (R & ~31) + perm32(R & 31);
        voffA[i] = (unsigned)(R * g.lda + C) * 2u; voffB[i] = (unsigned)(Rb * g.ldb + C) * 2u; }
    const size_t kstep = (size_t)(BK * 2);
    const size_t hstepA = (size_t)HALF * g.lda * 2, hstepB = (size_t)HALF * g.ldb * 2;
    const size_t tstepA = 2 * hstepA, tstepB = 2 * hstepB;
    const unsigned ldsw = (unsigned)wid * 1024u;
    const int aoff = lds_byte(wr * 64 + fr, fq * 8), boff = lds_byte(wc * 32 + fr, fq * 8);
#define PG8_SA(b, h) (((b) * 2 + (h)) * HTB)
#define PG8_SB(b, h) ((4 + (b) * 2 + (h)) * HTB)
#define PG8_STAGE(bufoff, gbase, voff) do { _Pragma("unroll") for (int _i = 0; _i < 2; ++_i) \
        __builtin_amdgcn_global_load_lds((const unsigned*)((const char*)(gbase) + (voff)[_i]), (LAS unsigned*)(lds + (bufoff) + ldsw + _i * 8192), 16, 0, 0); } while (0)
#define PG8_LDA(dst, b, h) do { _Pragma("unroll") for (int m = 0; m < 4; ++m) _Pragma("unroll") for (int k = 0; k < 2; ++k) dst[m][k] = *(const LAS bf16x8*)(lds + PG8_SA(b, h) + aoff + m * 2048 + k * 1024); } while (0)
#define PG8_LDB(dst, b, h) do { _Pragma("unroll") for (int n = 0; n < 2; ++n) _Pragma("unroll") for (int k = 0; k < 2; ++k) dst[n][k] = *(const LAS bf16x8*)(lds + PG8_SB(b, h) + boff + n * 2048 + k * 1024); } while (0)
#define PG8_MMA(ai, bj, At, Bt) do { __builtin_amdgcn_s_setprio(1); _Pragma("unroll") for (int m = 0; m < 4; ++m) _Pragma("unroll") for (int n = 0; n < 2; ++n) _Pragma("unroll") for (int k = 0; k < 2; ++k) \
        acc[ai][bj][m][n] = __builtin_amdgcn_mfma_f32_16x16x32_bf16(Bt[n][k], At[m][k], acc[ai][bj][m][n], 0, 0, 0); __builtin_amdgcn_s_setprio(0); } while (0)
#define PG8_WAIT_V(n) asm volatile("s_waitcnt vmcnt(" #n ")" ::: "memory")
#define PG8_WAIT_L(n) asm volatile("s_waitcnt lgkmcnt(" #n ")" ::: "memory")
#define PG8_BAR __builtin_amdgcn_s_barrier()
#define PG8_SCHED __builtin_amdgcn_sched_barrier(0)
    Unit cur, nxt; int ui = 0;
    if (!S.next(0, cur)) return;
    f32x4 acc[2][2][4][2];
#pragma unroll
    for (int a = 0; a < 2; ++a)
#pragma unroll
        for (int b = 0; b < 2; ++b)
#pragma unroll
            for (int m = 0; m < 4; ++m)
#pragma unroll
                for (int n = 0; n < 2; ++n) acc[a][b][m][n] = (f32x4){0.f, 0.f, 0.f, 0.f};
    bf16x8 At[4][2], B0[2][2], B1[2][2];
    const char* cA = (const char*)g.A + (size_t)cur.pm * tstepA + (size_t)cur.pn * g.a_pn_off * 2; const char* cB = (const char*)g.Bt + (size_t)cur.pn * tstepB;
    PG8_STAGE(PG8_SB(0, 0), cB, voffB); PG8_STAGE(PG8_SB(0, 1), cB + hstepB, voffB); PG8_STAGE(PG8_SA(0, 0), cA, voffA); PG8_STAGE(PG8_SA(0, 1), cA + hstepA, voffA);
    if (wr == 1) PG8_BAR;
    PG8_WAIT_V(2); PG8_BAR;
    PG8_STAGE(PG8_SB(1, 0), cB + kstep, voffB); PG8_STAGE(PG8_SA(1, 0), cA + kstep, voffA); PG8_STAGE(PG8_SB(1, 1), cB + hstepB + kstep, voffB);
    PG8_WAIT_V(6); PG8_BAR;
    for (;;) {
        const bool has_next = S.next(ui + 1, nxt);
        const char* nA = has_next ? (const char*)g.A + (size_t)nxt.pm * tstepA + (size_t)nxt.pn * g.a_pn_off * 2 : cA; const char* nB = has_next ? (const char*)g.Bt + (size_t)nxt.pn * tstepB : cB;
        for (int t = 0; t < nt; t += 2) {
            const bool last = (t == nt - 2);
            const char* a1 = cA + (size_t)(t + 1) * kstep;
            const char* a2 = last ? nA : cA + (size_t)(t + 2) * kstep; const char* b2 = last ? nB : cB + (size_t)(t + 2) * kstep;
            const char* a3 = a2 + kstep; const char* b3 = b2 + kstep;
            PG8_LDB(B0, 0, 0); PG8_LDB(B1, 0, 1); PG8_SCHED; PG8_LDA(At, 0, 0); PG8_STAGE(PG8_SA(1, 1), a1 + hstepA, voffA);
            PG8_WAIT_V(8); PG8_WAIT_L(0); PG8_BAR; PG8_MMA(0, 0, At, B0); PG8_MMA(0, 1, At, B1); PG8_BAR; PG8_SCHED;
            PG8_LDA(At, 0, 1); PG8_STAGE(PG8_SB(0, 0), b2, voffB); PG8_STAGE(PG8_SB(0, 1), b2 + hstepB, voffB); PG8_STAGE(PG8_SA(0, 0), a2, voffA);
            PG8_WAIT_V(8); PG8_WAIT_L(0); PG8_BAR; PG8_MMA(1, 0, At, B0); PG8_MMA(1, 1, At, B1); PG8_BAR; PG8_SCHED;
            PG8_LDB(B0, 1, 0); PG8_LDB(B1, 1, 1); PG8_SCHED; PG8_LDA(At, 1, 0); PG8_STAGE(PG8_SA(0, 1), a2 + hstepA, voffA);
            PG8_WAIT_V(8); PG8_WAIT_L(0); PG8_BAR; PG8_MMA(0, 0, At, B0); PG8_MMA(0, 1, At, B1); PG8_BAR; PG8_SCHED;
            PG8_LDA(At, 1, 1); PG8_STAGE(PG8_SB(1, 0), b3, voffB); PG8_STAGE(PG8_SB(1, 1), b3 + hstepB, voffB); PG8_STAGE(PG8_SA(1, 0), a3, voffA);
            PG8_WAIT_V(8); PG8_WAIT_L(0); PG8_BAR; PG8_MMA(1, 0, At, B0); PG8_MMA(1, 1, At, B1); PG8_BAR; PG8_SCHED;
        }
        if (wr == 0) PG8_BAR;
        E(acc, cur, wr, wc, fr, fq);
        if (!has_next) break;
#pragma unroll
        for (int a = 0; a < 2; ++a)
#pragma unroll
            for (int b = 0; b < 2; ++b)
#pragma unroll
                for (int m = 0; m < 4; ++m)
#pragma unroll
                    for (int n = 0; n < 2; ++n) acc[a][b][m][n] = (f32x4){0.f, 0.f, 0.f, 0.f};
        cur = nxt; cA = nA; cB = nB; ++ui;
        if (wr == 1) PG8_BAR;
    }
    PG8_WAIT_V(0);
    PG8_BAR;
#undef PG8_SA
#undef PG8_SB
#undef PG8_STAGE
#undef PG8_LDA
#undef PG8_LDB
#undef PG8_MMA
#undef PG8_WAIT_V
#undef PG8_WAIT_L
#undef PG8_BAR
#undef PG8_SCHED
}

constexpr int MTAIL0 = 16384;
template <class Epi>
__device__ __forceinline__ void gemm_tail(LAS unsigned char* lds_in, int wave_in, const Gemm g, const Epi& E) {
    int lane = (int)__builtin_amdgcn_mbcnt_hi(~0u, __builtin_amdgcn_mbcnt_lo(~0u, 0u)); asm volatile("" : "+v"(lane));
    int wid = wave_in; asm volatile("" : "+s"(wid));
    LAS unsigned char* lds = lds_in; asm volatile("" : "+s"(lds));
    int G = gridDim.x, bid = blockIdx.x; asm volatile("" : "+s"(G)); asm volatile("" : "+s"(bid));
    const int r = lane & 15, q = lane >> 4;
    constexpr int NRT = (MREAL - MTAIL0) / 32, NCT = 1024 / 64;
    const int klen = g.K / 8, kbeg = wid * klen;
    const int nx = (G % 8 == 0) ? 8 : 1, x = (nx == 8) ? (bid & 7) : 0, j = (nx == 8) ? (bid >> 3) : bid, nj = G / nx;
    const int ct_per = NCT / nx, ntile = NRT * ct_per;
    LAS float* red = (LAS float*)lds;
    const size_t a16 = (size_t)16 * g.lda, b16 = (size_t)16 * g.ldb;
    bf16x8 pa[4][2], pb[4][4];
#define TAIL_PTRS(tt_, rt_, ct_, row0_, col0_, ap_, bp_) const int rt_ = (tt_) % NRT, ct_ = x * ct_per + (tt_) / NRT, row0_ = MTAIL0 + 32 * rt_, col0_ = 64 * ct_; \
        const bf16_t* ap_ = g.A + (size_t)(row0_ + r) * g.lda + 8 * q + kbeg + (size_t)(col0_ >> 8) * g.a_pn_off; const bf16_t* bp_ = g.Bt + (size_t)(col0_ + r) * g.ldb + 8 * q + kbeg; (void)rt_; (void)ct_;
#define TAIL_PF(ap_, bp_) do { _Pragma("unroll") for (int s_ = 0; s_ < 4; ++s_) { _Pragma("unroll") for (int i = 0; i < 2; ++i) pa[s_][i] = *(const bf16x8*)((ap_) + i * a16 + 32 * s_); \
        _Pragma("unroll") for (int f = 0; f < 4; ++f) pb[s_][f] = *(const bf16x8*)((bp_) + f * b16 + 32 * s_); } } while (0)
    if (j < ntile) { TAIL_PTRS(j, rt0, ct0, row00, col00, ap0, bp0); (void)row00; TAIL_PF(ap0, bp0); }
    for (int tt = j; tt < ntile; tt += nj) {
        TAIL_PTRS(tt, rt, ct, row0, col0, ap, bp);
        const int rr = 4 * wid + (lane >> 4), cc = 4 * (lane & 15);
        const typename Epi::Pre pre = E.tail4_pre(row0 + rr, col0 + cc);
        f32x4 acc[2][4];
#pragma unroll
        for (int i = 0; i < 2; ++i)
#pragma unroll
            for (int f = 0; f < 4; ++f) acc[i][f] = (f32x4){0.f, 0.f, 0.f, 0.f};
#pragma unroll
        for (int s_ = 0; s_ < 4; ++s_)
#pragma unroll
            for (int i = 0; i < 2; ++i)
#pragma unroll
                for (int f = 0; f < 4; ++f) acc[i][f] = __builtin_amdgcn_mfma_f32_16x16x32_bf16(pb[s_][f], pa[s_][i], acc[i][f], 0, 0, 0);
#pragma unroll 4
        for (int k0 = 128; k0 < klen; k0 += 32) {
            bf16x8 a[2], b[4];
#pragma unroll
            for (int i = 0; i < 2; ++i) a[i] = *(const bf16x8*)(ap + i * a16 + k0);
#pragma unroll
            for (int f = 0; f < 4; ++f) b[f] = *(const bf16x8*)(bp + f * b16 + k0);
#pragma unroll
            for (int i = 0; i < 2; ++i)
#pragma unroll
                for (int f = 0; f < 4; ++f) acc[i][f] = __builtin_amdgcn_mfma_f32_16x16x32_bf16(b[f], a[i], acc[i][f], 0, 0, 0);
        }
        __builtin_amdgcn_sched_barrier(0);
        if (tt + nj < ntile) { TAIL_PTRS(tt + nj, rtn, ctn, row0n, col0n, apn, bpn); (void)row0n; TAIL_PF(apn, bpn); }
        __builtin_amdgcn_sched_barrier(0);
#pragma unroll
        for (int i = 0; i < 2; ++i)
#pragma unroll
            for (int f = 0; f < 4; ++f) *(LAS f32x4*)(red + wid * 2048 + (16 * i + r) * 64 + 16 * f + 4 * q) = acc[i][f];
        LBAR();
        {
            f32x4 v = (f32x4){0.f, 0.f, 0.f, 0.f};
#pragma unroll
            for (int w = 0; w < 8; ++w) v += *(const LAS f32x4*)(red + w * 2048 + rr * 64 + cc);
            E.tail4(v, pre, row0 + rr, col0 + cc, lane);
        }
        LBAR();
    }
#undef TAIL_PTRS
#undef TAIL_PF
}
}

struct Params { const float* in[26]; float* out; unsigned char* ws; };

typedef const Params __attribute__((address_space(4)))* KP;
__device__ __forceinline__ KP kparams() { KP p = (KP)__builtin_amdgcn_kernarg_segment_ptr(); asm volatile("" : "+s"(p)); return p; }
struct Ctx { int tid, lane, wave, G, bid; };
__device__ __forceinline__ Ctx get_ids(int wave_in) { Ctx I;
    int ln = (int)__builtin_amdgcn_mbcnt_hi(~0u, __builtin_amdgcn_mbcnt_lo(~0u, 0u)); asm volatile("" : "+v"(ln));
    int wv = wave_in; asm volatile("" : "+s"(wv));
    int gg = gridDim.x, bb = blockIdx.x; asm volatile("" : "+s"(gg)); asm volatile("" : "+s"(bb));
    I.lane = ln; I.wave = wv; I.tid = wv * 64 + ln; I.G = gg; I.bid = bb; return I; }

#define XB_TMO      128
#define XB_XCNT(j)  (256  + 64 * (j))
#define XB_XSUB(j)  (1280 + 64 * (j))
#define XB_XGEN(j)  (2304 + 64 * (j))
#define XB_TOP      3328
#define XB_TOPGEN   3392
#define XCD_BAR_WORDS 3456
#define XB_SPIN_CAP (1u << 20)
__device__ __forceinline__ unsigned xb_ld(unsigned* p)              { return __hip_atomic_load(p, __ATOMIC_RELAXED, __HIP_MEMORY_SCOPE_AGENT); }
__device__ __forceinline__ unsigned xb_add(unsigned* p, unsigned v) { return __hip_atomic_fetch_add(p, v, __ATOMIC_RELAXED, __HIP_MEMORY_SCOPE_AGENT); }
__device__ __forceinline__ unsigned xb_xcc_id() { return (unsigned)__builtin_amdgcn_s_getreg((3 << 11) | 20) & 0xFu; }
#define XB_SPIN(cond, bar) do { unsigned _sp = 0; while (cond) { __builtin_amdgcn_s_sleep(1); \
    if ((++_sp & 255u) == 0u) { if (xb_ld(&(bar)[XB_TMO])) break; if (_sp > XB_SPIN_CAP) { atomicAdd(&(bar)[XB_TMO], 1u); break; } } } } while (0)
__device__ __forceinline__ void xcd_barrier_complete(unsigned* bar, unsigned x, unsigned& nloc, unsigned& nx) {
    const unsigned G = gridDim.x;
    unsigned sum, cnt, mine, sp = 0u;
    for (;;) {
        sum = 0u; cnt = 0u; mine = 0u;
#pragma unroll
        for (unsigned j = 0; j < 16; ++j) { const unsigned c = xb_ld(&bar[XB_XCNT(j)]); sum += c; cnt += (c > 0u) ? 1u : 0u; mine = (j == x) ? c : mine; }
        if (sum == G) break;
        __builtin_amdgcn_s_sleep(1);
        if ((++sp & 255u) == 0u) { if (xb_ld(&bar[XB_TMO])) break; if (sp > XB_SPIN_CAP) { atomicAdd(&bar[XB_TMO], 1u); break; } }
    }
    nloc = mine > 0u ? mine : 1u; nx = cnt > 0u ? cnt : 1u;
}
__device__ __forceinline__ void grid_barrier(unsigned char* ws, LAS unsigned char* lds_in, int wave_in) {
    const Ctx C = get_ids(wave_in);
    unsigned* bar = (unsigned*)(ws + WS_CTL);
    volatile LAS unsigned* st = (volatile LAS unsigned*)(lds_in + LDS_ST_OFF);
    asm volatile("s_waitcnt vmcnt(0)" ::: "memory");
    __syncthreads();
    if (C.tid == 0) {
        __builtin_amdgcn_s_waitcnt(0);
        const unsigned x = xb_xcc_id();
        unsigned nloc = st[0], nx = st[1];
        if (nloc == 0u) { xcd_barrier_complete(bar, x, nloc, nx); st[0] = nloc; st[1] = nx; }
        const unsigned old = xb_add(&bar[XB_XSUB(x)], 1u);
        const unsigned gen = old / nloc;
        if (old + 1u == (gen + 1u) * nloc) {
            __builtin_amdgcn_fence(__ATOMIC_RELEASE, "agent");
            asm volatile("s_waitcnt vmcnt(0)" ::: "memory");
            const unsigned og = xb_add(&bar[XB_TOP], 1u);
            const unsigned tg = og / nx;
            if (og + 1u == (tg + 1u) * nx) xb_add(&bar[XB_TOPGEN], 1u);
            else XB_SPIN(xb_ld(&bar[XB_TOPGEN]) == tg, bar);
            __builtin_amdgcn_fence(__ATOMIC_ACQUIRE, "agent");
            xb_add(&bar[XB_XGEN(x)], 1u);
            asm volatile("s_waitcnt vmcnt(0)" ::: "memory");
        } else {
            XB_SPIN(xb_ld(&bar[XB_XGEN(x)]) == gen, bar);
            __builtin_amdgcn_fence(__ATOMIC_ACQUIRE, "agent");
            asm volatile("s_waitcnt vmcnt(0)" ::: "memory");
        }
    }
    __syncthreads();
}

#define IN_(i) (kp->in[i])
#define WSP(T, off) ((T*)(ws + (off)))

__device__ __forceinline__ void transpose_item(const float* W, int ldw, int col0, int k0, bf16_t* WT, int ldk, const float* ks, const float* ns, int ncol_valid, LAS float* scr, int lane) {
    const int c4 = (lane & 15) * 4, rsub = lane >> 4;
    const bool cv = c4 < ncol_valid;
    f32x4 nsv = (f32x4){1.f, 1.f, 1.f, 1.f}; if (ns && cv) nsv = *(const f32x4*)(ns + c4);
    f32x4 v[16];
#pragma unroll
    for (int i = 0; i < 16; ++i) v[i] = cv ? *(const f32x4*)(W + (size_t)(k0 + i * 4 + rsub) * ldw + col0 + c4) : (f32x4){0.f, 0.f, 0.f, 0.f};
#pragma unroll
    for (int i = 0; i < 16; ++i) { const int kk = i * 4 + rsub; f32x4 x = v[i] * nsv; if (ks) x = x * ks[k0 + kk];
        LAS float* d = scr + kk * 65 + c4; d[0] = x.x; d[1] = x.y; d[2] = x.z; d[3] = x.w; }
    LDS_WAIT(); asm volatile("" ::: "memory");
    const int c = lane & 7;
#pragma unroll
    for (int j = 0; j < 8; ++j) { const int n = (lane >> 3) + 8 * j; const LAS float* s = scr + (8 * c) * 65 + n;
        u32x4 o; o.x = pk2(s[0 * 65], s[1 * 65]); o.y = pk2(s[2 * 65], s[3 * 65]); o.z = pk2(s[4 * 65], s[5 * 65]); o.w = pk2(s[6 * 65], s[7 * 65]);
        *(u32x4*)(WT + (size_t)n * ldk + k0 + 8 * c) = o; }
    LDS_WAIT(); asm volatile("" ::: "memory");
}

__device__ __forceinline__ void prologue(const Ctx& C_, LAS unsigned char* lds) {
    const Ctx C = get_ids(C_.wave);
    KP kp = kparams(); unsigned char* ws = kp->ws; (void)ws;
    const float* const L_x_prompt = kp->in[0];
    const float* const L_x_sample = kp->in[1];
    const float* const L_meta = kp->in[6];
    const float* const L_norm1_w = kp->in[7];
    const float* const L_w_in = kp->in[8];
    const float* const L_pool_w = kp->in[9];
    const float* const L_pool_scale = kp->in[10];
    const float* const L_w_pool_out = kp->in[11];
    const float* const L_ssd_norm_w = kp->in[17];
    const float* const L_w_ssd_out = kp->in[18];
    const float* const L_w_o = kp->in[19];
    const float* const L_norm2_w = kp->in[20];
    const float* const L_w_up = kp->in[21];
    const float* const L_w_down = kp->in[24];
    bf16_t* const L_W1T = (bf16_t*)(ws + WS_W1T);
    bf16_t* const L_PWT = (bf16_t*)(ws + WS_PWT);
    bf16_t* const L_WPOT = (bf16_t*)(ws + WS_WPOT);
    bf16_t* const L_WSOT = (bf16_t*)(ws + WS_WSOT);
    bf16_t* const L_WOT = (bf16_t*)(ws + WS_WOT);
    bf16_t* const L_WUPT = (bf16_t*)(ws + WS_WUPT);
    bf16_t* const L_WDT = (bf16_t*)(ws + WS_WDT);
    bf16_t* const L_XB = (bf16_t*)(ws + WS_XB);
    float* const L_X = (float*)(ws + WS_X);
    float* const L_RSS = (float*)(ws + WS_RSS);
    LAS float* scr = (LAS float*)(lds + C.wave * 16640);
    const int gw = C.bid * NWAVES + C.wave, NGW = C.G * NWAVES, lane = C.lane;
    constexpr int NB1 = NPROJ / 64;
    constexpr int I_W1 = 16 * NB1, I_PW = 4 * 4 * 4, I_PO = 16 * 16, I_SO = 32 * 16, I_O = 16 * 16, I_UP = 16 * (DUP / 64), I_D = (DFF / 64) * 16;
    constexpr int I_LAYER = I_W1 + I_PW + I_PO + I_SO + I_O + I_UP + I_D;
    for (int it = gw; it < DEPTH * I_LAYER; it += NGW) {
        const int l = it / I_LAYER; int r = it - l * I_LAYER;
        if (r < I_W1) {
            const int nb = r % NB1, kb = r / NB1, n0 = nb * 64, k0 = kb * 64;
            bf16_t* dst = L_W1T + ((size_t)l * NPROJ + n0) * 1024;
            if (n0 >= PC_DT + 64) {
                const int c = lane & 7;
#pragma unroll
                for (int j = 0; j < 8; ++j) { const int n = (lane >> 3) + 8 * j; *(u32x4*)(dst + (size_t)n * 1024 + k0 + 8 * c) = (u32x4){0u, 0u, 0u, 0u}; }
            } else {
                int sc, nv = 64;
                if (n0 < PC_GA) sc = n0; else if (n0 < PC_GB) sc = 6176 + (n0 - PC_GA); else if (n0 < PC_DT) sc = 7200 + (n0 - PC_GB); else { sc = 6144; nv = 32; }
                transpose_item(L_w_in + (size_t)l * 1024 * 8224, 8224, sc, k0, dst, 1024, L_norm1_w + l * 1024, nullptr, nv, scr, lane);
            }
            continue;
        }
        r -= I_W1;
        if (r < I_PW) {
            const int g = r / 16, rr = r % 16, kb = rr / 4, nb = rr % 4;
            transpose_item(L_pool_w + ((size_t)(l * 4 + g) * 256) * 256, 256, nb * 64, kb * 64, L_PWT + ((size_t)l * 1024 + g * 256 + nb * 64) * 256, 256, nullptr, L_pool_scale + l * 1024 + g * 256 + nb * 64, 64, scr, lane);
            continue;
        }
        r -= I_PW;
        if (r < I_PO) { const int kb = r / 16, nb = r % 16;
            transpose_item(L_w_pool_out + (size_t)l * 1024 * 1024, 1024, nb * 64, kb * 64, L_WPOT + ((size_t)l * 1024 + nb * 64) * 1024, 1024, nullptr, nullptr, 64, scr, lane); continue; }
        r -= I_PO;
        if (r < I_SO) { const int kb = r / 16, nb = r % 16;
            transpose_item(L_w_ssd_out + (size_t)l * 2048 * 1024, 1024, nb * 64, kb * 64, L_WSOT + ((size_t)l * 1024 + nb * 64) * 2048, 2048, L_ssd_norm_w + l * 2048, nullptr, 64, scr, lane); continue; }
        r -= I_SO;
        if (r < I_O) { const int kb = r / 16, nb = r % 16;
            transpose_item(L_w_o + (size_t)l * 1024 * 1024, 1024, nb * 64, kb * 64, L_WOT + ((size_t)l * 1024 + nb * 64) * 1024, 1024, nullptr, nullptr, 64, scr, lane); continue; }
        r -= I_O;
        if (r < I_UP) { const int kb = r / (DUP / 64), nb = r % (DUP / 64);
            transpose_item(L_w_up + (size_t)l * 1024 * DUP, DUP, nb * 64, kb * 64, L_WUPT + ((size_t)l * DUP + nb * 64) * 1024, 1024, L_norm2_w + l * 1024, nullptr, 64, scr, lane); continue; }
        r -= I_UP;
        { const int kb = r / 16, nb = r % 16;
            transpose_item(L_w_down + (size_t)l * DFF * 1024, 1024, nb * 64, kb * 64, L_WDT + ((size_t)l * 1024 + nb * 64) * DFF, DFF, nullptr, nullptr, 64, scr, lane); }
    }
    for (int m = gw; m < MP; m += NGW) {
        const float* src = nullptr;
        if (m < MPROMPT) { const int b = m / LP, t = m - b * LP; src = (t < NMETA) ? L_meta + (size_t)t * DM : L_x_prompt + ((size_t)b * SEQ + (t - NMETA)) * DM; }
        else if (m < MREAL) src = L_x_sample + (size_t)(m - MPROMPT) * DM;
        float ss = 0.f;
        f32x4 vin[4];
#pragma unroll
        for (int j = 0; j < 4; ++j) vin[j] = src ? ((const f32x4*)src)[lane + 64 * j] : (f32x4){0.f, 0.f, 0.f, 0.f};
#pragma unroll
        for (int j = 0; j < 4; ++j) {
            const f32x4 v = vin[j];
            ss += (v.x * v.x + v.y * v.y) + (v.z * v.z + v.w * v.w);
            ((f32x4*)(L_X + (size_t)m * DM))[lane + 64 * j] = v;
            u32x2 w; w.x = pk2(v.x, v.y); w.y = pk2(v.z, v.w);
            ((u32x2*)(L_XB + (size_t)m * DM))[lane + 64 * j] = w;
        }
        ss = wave_sum(ss);
        if (lane < 16) L_RSS[(size_t)m * 16 + lane] = (lane == 0) ? ss : 0.f;
    }
}

__device__ __forceinline__ void conv_pass(const Ctx& C_, int l) {
    const Ctx C = get_ids(C_.wave);
    KP kp = kparams(); unsigned char* ws = kp->ws;
    const float* const L_state_conv = kp->in[3];
    const float* const L_conv_w = kp->in[12];
    const float* const L_conv_b = kp->in[13];
    const float* const L_dt_bias = kp->in[14];
    const bf16_t* const L_PROJ = (const bf16_t*)(ws + WS_PROJ);
    bf16_t* const L_XBCC = (bf16_t*)(ws + WS_XBCC);
    const float* const L_DT = (const float*)(ws + WS_DT);
    float* const L_DTS = (float*)(ws + WS_DTS);
    const int gtid = C.bid * NTHREADS + C.tid, NT = C.G * NTHREADS;
    constexpr int NV = CONVD / 8, NSTRIP = MREAL / 8;
    for (int it = gtid; it < NSTRIP * NV; it += NT) {
        const int strip = it / NV, v = it - strip * NV, ch = v * 8, m0 = strip * 8;
        const bool sample = m0 >= MPROMPT;
        const int t0 = sample ? 0 : (m0 % LP), b = sample ? (m0 - MPROMPT) / DS : 0;
        const bf16_t* rb = L_PROJ + ((size_t)m0 - 3) * NPROJ + PC_XBC + ch;
        u32x4 raw[11];
#pragma unroll
        for (int i = 0; i < 11; ++i) raw[i] = *(const u32x4*)(rb + (size_t)((t0 + i - 3 >= 0) ? i : 3) * NPROJ);
        if (t0 < 3) {
#pragma unroll
            for (int i = 0; i < 3; ++i) if (t0 + i - 3 < 0) {
                u32x4 rv = (u32x4){0u, 0u, 0u, 0u};
                if (sample) { const float* pp = L_state_conv + ((size_t)(l * DB + b) * 3 + i) * CONVD + ch; rv = pack8v(*(const f32x4*)pp, *(const f32x4*)(pp + 4)); }
                raw[i] = rv; }
        }
        f32x4 cw[4][2], cbias[2];
#pragma unroll
        for (int k = 0; k < 4; ++k) { cw[k][0] = *(const f32x4*)(L_conv_w + ((size_t)l * 4 + k) * CONVD + ch); cw[k][1] = *(const f32x4*)(L_conv_w + ((size_t)l * 4 + k) * CONVD + ch + 4); }
        cbias[0] = *(const f32x4*)(L_conv_b + (size_t)l * CONVD + ch); cbias[1] = *(const f32x4*)(L_conv_b + (size_t)l * CONVD + ch + 4);
        float oacc[4][8];
#pragma unroll
        for (int i = 0; i < 11; ++i) {
            float xv[8]; unpack8(raw[i], xv);
            if (i < 8) {
#pragma unroll
                for (int e = 0; e < 8; ++e) oacc[i & 3][e] = 0.f;
            }
#pragma unroll
            for (int k = 0; k < 4; ++k) { const int j = i - k;
                if (j >= 0 && j < 8) { float* o = oacc[j & 3];
                    o[0] += cw[k][0].x * xv[0]; o[1] += cw[k][0].y * xv[1]; o[2] += cw[k][0].z * xv[2]; o[3] += cw[k][0].w * xv[3];
                    o[4] += cw[k][1].x * xv[4]; o[5] += cw[k][1].y * xv[5]; o[6] += cw[k][1].z * xv[6]; o[7] += cw[k][1].w * xv[7]; } }
            if (i >= 3) {
                const int j = i - 3; const float* oa = oacc[j & 3];
                float o[8];
                o[0] = siluf_(oa[0] + cbias[0].x); o[1] = siluf_(oa[1] + cbias[0].y); o[2] = siluf_(oa[2] + cbias[0].z); o[3] = siluf_(oa[3] + cbias[0].w);
                o[4] = siluf_(oa[4] + cbias[1].x); o[5] = siluf_(oa[5] + cbias[1].y); o[6] = siluf_(oa[6] + cbias[1].z); o[7] = siluf_(oa[7] + cbias[1].w);
                *(u32x4*)(L_XBCC + (size_t)(m0 + j) * CONVD + ch) = pack8(o);
            }
        }
    }
    for (int idx = gtid; idx < MREAL * NH; idx += NT) {
        const float rw = L_DT[idx] + L_dt_bias[l * NH + (idx & 31)];
        L_DTS[(size_t)(idx & 31) * MP + (idx >> 5)] = rw > 20.f ? rw : __logf(1.0f + __expf(rw));
    }
}

constexpr int LD128 = 136, LD64 = 72;
constexpr int S_C = 0, S_CS = 17408, S_B = 34816, S_BWT = 52224, S_XDT = 70656, S_XS = 79872, S_M = 89088, S_H = 98304, S_Z = 115712  , S_DTV = 124928, S_CUM = 125440, S_SSQ = 125952;

#define SSD_PREFETCH(r0_, ntok_, h_, xoff_, zoff_, boff_, c0n) do { \
    const int nqn_ = ((ntok_) - (c0n)) < 64 ? ((ntok_) - (c0n)) : 64; \
    const bf16_t* xb_ = L_XBCC + (size_t)((r0_) + (c0n)) * CONVD; \
    { unsigned z_ = 0u; asm volatile("" : "+v"(z_)); rx = (u32x4){z_, z_, z_, z_}; } zraw = rx; rB[0] = rx; rB[1] = rx; rC[0] = rx; rC[1] = rx;     \
    if (zt < nqn_) zraw = *(const u32x4*)(L_PROJ + (size_t)((r0_) + (c0n)) * NPROJ + (zoff_)); \
    if (zt < nqn_) rx = *(const u32x4*)(xb_ + (xoff_)); \
    _Pragma("unroll") for (int i_ = 0; i_ < 2; ++i_) if (bt + 32 * i_ < nqn_) { rB[i_] = *(const u32x4*)(xb_ + (boff_) + (size_t)i_ * 32 * CONVD); rC[i_] = *(const u32x4*)(xb_ + (boff_) + 512 + (size_t)i_ * 32 * CONVD); } \
    dtraw = (lane < nqn_) ? L_DTS[(size_t)(h_) * MP + (unsigned)((r0_) + (c0n) + lane)] : 0.f; \
} while (0)
#define SSD_UNIT(u_, smp_, b_, h_, r0_, ntok_, xoff_, zoff_, boff_) do { \
    smp_ = (u_) >= NBATCH * NH; const int k_ = smp_ ? (u_) - NBATCH * NH : (u_); b_ = k_ / NH; h_ = k_ - b_ * NH; \
    r0_ = smp_ ? MPROMPT + b_ * DS : b_ * LP; ntok_ = smp_ ? DS : LP; \
    xoff_ = (unsigned)zt * CONVD + h_ * 64 + zv * 8; zoff_ = (unsigned)zt * NPROJ + PC_Z + h_ * 64 + zv * 8; boff_ = (unsigned)bt * CONVD + 2048 + (h_ >> 3) * 128 + bv * 8; \
} while (0)

__device__ __forceinline__ void ssd_phase(const Ctx& C_, LAS unsigned char* lds_in, int l) {
    const Ctx C = get_ids(C_.wave);
    LAS unsigned char* lds = lds_in; asm volatile("" : "+s"(lds));
    KP kp = kparams(); unsigned char* ws = kp->ws;
    const float* const L_state_ssm = kp->in[4];
    float* const L_out = kp->out;
    const bf16_t* const L_PROJ = (const bf16_t*)(ws + WS_PROJ);
    const bf16_t* const L_XBCC = (const bf16_t*)(ws + WS_XBCC);
    bf16_t* const L_YN = (bf16_t*)(ws + WS_YN);
    const float* const L_DTS = (const float*)(ws + WS_DTS);
    float* const L_SSQ = (float*)(ws + WS_SSQ);
    const float* const L_a_log = kp->in[15] + l * NH; const float* const L_d_skip = kp->in[16] + l * NH;
    const int tid = C.tid, lane = C.lane, wave = C.wave, r = lane & 15, q = lane >> 4;
    LAS bf16_t* sC = (LAS bf16_t*)(lds + S_C); LAS bf16_t* sCs = (LAS bf16_t*)(lds + S_CS); LAS bf16_t* sB = (LAS bf16_t*)(lds + S_B);
    LAS bf16_t* sBwT = (LAS bf16_t*)(lds + S_BWT); LAS bf16_t* sXdT = (LAS bf16_t*)(lds + S_XDT); LAS bf16_t* sXs = (LAS bf16_t*)(lds + S_XS);
    LAS bf16_t* sM = (LAS bf16_t*)(lds + S_M); LAS bf16_t* sH = (LAS bf16_t*)(lds + S_H); LAS bf16_t* sZ = (LAS bf16_t*)(lds + S_Z);
    LAS float* scum = (LAS float*)(lds + S_CUM); LAS float* sssq = (LAS float*)(lds + S_SSQ);
    const int zt = tid >> 3, zv = tid & 7, bt = tid >> 4, bv = tid & 15;
    const int pjs = wave & 3, ni0 = (wave >> 2) * 4;
    const int NU = NBATCH * NH;
    int u = C.bid; if (u >= NU) return;
    bool sample; int b, h, r0, ntok; unsigned xoff, zoff, boff;
    SSD_UNIT(u, sample, b, h, r0, ntok, xoff, zoff, boff);
    u32x4 rx, zraw, rB[2], rC[2]; float dtraw = 0.f;
    SSD_PREFETCH(r0, ntok, h, xoff, zoff, boff, 0);
    if (tid < 64) sssq[tid] = 0.f;
  for (;;) {
    const float a_h = -__expf(L_a_log[h]), dsk = L_d_skip[h];
    f32x4 H[4];
    if (sample) { const float* h0 = L_state_ssm + ((size_t)(l * DB + b) * NH + h) * (HD * NST);
#pragma unroll
        for (int j = 0; j < 4; ++j) H[j] = *(const f32x4*)(h0 + (16 * pjs + r) * NST + 16 * (ni0 + j) + 4 * q);
    } else {
        float z_ = 0.f; asm volatile("" : "+v"(z_));
#pragma unroll
        for (int j = 0; j < 4; ++j) H[j] = (f32x4){z_, z_, z_, z_};
    }
    const int un = u + C.G; const bool has_next = un < NU;
    LBAR();

    int par = 0;
    for (int c0 = 0; c0 < ntok; c0 += 64, par ^= 1) {
        const int nq = (ntok - c0) < 64 ? (ntok - c0) : 64;
        const bool more = (c0 + 64) < ntok;
        const LAS float* cumc = scum;
        const float d = dtraw;
        float cs = d * a_h;
#pragma unroll
        for (int o_ = 1; o_ < 64; o_ <<= 1) { const float v_ = shup(cs, o_, lane); if (lane >= o_) cs += v_; }
        const float clast = shidx(cs, 63);
        if (wave == 7) scum[lane] = cs;
#define SWZ(row_, tok_) ((row_) * LD64 + (((((tok_) >> 3) ^ (((row_) >> 3) & 7)) << 3) | ((tok_) & 7)))
        {
            const float dz = shidx(d, zt), wcs0 = shidx(cs, bt), wcs1 = shidx(cs, bt + 32);
            float xv[8]; unpack8(rx, xv);
            *(LAS u32x4*)(sXs + zt * LD64 + zv * 8) = rx;
            *(LAS u32x4*)(sZ + zt * LD64 + zv * 8) = zraw;
#pragma unroll
            for (int e = 0; e < 8; ++e) sXdT[SWZ(zv * 8 + e, zt)] = (bf16_t)f2bf(xv[e] * dz);
#pragma unroll
            for (int i = 0; i < 2; ++i) {
                const int st = bt + 32 * i; const float csx = i == 0 ? wcs0 : wcs1;
                const float wb = __expf(clast - csx), wc = __expf(csx);
                float bvv[8]; unpack8(rB[i], bvv);
                *(LAS u32x4*)(sB + st * LD128 + bv * 8) = rB[i];
#pragma unroll
                for (int e = 0; e < 8; ++e) sBwT[SWZ(bv * 8 + e, st)] = (bf16_t)f2bf(bvv[e] * wb);
                float cvv[8]; unpack8(rC[i], cvv);
                *(LAS u32x4*)(sC + st * LD128 + bv * 8) = rC[i];
#pragma unroll
                for (int e = 0; e < 8; ++e) cvv[e] *= wc;
                *(LAS u32x4*)(sCs + st * LD128 + bv * 8) = pack8(cvv);
            }
        }
        __builtin_amdgcn_sched_barrier(0);
        if (more) { SSD_PREFETCH(r0, ntok, h, xoff, zoff, boff, c0 + 64); }
        else if (has_next) {
            bool sample_n; int b_n, h_n, r0_n, ntok_n; unsigned xoff_n, zoff_n, boff_n;
            SSD_UNIT(un, sample_n, b_n, h_n, r0_n, ntok_n, xoff_n, zoff_n, boff_n);
            SSD_PREFETCH(r0_n, ntok_n, h_n, xoff_n, zoff_n, boff_n, 0);
        }
        LBAR();
        {
            const int ti = wave >> 1, sj0 = (wave & 1) * 2;
            if (16 * ti < nq) {
                bf16x8 fa[4], fb[2][4];
#pragma unroll
                for (int kk = 0; kk < 4; ++kk) {
                    fa[kk] = *(const LAS bf16x8*)(sC + (16 * ti + r) * LD128 + kk * 32 + q * 8);
                    fb[0][kk] = *(const LAS bf16x8*)(sB + (16 * sj0 + r) * LD128 + kk * 32 + q * 8);
                    fb[1][kk] = *(const LAS bf16x8*)(sB + (16 * (sj0 + 1) + r) * LD128 + kk * 32 + q * 8);
                }
                const int t = 16 * ti + r; const float ctv = cumc[t];
                const f32x4 cs0 = *(const LAS f32x4*)(cumc + 16 * sj0 + 4 * q), cs1 = *(const LAS f32x4*)(cumc + 16 * (sj0 + 1) + 4 * q);
                __builtin_amdgcn_sched_barrier(0);
                f32x4 S0 = (f32x4){0.f, 0.f, 0.f, 0.f}, S1 = S0;
#pragma unroll
                for (int kk = 0; kk < 4; ++kk) { S0 = __builtin_amdgcn_mfma_f32_16x16x32_bf16(fb[0][kk], fa[kk], S0, 0, 0, 0); S1 = __builtin_amdgcn_mfma_f32_16x16x32_bf16(fb[1][kk], fa[kk], S1, 0, 0, 0); }
                {
                    float m0[4], m1[4];
#pragma unroll
                    for (int jj = 0; jj < 4; ++jj) {
                        const int s0 = 16 * sj0 + 4 * q + jj, s1 = s0 + 16;
                        m0[jj] = (s0 <= t) ? S0[jj] * __expf(fminf(ctv - cs0[jj], 0.f)) : 0.f;
                        m1[jj] = (s1 <= t) ? S1[jj] * __expf(fminf(ctv - cs1[jj], 0.f)) : 0.f;
                    }
                    u32x2 w0, w1; w0.x = pk2(m0[0], m0[1]); w0.y = pk2(m0[2], m0[3]); w1.x = pk2(m1[0], m1[1]); w1.y = pk2(m1[2], m1[3]);
                    *(LAS u32x2*)(sM + t * LD64 + 16 * sj0 + 4 * q) = w0; *(LAS u32x2*)(sM + t * LD64 + 16 * (sj0 + 1) + 4 * q) = w1;
                }
            }
        }
        if (c0 == 0) {
#pragma unroll
            for (int j = 0; j < 4; ++j) { u32x2 w; w.x = pk2(H[j][0], H[j][1]); w.y = pk2(H[j][2], H[j][3]); *(LAS u32x2*)(sH + (16 * pjs + r) * LD128 + 16 * (ni0 + j) + 4 * q) = w; }
        }
        LBAR();
        {
            const int ti = wave >> 1, pj0 = (wave & 1) * 2;
            const bool yv = 16 * ti < nq;
            bf16x8 sA[4][2], sBf[2];
            f32x4 Y[2];
            Y[0] = (f32x4){0.f, 0.f, 0.f, 0.f}; Y[1] = Y[0];
            if (yv) {
                {
                    bf16x8 aM[2], bX[2][2];
#pragma unroll
                    for (int kk = 0; kk < 2; ++kk) { aM[kk] = *(const LAS bf16x8*)(sM + (16 * ti + r) * LD64 + kk * 32 + q * 8);
                        bX[0][kk] = *(const LAS bf16x8*)(sXdT + SWZ(16 * pj0 + r, kk * 32 + q * 8)); bX[1][kk] = *(const LAS bf16x8*)(sXdT + SWZ(16 * (pj0 + 1) + r, kk * 32 + q * 8)); }
                    __builtin_amdgcn_sched_barrier(0);
#pragma unroll
                    for (int kk = 0; kk < 2; ++kk) { Y[0] = __builtin_amdgcn_mfma_f32_16x16x32_bf16(bX[0][kk], aM[kk], Y[0], 0, 0, 0); Y[1] = __builtin_amdgcn_mfma_f32_16x16x32_bf16(bX[1][kk], aM[kk], Y[1], 0, 0, 0); }
                }
                __builtin_amdgcn_sched_barrier(0);
                {
                    bf16x8 aC[4], bH[2][4];
#pragma unroll
                    for (int kk = 0; kk < 4; ++kk) { aC[kk] = *(const LAS bf16x8*)(sCs + (16 * ti + r) * LD128 + kk * 32 + q * 8);
                        bH[0][kk] = *(const LAS bf16x8*)(sH + (16 * pj0 + r) * LD128 + kk * 32 + q * 8); bH[1][kk] = *(const LAS bf16x8*)(sH + (16 * (pj0 + 1) + r) * LD128 + kk * 32 + q * 8); }
                    __builtin_amdgcn_sched_barrier(0);
#pragma unroll
                    for (int kk = 0; kk < 4; ++kk) { Y[0] = __builtin_amdgcn_mfma_f32_16x16x32_bf16(bH[0][kk], aC[kk], Y[0], 0, 0, 0); Y[1] = __builtin_amdgcn_mfma_f32_16x16x32_bf16(bH[1][kk], aC[kk], Y[1], 0, 0, 0); }
                }
            }
            __builtin_amdgcn_sched_barrier(0);
#pragma unroll
            for (int kk = 0; kk < 2; ++kk) { sBf[kk] = *(const LAS bf16x8*)(sXdT + SWZ(16 * pjs + r, kk * 32 + q * 8));
#pragma unroll
                for (int j = 0; j < 4; ++j) sA[j][kk] = *(const LAS bf16x8*)(sBwT + SWZ(16 * (ni0 + j) + r, kk * 32 + q * 8)); }
            __builtin_amdgcn_sched_barrier(0);
            {
                const float dec = __expf(clast);
#pragma unroll
                for (int j = 0; j < 4; ++j) H[j] = H[j] * dec;
#pragma unroll
                for (int kk = 0; kk < 2; ++kk)
#pragma unroll
                    for (int j = 0; j < 4; ++j) H[j] = __builtin_amdgcn_mfma_f32_16x16x32_bf16(sA[j][kk], sBf[kk], H[j], 0, 0, 0);
            }
            if (yv) {
                const int t = 16 * ti + r;
                float ss = 0.f;
#pragma unroll
                for (int j = 0; j < 2; ++j) {
                    const int p0 = 16 * (pj0 + j) + 4 * q;
                    const u32x2 xw = *(const LAS u32x2*)(sXs + t * LD64 + p0), zw = *(const LAS u32x2*)(sZ + t * LD64 + p0);
                    const float y0 = (Y[j][0] + dsk * bflo(xw.x)) * siluf_(bflo(zw.x)), y1 = (Y[j][1] + dsk * bfhi(xw.x)) * siluf_(bfhi(zw.x));
                    const float y2 = (Y[j][2] + dsk * bflo(xw.y)) * siluf_(bflo(zw.y)), y3 = (Y[j][3] + dsk * bfhi(xw.y)) * siluf_(bfhi(zw.y));
                    ss += (y0 * y0 + y1 * y1) + (y2 * y2 + y3 * y3);
                    u32x2 w; w.x = pk2(y0, y1); w.y = pk2(y2, y3);
                    *(LAS u32x2*)(sZ + t * LD64 + p0) = w;
                }
                ss += shx(ss, 16, lane); ss += shx(ss, 32, lane);
                if (q == 0 && t < nq) (void)__hip_atomic_fetch_add(sssq + t, ss, __ATOMIC_RELAXED, __HIP_MEMORY_SCOPE_WORKGROUP);
            }
        }
        LBAR();
#pragma unroll
        for (int j = 0; j < 4; ++j) { u32x2 w; w.x = pk2(H[j][0], H[j][1]); w.y = pk2(H[j][2], H[j][3]); *(LAS u32x2*)(sH + (16 * pjs + r) * LD128 + 16 * (ni0 + j) + 4 * q) = w; }
        if (zt < nq) *(u32x4*)(L_YN + (size_t)(r0 + c0 + zt) * DINNER + h * 64 + zv * 8) = *(const LAS u32x4*)(sZ + zt * LD64 + zv * 8);
        if (tid < 64) { if (tid < nq) L_SSQ[(size_t)(r0 + c0 + tid) * 32 + h] = sssq[tid]; sssq[tid] = 0.f; }
        __builtin_amdgcn_sched_barrier(0);
    }
    float* so = L_out + (sample ? O_SSSM + ((size_t)(l * DB + b) * NH + h) * (HD * NST) : O_PSSM + ((size_t)(l * NBATCH + b) * NH + h) * (HD * NST));
#pragma unroll
    for (int j = 0; j < 4; ++j) *(f32x4*)(so + (16 * pjs + r) * NST + 16 * (ni0 + j) + 4 * q) = H[j];
    if (!has_next) break;
    u = un; SSD_UNIT(u, sample, b, h, r0, ntok, xoff, zoff, boff);
  }
    LBAR();
}

constexpr int SMP_WAVE_LDS = 14592;
__device__ __forceinline__ void ssd_sample(const Ctx& C_, LAS unsigned char* lds_in, int l) {
    const Ctx C = get_ids(C_.wave);
    LAS unsigned char* lds = lds_in; asm volatile("" : "+s"(lds));
    KP kp = kparams(); unsigned char* ws = kp->ws;
    const float* const L_state_ssm = kp->in[4];
    float* const L_out = kp->out;
    const bf16_t* const L_PROJ = (const bf16_t*)(ws + WS_PROJ);
    const bf16_t* const L_XBCC = (const bf16_t*)(ws + WS_XBCC);
    bf16_t* const L_YN = (bf16_t*)(ws + WS_YN);
    const float* const L_DTS = (const float*)(ws + WS_DTS);
    float* const L_SSQ = (float*)(ws + WS_SSQ);
    const float* const L_a_log = kp->in[15] + l * NH; const float* const L_d_skip = kp->in[16] + l * NH;
    const int lane = C.lane, wave = C.wave, r = lane & 15, q = lane >> 4;
    LAS float* sBf = (LAS float*)(lds + wave * SMP_WAVE_LDS); LAS float* sCf = sBf + 1024; LAS float* sXf = sBf + 2048; LAS float* sZf = sBf + 2560; LAS float* sY2 = sBf + 3072;
    LAS float* sdt = sBf + 3584; LAS float* sdA = sBf + 3592;
    for (int k = C.bid * NWAVES + wave; k < DB * NH; k += C.G * NWAVES) {
        const int b = k / NH, h = k - b * NH, g = h >> 3, r0 = MPROMPT + b * DS;
        const float a_h = -__expf(L_a_log[h]), dsk = L_d_skip[h];
        int ln = lane; asm volatile("" : "+v"(ln));
#pragma unroll 1
        for (int i = 0; i < 5; ++i) {
            const int idx = ln + 64 * i, t = idx / 40, v = idx - t * 40;
            int ch; LAS float* dst;
            if (v < 8) { ch = h * 64 + v * 8; dst = sXf + t * 64 + v * 8; } else if (v < 24) { ch = 2048 + g * 128 + (v - 8) * 8; dst = sBf + t * 128 + (v - 8) * 8; } else { ch = 2560 + g * 128 + (v - 24) * 8; dst = sCf + t * 128 + (v - 24) * 8; }
            const u32x4 w = *(const u32x4*)(L_XBCC + (size_t)(r0 + t) * CONVD + ch); float o[8]; unpack8(w, o);
            *(LAS f32x4*)dst = (f32x4){o[0], o[1], o[2], o[3]}; *(LAS f32x4*)(dst + 4) = (f32x4){o[4], o[5], o[6], o[7]};
        }
        { const int t = ln >> 3, v = ln & 7;
            const u32x4 w = *(const u32x4*)(L_PROJ + (size_t)(r0 + t) * NPROJ + PC_Z + h * 64 + v * 8); float o[8]; unpack8(w, o);
            *(LAS f32x4*)(sZf + t * 64 + v * 8) = (f32x4){o[0], o[1], o[2], o[3]}; *(LAS f32x4*)(sZf + t * 64 + v * 8 + 4) = (f32x4){o[4], o[5], o[6], o[7]}; }
        if (ln < 8) { const float dtv = L_DTS[(size_t)h * MP + r0 + ln]; sdt[ln] = dtv; sdA[ln] = __expf(dtv * a_h); }
        const float* h0 = L_state_ssm + ((size_t)(l * DB + b) * NH + h) * (HD * NST);
        f32x4 hs[4][4][2];
        unsigned hoff = (unsigned)(r * NST + 8 * q); asm volatile("" : "+v"(hoff));
#pragma unroll
        for (int pj = 0; pj < 4; ++pj)
#pragma unroll
            for (int kk = 0; kk < 4; ++kk) { const float* p = h0 + hoff + (16 * pj * NST + 32 * kk); hs[pj][kk][0] = *(const f32x4*)p; hs[pj][kk][1] = *(const f32x4*)(p + 4); }
        LDS_WAIT(); asm volatile("" ::: "memory");
#pragma unroll 1
        for (int t = 0; t < DS; ++t) {
            const float dt = sdt[t], dA = sdA[t];
            float xd[4], y[4];
#pragma unroll
            for (int pj = 0; pj < 4; ++pj) { xd[pj] = sXf[t * 64 + 16 * pj + r] * dt; y[pj] = 0.f; }
#pragma unroll
            for (int kk = 0; kk < 4; ++kk) {
                const f32x4 B0 = *(const LAS f32x4*)(sBf + t * 128 + 32 * kk + 8 * q), B1 = *(const LAS f32x4*)(sBf + t * 128 + 32 * kk + 8 * q + 4);
                const f32x4 C0 = *(const LAS f32x4*)(sCf + t * 128 + 32 * kk + 8 * q), C1 = *(const LAS f32x4*)(sCf + t * 128 + 32 * kk + 8 * q + 4);
#pragma unroll
                for (int pj = 0; pj < 4; ++pj) {
                    f32x4 h0v = hs[pj][kk][0] * dA + B0 * xd[pj], h1v = hs[pj][kk][1] * dA + B1 * xd[pj];
                    hs[pj][kk][0] = h0v; hs[pj][kk][1] = h1v;
                    const f32x4 m0 = C0 * h0v, m1 = C1 * h1v;
                    y[pj] += ((m0.x + m0.y) + (m0.z + m0.w)) + ((m1.x + m1.y) + (m1.z + m1.w));
                }
            }
#pragma unroll
            for (int pj = 0; pj < 4; ++pj) { y[pj] += shx(y[pj], 16, lane); y[pj] += shx(y[pj], 32, lane); }
            const float yv = q == 0 ? y[0] : (q == 1 ? y[1] : (q == 2 ? y[2] : y[3]));
            const float yg = (yv + dsk * sXf[t * 64 + lane]) * siluf_(sZf[t * 64 + lane]);
            L_YN[(size_t)(r0 + t) * DINNER + h * 64 + lane] = (bf16_t)f2bf(yg);
            sY2[t * 64 + lane] = yg * yg;
        }
        LDS_WAIT(); asm volatile("" ::: "memory");
        {
            const LAS float* p = sY2 + (lane >> 3) * 64 + (lane & 7) * 8;
            const f32x4 a = *(const LAS f32x4*)p, c = *(const LAS f32x4*)(p + 4);
            float ss = ((a.x + a.y) + (a.z + a.w)) + ((c.x + c.y) + (c.z + c.w));
            ss += shx(ss, 1, lane); ss += shx(ss, 2, lane); ss += shx(ss, 4, lane);
            if ((lane & 7) == 0) L_SSQ[(size_t)(r0 + (lane >> 3)) * 32 + h] = ss;
        }
        float* so = L_out + O_SSSM + ((size_t)(l * DB + b) * NH + h) * (HD * NST);
#pragma unroll
        for (int pj = 0; pj < 4; ++pj)
#pragma unroll
            for (int kk = 0; kk < 4; ++kk) { float* p = so + hoff + (16 * pj * NST + 32 * kk); *(f32x4*)p = hs[pj][kk][0]; *(f32x4*)(p + 4) = hs[pj][kk][1]; }
        LDS_WAIT(); asm volatile("" ::: "memory");
    }
}

__device__ __forceinline__ void row_bf16_to_f32(const bf16_t* src, float* dst, int ncol, int lane) {
    for (int v = lane; v < ncol / 8; v += 64) { const u32x4 w = *(const u32x4*)(src + v * 8); float o[8]; unpack8(w, o);
        *(f32x4*)(dst + v * 8) = (f32x4){o[0], o[1], o[2], o[3]}; *(f32x4*)(dst + v * 8 + 4) = (f32x4){o[4], o[5], o[6], o[7]}; }
}
__device__ __forceinline__ void row_f32_copy(const float* src, float* dst, int ncol, int lane) {
    for (int v = lane; v < ncol / 4; v += 64) *(f32x4*)(dst + v * 4) = *(const f32x4*)(src + v * 4);
}

template <int MAXW>
__device__ __forceinline__ void pool_load(const bf16_t* PROJ, const float* state_pool, int l, int m, bool sample, int b, int t, int ch, int win, u32x4 (&rw)[MAXW]) {
#pragma unroll
    for (int j = 0; j < MAXW; ++j) { const bool need = (j < win) && (t - j >= 0);
        const u32x4 rv = *(const u32x4*)(PROJ + (size_t)(m - (need ? j : 0)) * NPROJ + PC_U + ch);
        rw[j] = need ? rv : (u32x4){0u, 0u, 0u, 0u}; }
    if (sample && t < win - 1) {
#pragma unroll
        for (int j = 1; j < MAXW; ++j) if (j < win && t - j < 0) {
            const float* pp = state_pool + ((size_t)(l * DB + b) * 15 + (15 + t - j)) * 1024 + ch; rw[j] = pack8v(*(const f32x4*)pp, *(const f32x4*)(pp + 4)); }
    }
}
template <int MAXW>
__device__ __forceinline__ void pool_finish(bf16_t* DBUF, int m, bool sample, int t, int ch, int win, const u32x4 (&rw)[MAXW]) {
    float acc[8], u0[8];
    unpack8(rw[0], u0);
#pragma unroll
    for (int e = 0; e < 8; ++e) acc[e] = u0[e];
#pragma unroll
    for (int j = 1; j < MAXW; ++j) { float xv[8]; unpack8(rw[j], xv);
#pragma unroll
        for (int e = 0; e < 8; ++e) acc[e] += xv[e]; }
    const int cnt = sample ? win : ((t + 1) < win ? (t + 1) : win);
    const float inv = 1.0f / (float)cnt;
    float d[8];
#pragma unroll
    for (int e = 0; e < 8; ++e) d[e] = acc[e] * inv - u0[e];
    *(u32x4*)(DBUF + (size_t)m * 1024 + ch) = pack8(d);
}

__device__ __forceinline__ void mixer_elementwise(const Ctx& C_, int l) {
    const Ctx C = get_ids(C_.wave);
    KP kp = kparams(); unsigned char* ws = kp->ws;
    const float* const L_state_pool = kp->in[2];
    float* const L_out = kp->out;
    const bf16_t* const L_PROJ = (const bf16_t*)(ws + WS_PROJ);
    bf16_t* const L_DBUF = (bf16_t*)(ws + WS_DBUF);
    const int gw = C.bid * NWAVES + C.wave, NGW = C.G * NWAVES, lane = C.lane;
    for (int m = gw; m < MREAL; m += NGW) {
        const bool sample = m >= MPROMPT;
        int b, t; if (sample) { b = (m - MPROMPT) / DS; t = (m - MPROMPT) - b * DS; } else { b = m / LP; t = m - b * LP; }
        const int chA = lane * 8, chB = (lane + 64) * 8, winA = 2 << (chA >> 8), winB = 2 << (chB >> 8);
        u32x4 rwA[4], rwB[16];
        pool_load<4>(L_PROJ, L_state_pool, l, m, sample, b, t, chA, winA, rwA);
        pool_load<16>(L_PROJ, L_state_pool, l, m, sample, b, t, chB, winB, rwB);
        pool_finish<4>(L_DBUF, m, sample, t, chA, winA, rwA);
        pool_finish<16>(L_DBUF, m, sample, t, chB, winB, rwB);
    }
    for (int it = gw; it < (NBATCH + DB) * 15; it += NGW) {
        if (it < NBATCH * 15) { const int b = it / 15, i = it - b * 15;
            row_bf16_to_f32(L_PROJ + (size_t)(b * LP + LP - 15 + i) * NPROJ + PC_U, L_out + O_PPOOL + ((size_t)(l * NBATCH + b) * 15 + i) * 1024, 1024, lane);
        } else { const int k = it - NBATCH * 15, b = k / 15, i = k - b * 15;
            float* dst = L_out + O_SPOOL + ((size_t)(l * DB + b) * 15 + i) * 1024;
            if (i < 7) row_f32_copy(L_state_pool + ((size_t)(l * DB + b) * 15 + 8 + i) * 1024, dst, 1024, lane);
            else row_bf16_to_f32(L_PROJ + (size_t)(MPROMPT + b * DS + (i - 7)) * NPROJ + PC_U, dst, 1024, lane); }
    }
    for (int it = gw; it < (NBATCH + DB) * 3; it += NGW) {
        if (it < NBATCH * 3) { const int b = it / 3, i = it - b * 3;
            row_bf16_to_f32(L_PROJ + (size_t)(b * LP + LP - 3 + i) * NPROJ + PC_XBC, L_out + O_PCONV + ((size_t)(l * NBATCH + b) * 3 + i) * CONVD, CONVD, lane);
        } else { const int k = it - NBATCH * 3, b = k / 3, i = k - b * 3;
            row_bf16_to_f32(L_PROJ + (size_t)(MPROMPT + b * DS + 5 + i) * NPROJ + PC_XBC, L_out + O_SCONV + ((size_t)(l * DB + b) * 3 + i) * CONVD, CONVD, lane); }
    }
}

__device__ __forceinline__ void yn_normalize(const Ctx& C_) {
    const Ctx C = get_ids(C_.wave);
    KP kp = kparams(); unsigned char* ws = kp->ws; (void)ws;
    bf16_t* const L_YN = (bf16_t*)(ws + WS_YN);
    float* const L_SSQ = (float*)(ws + WS_SSQ);
    const int gw = C.bid * NWAVES + C.wave, NGW = C.G * NWAVES, lane = C.lane;
    for (int m = gw; m < MREAL; m += NGW) {
        const f32x4* sp = (const f32x4*)(L_SSQ + (size_t)m * 32);
        float rs[4];
#pragma unroll
        for (int gi = 0; gi < 4; ++gi) { const f32x4 a = sp[2 * gi], b = sp[2 * gi + 1]; rs[gi] = rsqrtf((((a.x + a.y) + (a.z + a.w)) + ((b.x + b.y) + (b.z + b.w))) * (1.0f / 512.0f) + EPS); }
        u32x4 rawv[4];
#pragma unroll
        for (int i = 0; i < 4; ++i) rawv[i] = *(const u32x4*)(L_YN + (size_t)m * DINNER + (lane + 64 * i) * 8);
#pragma unroll
        for (int i = 0; i < 4; ++i) {
            const int v = lane + 64 * i;
            float o[8]; unpack8(rawv[i], o);
            const float s = rs[i];
#pragma unroll
            for (int e = 0; e < 8; ++e) o[e] *= s;
            *(u32x4*)(L_YN + (size_t)m * DINNER + v * 8) = pack8(o);
        }
    }
}

__device__ __forceinline__ void ffn_half(const bf16_t* UP, const float* state_ffn, const float* fw, const float* fb, int l, int m0, int t0, bool sample, int b, int col, float (&res)[8][8]) {
    u32x4 raw[10];
#pragma unroll
    for (int i = 0; i < 10; ++i) raw[i] = *(const u32x4*)(UP + (size_t)(m0 + ((t0 + i - 2 >= 0) ? i - 2 : 0)) * DUP + col);
    if (t0 < 2) {
#pragma unroll
        for (int i = 0; i < 2; ++i) if (t0 + i - 2 < 0) {
            u32x4 rv = (u32x4){0u, 0u, 0u, 0u};
            if (sample) { const float* pp = state_ffn + ((size_t)(l * DB + b) * 2 + i) * DUP + col; rv = pack8v(*(const f32x4*)pp, *(const f32x4*)(pp + 4)); }
            raw[i] = rv; }
    }
    f32x4 w[3][2], bs[2];
#pragma unroll
    for (int k = 0; k < 3; ++k) { w[k][0] = *(const f32x4*)(fw + (size_t)k * DUP + col); w[k][1] = *(const f32x4*)(fw + (size_t)k * DUP + col + 4); }
    bs[0] = *(const f32x4*)(fb + col); bs[1] = *(const f32x4*)(fb + col + 4);
#pragma unroll
    for (int j = 0; j < 8; ++j) { res[j][0] = bs[0].x; res[j][1] = bs[0].y; res[j][2] = bs[0].z; res[j][3] = bs[0].w; res[j][4] = bs[1].x; res[j][5] = bs[1].y; res[j][6] = bs[1].z; res[j][7] = bs[1].w; }
#pragma unroll
    for (int i = 0; i < 10; ++i) {
        float xv[8]; unpack8(raw[i], xv);
#pragma unroll
        for (int k = 0; k < 3; ++k) { const int j = i - k;
            if (j >= 0 && j < 8) {
                res[j][0] += w[k][0].x * xv[0]; res[j][1] += w[k][0].y * xv[1]; res[j][2] += w[k][0].z * xv[2]; res[j][3] += w[k][0].w * xv[3];
                res[j][4] += w[k][1].x * xv[4]; res[j][5] += w[k][1].y * xv[5]; res[j][6] += w[k][1].z * xv[6]; res[j][7] += w[k][1].w * xv[7]; } }
    }
}

__device__ __forceinline__ void ffn_elementwise(const Ctx& C_, int l) {
    const Ctx C = get_ids(C_.wave);
    KP kp = kparams(); unsigned char* ws = kp->ws;
    const float* const L_state_ffn = kp->in[5];
    float* const L_out = kp->out;
    const bf16_t* const L_UP = (const bf16_t*)(ws + WS_UP);
    bf16_t* const L_ACT = (bf16_t*)(ws + WS_ACT);
    const float* fw = kp->in[22] + (size_t)l * 3 * DUP; const float* fb = kp->in[23] + (size_t)l * DUP;
    const int gtid = C.bid * NTHREADS + C.tid, NT = C.G * NTHREADS;
    constexpr int NV = DFF / 8, NSTRIP = MREAL / 8;
    for (int it = gtid; it < NSTRIP * NV; it += NT) {
        const int strip = it / NV, v = it - strip * NV, m0 = strip * 8;
        const bool sample = m0 >= MPROMPT;
        const int t0 = sample ? 0 : (m0 % LP), b = sample ? (m0 - MPROMPT) / DS : 0;
        float gate[8][8], val[8][8];
        ffn_half(L_UP, L_state_ffn, fw, fb, l, m0, t0, sample, b, v * 8, gate);
#pragma unroll
        for (int j = 0; j < 8; ++j)
#pragma unroll
            for (int e = 0; e < 8; ++e) gate[j][e] = siluf_(gate[j][e]);
        ffn_half(L_UP, L_state_ffn, fw, fb, l, m0, t0, sample, b, DFF + v * 8, val);
#pragma unroll
        for (int j = 0; j < 8; ++j) { float a[8];
#pragma unroll
            for (int e = 0; e < 8; ++e) a[e] = gate[j][e] * val[j][e];
            *(u32x4*)(L_ACT + (size_t)(m0 + j) * DFF + v * 8) = pack8(a); }
    }
    const int gw = C.bid * NWAVES + C.wave, NGW = C.G * NWAVES, lane = C.lane;
    for (int it = gw; it < (NBATCH + DB) * 2; it += NGW) {
        if (it < NBATCH * 2) { const int b = it / 2, i = it - b * 2;
            row_bf16_to_f32(L_UP + (size_t)(b * LP + LP - 2 + i) * DUP, L_out + O_PFFN + ((size_t)(l * NBATCH + b) * 2 + i) * DUP, DUP, lane);
        } else { const int k = it - NBATCH * 2, b = k / 2, i = k - b * 2;
            row_bf16_to_f32(L_UP + (size_t)(MPROMPT + b * DS + 6 + i) * DUP, L_out + O_SFFN + ((size_t)(l * DB + b) * 2 + i) * DUP, DUP, lane); }
    }
}

__device__ __forceinline__ void final_norm(const Ctx& C_) {
    const Ctx C = get_ids(C_.wave);
    KP kp = kparams(); unsigned char* ws = kp->ws; (void)ws;
    const float* const L_final_norm_w = kp->in[25];
    float* const L_X = (float*)(ws + WS_X);
    float* const L_RSS = (float*)(ws + WS_RSS);
    float* const L_out = kp->out;
    const int gw = C.bid * NWAVES + C.wave, NGW = C.G * NWAVES, lane = C.lane;
    for (int m = gw; m < MREAL; m += NGW) {
        float* dst;
        if (m < MPROMPT) { const int b = m / LP, t = m - b * LP; if (t < NMETA) continue; dst = L_out + O_YP + ((size_t)b * SEQ + (t - NMETA)) * DM; }
        else dst = L_out + O_YS + (size_t)(m - MPROMPT) * DM;
        const f32x4* p = (const f32x4*)(L_RSS + (size_t)m * 16); const f32x4 a = p[0], b4 = p[1], c = p[2], d = p[3];
        const float s = ((a.x + a.y) + (a.z + a.w)) + ((b4.x + b4.y) + (b4.z + b4.w)) + ((c.x + c.y) + (c.z + c.w)) + ((d.x + d.y) + (d.z + d.w));
        const float rstd = rsqrtf(s * (1.0f / 1024.0f) + EPS);
        f32x4 xin[4], win[4];
#pragma unroll
        for (int j = 0; j < 4; ++j) { xin[j] = ((const f32x4*)(L_X + (size_t)m * DM))[lane + 64 * j]; win[j] = ((const f32x4*)L_final_norm_w)[lane + 64 * j]; }
#pragma unroll
        for (int j = 0; j < 4; ++j) ((f32x4*)dst)[lane + 64 * j] = xin[j] * rstd * win[j];
    }
}

__global__ void __launch_bounds__(NTHREADS, 2) hybrid_fwd(Params P) {
    extern __shared__ __attribute__((aligned(16))) unsigned char lds_raw[];
    LAS unsigned char* lds = (LAS unsigned char*)lds_raw;
    Ctx C;
    {
        const int t0 = threadIdx.x;
        C.tid = t0; C.lane = t0 & 63; C.wave = __builtin_amdgcn_readfirstlane(t0 >> 6); C.G = gridDim.x; C.bid = blockIdx.x;
        if (t0 < 4) ((LAS unsigned*)(lds + LDS_ST_OFF))[t0] = 0u;
        if (t0 == 0) { KP kp0 = kparams(); (void)xb_add((unsigned*)(kp0->ws + WS_CTL) + XB_XCNT(xb_xcc_id()), 1u); }
        __syncthreads();
        cg::this_grid().sync();
    }
#define LG_(x) ({ int v_ = (x); asm volatile("" : "+s"(v_)); v_; })
#define GRID_SYNC() do { KP kpb_ = kparams(); grid_barrier(kpb_->ws, lds, C.wave); } while (0)
    prologue(C, lds);
    GRID_SYNC();

    for (int l = 0; l < DEPTH; ++l) {
        { KP kp = kparams(); unsigned char* ws = kp->ws; pg8::StaticOrder S;
          pg8::Gemm g{WSP(bf16_t, WS_XB), WSP(bf16_t, WS_W1T) + (size_t)l * NPROJ * 1024, 1024, 1024, 1024, 0}; S.init(MP, NPROJ, LG_(C.G), LG_(C.bid));
          pg8::EpiScale E{WSP(bf16_t, WS_PROJ), NPROJ, WSP(float, WS_RSS), WSP(float, WS_DT), PC_DT / 256};
          pg8::gemm_phase(lds, C.wave, g, S, E); }
        GRID_SYNC();
        conv_pass(C, l);
        mixer_elementwise(C, l);
        GRID_SYNC();
        ssd_phase(C, lds, l);
        ssd_sample(C, lds, l);
        __syncthreads();
        { KP kp = kparams(); unsigned char* ws = kp->ws; pg8::StaticOrder S;
          pg8::Gemm g{WSP(bf16_t, WS_DBUF), WSP(bf16_t, WS_PWT) + (size_t)l * 1024 * 256, 1024, 256, 256, 256}; S.init(MP, 1024, LG_(C.G), LG_(C.bid));
          pg8::EpiScale E{WSP(bf16_t, WS_POOLED), 1024, nullptr, nullptr, -1};
          pg8::gemm_phase(lds, C.wave, g, S, E); }
        GRID_SYNC();
        yn_normalize(C);
        { KP kp = kparams(); unsigned char* ws = kp->ws; pg8::StaticOrder S;
          pg8::Gemm g{WSP(bf16_t, WS_POOLED), WSP(bf16_t, WS_WPOT) + (size_t)l * 1024 * 1024, 1024, 1024, 1024, 0}; S.init(pg8::MTAIL0, 1024, LG_(C.G), LG_(C.bid));
          pg8::EpiGate<0> E{WSP(bf16_t, WS_MERGED), 1024, WSP(bf16_t, WS_PROJ) + PC_GA, NPROJ};
          pg8::gemm_phase(lds, C.wave, g, S, E); pg8::gemm_tail(lds, C.wave, g, E); }
        GRID_SYNC();
        { KP kp = kparams(); unsigned char* ws = kp->ws; pg8::StaticOrder S;
          pg8::Gemm g{WSP(bf16_t, WS_YN), WSP(bf16_t, WS_WSOT) + (size_t)l * 1024 * 2048, 2048, 2048, 2048, 0}; S.init(pg8::MTAIL0, 1024, LG_(C.G), LG_(C.bid));
          pg8::EpiGate<1> E{WSP(bf16_t, WS_MERGED), 1024, WSP(bf16_t, WS_PROJ) + PC_GB, NPROJ};
          pg8::gemm_phase(lds, C.wave, g, S, E); pg8::gemm_tail(lds, C.wave, g, E); }
        GRID_SYNC();
        { KP kp = kparams(); unsigned char* ws = kp->ws; pg8::StaticOrder S;
          pg8::Gemm g{WSP(bf16_t, WS_MERGED), WSP(bf16_t, WS_WOT) + (size_t)l * 1024 * 1024, 1024, 1024, 1024, 0}; S.init(pg8::MTAIL0, 1024, LG_(C.G), LG_(C.bid));
          pg8::EpiResid E{WSP(float, WS_X), WSP(bf16_t, WS_XB), WSP(float, WS_RSS)};
          pg8::gemm_phase(lds, C.wave, g, S, E); pg8::gemm_tail(lds, C.wave, g, E); }
        GRID_SYNC();
        { KP kp = kparams(); unsigned char* ws = kp->ws; pg8::StaticOrder S;
          pg8::Gemm g{WSP(bf16_t, WS_XB), WSP(bf16_t, WS_WUPT) + (size_t)l * DUP * 1024, 1024, 1024, 1024, 0}; S.init(MP, DUP, LG_(C.G), LG_(C.bid));
          pg8::EpiScale E{WSP(bf16_t, WS_UP), DUP, WSP(float, WS_RSS), nullptr, -1};
          pg8::gemm_phase(lds, C.wave, g, S, E); }
        GRID_SYNC();
        ffn_elementwise(C, l);
        GRID_SYNC();
        { KP kp = kparams(); unsigned char* ws = kp->ws; pg8::StaticOrder S;
          pg8::Gemm g{WSP(bf16_t, WS_ACT), WSP(bf16_t, WS_WDT) + (size_t)l * 1024 * DFF, DFF, DFF, DFF, 0}; S.init(pg8::MTAIL0, 1024, LG_(C.G), LG_(C.bid));
          pg8::EpiResid E{WSP(float, WS_X), WSP(bf16_t, WS_XB), WSP(float, WS_RSS)};
          pg8::gemm_phase(lds, C.wave, g, S, E); pg8::gemm_tail(lds, C.wave, g, E); }
        GRID_SYNC();
    }
    final_norm(C);
}

extern "C" void kernel_launch(void* const* d_in, const int* in_sizes, int n_in, void* d_out, int out_size, void* d_ws, size_t ws_size, hipStream_t stream) {
    static int grid_blocks = 0;
    if (grid_blocks == 0) {
        if (n_in != 26 || (size_t)out_size != O_END || ws_size < WS_END) {
            fprintf(stderr, "kernel_launch: unexpected shapes: n_in %d out %d (want %zu) ws %zu (want %zu)\n", n_in, out_size, (size_t)O_END, ws_size, (size_t)WS_END); grid_blocks = -1; return; }
        int dev = 0, cus = 0, per_cu = 0;
        hipGetDevice(&dev);
        hipDeviceGetAttribute(&cus, hipDeviceAttributeMultiprocessorCount, dev);
        if (hipFuncSetAttribute((const void*)hybrid_fwd, hipFuncAttributeMaxDynamicSharedMemorySize, LDS_BYTES) != hipSuccess) { fprintf(stderr, "kernel_launch: hipFuncSetAttribute failed\n"); grid_blocks = -1; return; }
        if (hipOccupancyMaxActiveBlocksPerMultiprocessor(&per_cu, (const void*)hybrid_fwd, NTHREADS, LDS_BYTES) != hipSuccess || per_cu < 1) { fprintf(stderr, "kernel_launch: occupancy query gave %d\n", per_cu); per_cu = 1; }
        (void)hipGetLastError();
        grid_blocks = cus * per_cu;
    }
    if (grid_blocks < 0) return;
    if (hipMemsetAsync((char*)d_ws + WS_CTL, 0, WS_CTL_BYTES, stream) != hipSuccess) { fprintf(stderr, "kernel_launch: memset of barrier words failed\n"); return; }
    Params p{};
    for (int i = 0; i < 26; ++i) p.in[i] = (const float*)d_in[i];
    p.out = (float*)d_out; p.ws = (unsigned char*)d_ws;
    void* args[] = {&p};
    hipError_t e = hipLaunchCooperativeKernel((const void*)hybrid_fwd, dim3(grid_blocks), dim3(NTHREADS), args, LDS_BYTES, stream);
    if (e != hipSuccess) fprintf(stderr, "cooperative launch failed: %s (grid %d)\n", hipGetErrorString(e), grid_blocks);
}
```

```cpp
#include <hip/hip_runtime.h>
#include <hip/hip_cooperative_groups.h>
#include <cstdio>
#include <cstdint>
namespace cg = cooperative_groups;

#define LAS __attribute__((address_space(3)))
typedef unsigned short bf16_t;
typedef short bf16x8 __attribute__((ext_vector_type(8)));
typedef float f32x4 __attribute__((ext_vector_type(4)));
typedef unsigned u32x4 __attribute__((ext_vector_type(4)));
typedef unsigned u32x2 __attribute__((ext_vector_type(2)));

constexpr int DM = 1024, NBATCH = 8, SEQ = 2048, NMETA = 16, LP = SEQ + NMETA, DEPTH = 4, DB = 128, DS = 8;
constexpr int MPROMPT = NBATCH * LP;
constexpr int MREAL = MPROMPT + DB * DS;
constexpr int MP = 17664;
constexpr int NH = 32, HD = 64, NG = 4, NST = 128, CONVD = 3072, DFF = 2816, DUP = 5632, DINNER = 2048;
constexpr int NPROJ = 8448;
constexpr int PC_U = 0, PC_Z = 1024, PC_XBC = 3072, PC_GA = 6144, PC_GB = 7168, PC_DT = 8192;
constexpr float EPS = 1e-6f;
constexpr int NTHREADS = 512, NWAVES = 8;
constexpr int LDS_BYTES = 147456;
constexpr int LDS_ST_OFF = LDS_BYTES - 16;

constexpr size_t al256(size_t x) { return (x + 255) & ~(size_t)255; }
constexpr size_t WS_W1T = 0;
constexpr size_t WS_PWT = WS_W1T + al256((size_t)DEPTH * NPROJ * 1024 * 2);
constexpr size_t WS_WPOT = WS_PWT + al256((size_t)DEPTH * 1024 * 256 * 2);
constexpr size_t WS_WSOT = WS_WPOT + al256((size_t)DEPTH * 1024 * 1024 * 2);
constexpr size_t WS_WOT = WS_WSOT + al256((size_t)DEPTH * 1024 * 2048 * 2);
constexpr size_t WS_WUPT = WS_WOT + al256((size_t)DEPTH * 1024 * 1024 * 2);
constexpr size_t WS_WDT = WS_WUPT + al256((size_t)DEPTH * DUP * 1024 * 2);
constexpr size_t WS_X = WS_WDT + al256((size_t)DEPTH * 1024 * DFF * 2);
constexpr size_t WS_XB = WS_X + al256((size_t)MP * 1024 * 4);
constexpr size_t WS_RSS = WS_XB + al256((size_t)MP * 1024 * 2);
constexpr size_t WS_PROJ = WS_RSS + al256((size_t)MP * 16 * 4);
constexpr size_t WS_DT = WS_PROJ + al256((size_t)MP * NPROJ * 2);
constexpr size_t WS_DBUF = WS_DT + al256((size_t)MP * 32 * 4);
constexpr size_t WS_POOLED = WS_DBUF + al256((size_t)MP * 1024 * 2);
constexpr size_t WS_YN = WS_POOLED + al256((size_t)MP * 1024 * 2);
constexpr size_t WS_SSQ = WS_YN + al256((size_t)MP * 2048 * 2);
constexpr size_t WS_MERGED = WS_SSQ + al256((size_t)MP * 32 * 4);
constexpr size_t WS_UP = WS_MERGED + al256((size_t)MP * 1024 * 2);
constexpr size_t WS_ACT = WS_UP + al256((size_t)MP * DUP * 2);
constexpr size_t WS_XBCC = WS_ACT + al256((size_t)MP * DFF * 2);
constexpr size_t WS_DTS = WS_XBCC + al256((size_t)MP * CONVD * 2);
constexpr size_t WS_CTL = WS_DTS + al256((size_t)MP * 32 * 4);
constexpr size_t WS_CTL_BYTES = 16384;
constexpr size_t WS_END = WS_CTL + WS_CTL_BYTES;

constexpr size_t O_YP = 0;
constexpr size_t O_YS = O_YP + (size_t)NBATCH * SEQ * DM;
constexpr size_t O_PPOOL = O_YS + (size_t)DB * DS * DM;
constexpr size_t O_PCONV = O_PPOOL + (size_t)DEPTH * NBATCH * 15 * 1024;
constexpr size_t O_PSSM = O_PCONV + (size_t)DEPTH * NBATCH * 3 * CONVD;
constexpr size_t O_PFFN = O_PSSM + (size_t)DEPTH * NBATCH * NH * HD * NST;
constexpr size_t O_SPOOL = O_PFFN + (size_t)DEPTH * NBATCH * 2 * DUP;
constexpr size_t O_SCONV = O_SPOOL + (size_t)DEPTH * DB * 15 * 1024;
constexpr size_t O_SSSM = O_SCONV + (size_t)DEPTH * DB * 3 * CONVD;
constexpr size_t O_SFFN = O_SSSM + (size_t)DEPTH * DB * NH * HD * NST;
constexpr size_t O_END = O_SFFN + (size_t)DEPTH * DB * 2 * DUP;

__device__ __forceinline__ unsigned cvt_pk_bf16(float lo, float hi) { unsigned r; asm("v_cvt_pk_bf16_f32 %0, %1, %2" : "=v"(r) : "v"(lo), "v"(hi)); return r; }
__device__ __forceinline__ unsigned f2bf(float f) { return cvt_pk_bf16(f, f) & 0xffffu; }
__device__ __forceinline__ unsigned pk2(float lo, float hi) { return cvt_pk_bf16(lo, hi); }
__device__ __forceinline__ float bflo(unsigned w) { return __builtin_bit_cast(float, w << 16); }
__device__ __forceinline__ float bfhi(unsigned w) { return __builtin_bit_cast(float, w & 0xffff0000u); }
__device__ __forceinline__ float bf1(bf16_t h) { return __builtin_bit_cast(float, ((unsigned)h) << 16); }
__device__ __forceinline__ float sigmoidf_(float x) { return __builtin_amdgcn_rcpf(1.0f + __expf(-x)); }
__device__ __forceinline__ float siluf_(float x) { return x * sigmoidf_(x); }
__device__ __forceinline__ void unpack8(const u32x4 w, float (&o)[8]) {
    o[0] = bflo(w.x); o[1] = bfhi(w.x); o[2] = bflo(w.y); o[3] = bfhi(w.y); o[4] = bflo(w.z); o[5] = bfhi(w.z); o[6] = bflo(w.w); o[7] = bfhi(w.w);
}
__device__ __forceinline__ u32x4 pack8(const float (&o)[8]) {
    u32x4 w; w.x = pk2(o[0], o[1]); w.y = pk2(o[2], o[3]); w.z = pk2(o[4], o[5]); w.w = pk2(o[6], o[7]); return w;
}
__device__ __forceinline__ float shx(float v, int m, int lane) { return __builtin_bit_cast(float, __builtin_amdgcn_ds_bpermute((lane ^ m) << 2, __builtin_bit_cast(int, v))); }
__device__ __forceinline__ float shup(float v, int d, int lane) { return __builtin_bit_cast(float, __builtin_amdgcn_ds_bpermute((lane - d) << 2, __builtin_bit_cast(int, v))); }
__device__ __forceinline__ float shidx(float v, int src) { return __builtin_bit_cast(float, __builtin_amdgcn_ds_bpermute(src << 2, __builtin_bit_cast(int, v))); }
__device__ __forceinline__ float wave_sum(float v) {
#pragma unroll
    for (int o = 1; o < 64; o <<= 1) v += __shfl_xor(v, o);
    return v;
}
__device__ __forceinline__ u32x4 pack8v(const f32x4 a, const f32x4 b) { u32x4 w; w.x = pk2(a.x, a.y); w.y = pk2(a.z, a.w); w.z = pk2(b.x, b.y); w.w = pk2(b.z, b.w); return w; }
#define LDS_WAIT() asm volatile("s_waitcnt lgkmcnt(0)" ::: "memory")
#define LBAR() do { asm volatile("s_waitcnt lgkmcnt(0)" ::: "memory"); __builtin_amdgcn_s_barrier(); asm volatile("" ::: "memory"); } while (0)

namespace pg8 {
constexpr int BM = 256, BK = 64, HALF = 128, HTB = HALF * BK * 2, STAGE_BYTES = 8 * HTB, NXCD = 8, WGM = 8;
__host__ __device__ __forceinline__ int lds_byte(int r, int c) { const int st = (r >> 4) * 2 + (c >> 5), rr = r & 15, cc = c & 31, ob = rr * 64 + cc * 2; return st * 1024 + (ob ^ (((ob >> 9) & 1) << 5)); }
__host__ __device__ __forceinline__ void stage_rc(int b, int& R, int& C) { const int st = b / 1024, sb = b % 1024, swz = sb ^ (((sb >> 9) & 1) << 5); R = (st >> 1) * 16 + swz / 64; C = (st & 1) * 32 + (swz % 64) / 2; }
__host__ __device__ __forceinline__ int perm32(int rho) { const int n = rho >> 4, i = rho & 15; return 8 * (i >> 2) + 4 * n + (i & 3); }

struct Unit { int pm, pn; };
struct Gemm { const bf16_t* A; const bf16_t* Bt; int lda, ldb, K, a_pn_off; };

struct StaticOrder {
    int nM, nN, nwg, G, c;
    __device__ void init(int M, int N, int G_, int c_) { nM = M / BM; nN = N / BM; nwg = nM * nN; G = G_; c = c_; }
    __device__ bool next(int i, Unit& u) const {
        const long L = (long)i * G + c; if (L >= nwg) return false;
        int wgid = (int)L; { const int q = nwg / NXCD, r = nwg % NXCD, xcd = wgid % NXCD, off = wgid / NXCD; wgid = (xcd < r ? xcd * (q + 1) : r * (q + 1) + (xcd - r) * q) + off; }
        const int nig = WGM * nN, gid = wgid / nig, fm = gid * WGM, gsz = (nM - fm) < WGM ? (nM - fm) : WGM;
        u.pm = fm + ((wgid % nig) % gsz); u.pn = (wgid % nig) / gsz; return true;
    }
};


struct EpiScale {
    bf16_t* O; int ldc; const float* rss; float* dtf; int dt_pn;
    __device__ __forceinline__ void operator()(const f32x4 (&acc)[2][2][4][2], const Unit& u, int wr, int wc, int fr, int fq) const {
        const int row0 = u.pm * BM + wr * 64 + fr, col0 = u.pn * BM + wc * 32 + 8 * fq;
#pragma unroll
        for (int ai = 0; ai < 2; ++ai)
#pragma unroll
            for (int m = 0; m < 4; ++m) {
                const int row = row0 + ai * HALF + m * 16;
                float sc = 1.f;
                if (rss) { const f32x4* p = (const f32x4*)(rss + (size_t)row * 16); const f32x4 a = p[0], b = p[1], c = p[2], d = p[3];
                    const float s = ((a.x + a.y) + (a.z + a.w)) + ((b.x + b.y) + (b.z + b.w)) + ((c.x + c.y) + (c.z + c.w)) + ((d.x + d.y) + (d.z + d.w));
                    sc = rsqrtf(s * (1.0f / 1024.0f) + EPS); }
                bf16_t* rowp = O + (size_t)row * ldc + col0;
#pragma unroll
                for (int bj = 0; bj < 2; ++bj) { const f32x4 v0 = acc[ai][bj][m][0] * sc, v1 = acc[ai][bj][m][1] * sc;
                    u32x4 w; w.x = cvt_pk_bf16(v0[0], v0[1]); w.y = cvt_pk_bf16(v0[2], v0[3]); w.z = cvt_pk_bf16(v1[0], v1[1]); w.w = cvt_pk_bf16(v1[2], v1[3]);
                    *(u32x4*)(rowp + bj * HALF) = w;
                    if (bj == 0 && dtf != nullptr && u.pn == dt_pn && wc == 0) { float* dp = dtf + (size_t)row * 32 + 8 * fq; *(f32x4*)dp = v0; *(f32x4*)(dp + 4) = v1; } }
            }
    }
};
template <int MODE> struct EpiGate {
    bf16_t* O; int ldc; const bf16_t* gate; int ldg;
    struct Pre { u32x2 gw, ow; };
    __device__ __forceinline__ Pre tail4_pre(int row, int col) const { Pre p; p.gw = *(const u32x2*)(gate + (size_t)row * ldg + col); p.ow = (u32x2){0u, 0u};
        if (MODE == 1) p.ow = *(const u32x2*)(O + (size_t)row * ldc + col); return p; }
    __device__ __forceinline__ void tail4(const f32x4 v, const Pre& pre, int row, int col, int l16) const {
        const u32x2 gw = pre.gw;
        float v0 = sigmoidf_(bflo(gw.x)) * v[0], v1 = sigmoidf_(bfhi(gw.x)) * v[1], v2 = sigmoidf_(bflo(gw.y)) * v[2], v3 = sigmoidf_(bfhi(gw.y)) * v[3];
        bf16_t* op = O + (size_t)row * ldc + col;
        if (MODE == 1) { const u32x2 ow = pre.ow; v0 += bflo(ow.x); v1 += bfhi(ow.x); v2 += bflo(ow.y); v3 += bfhi(ow.y); }
        u32x2 w; w.x = cvt_pk_bf16(v0, v1); w.y = cvt_pk_bf16(v2, v3);
        *(u32x2*)op = w;
    }
    __device__ __forceinline__ void operator()(const f32x4 (&acc)[2][2][4][2], const Unit& u, int wr, int wc, int fr, int fq) const {
        const int row0 = u.pm * BM + wr * 64 + fr, col0 = u.pn * BM + wc * 32 + 8 * fq;
#pragma unroll
        for (int ai = 0; ai < 2; ++ai) {
            u32x4 gwv[4][2], owv[4][2];
#pragma unroll
            for (int m = 0; m < 4; ++m)
#pragma unroll
                for (int bj = 0; bj < 2; ++bj) { const size_t row = (size_t)(row0 + ai * HALF + m * 16);
                    gwv[m][bj] = *(const u32x4*)(gate + row * ldg + col0 + bj * HALF);
                    if (MODE == 1) owv[m][bj] = *(const u32x4*)(O + row * ldc + col0 + bj * HALF); }
#pragma unroll
            for (int m = 0; m < 4; ++m) {
                bf16_t* rowp = O + (size_t)(row0 + ai * HALF + m * 16) * ldc + col0;
#pragma unroll
                for (int bj = 0; bj < 2; ++bj) {
                    float g[8]; unpack8(gwv[m][bj], g);
                    const f32x4 a0 = acc[ai][bj][m][0], a1 = acc[ai][bj][m][1];
                    float v[8];
                    v[0] = sigmoidf_(g[0]) * a0[0]; v[1] = sigmoidf_(g[1]) * a0[1]; v[2] = sigmoidf_(g[2]) * a0[2]; v[3] = sigmoidf_(g[3]) * a0[3];
                    v[4] = sigmoidf_(g[4]) * a1[0]; v[5] = sigmoidf_(g[5]) * a1[1]; v[6] = sigmoidf_(g[6]) * a1[2]; v[7] = sigmoidf_(g[7]) * a1[3];
                    if (MODE == 1) { float o[8]; unpack8(owv[m][bj], o);
#pragma unroll
                        for (int e = 0; e < 8; ++e) v[e] += o[e]; }
                    u32x4 w; w.x = cvt_pk_bf16(v[0], v[1]); w.y = cvt_pk_bf16(v[2], v[3]); w.z = cvt_pk_bf16(v[4], v[5]); w.w = cvt_pk_bf16(v[6], v[7]);
                    *(u32x4*)(rowp + bj * HALF) = w; }
            }
        }
    }
};
struct EpiResid {
    float* X; bf16_t* XB; float* rss;
    struct Pre { f32x4 x; };
    __device__ __forceinline__ Pre tail4_pre(int row, int col) const { Pre p; p.x = *(const f32x4*)(X + (size_t)row * DM + col); return p; }
    __device__ __forceinline__ void tail4(const f32x4 v, const Pre& pre, int row, int col, int l16) const {
        float* xp = X + (size_t)row * DM + col;
        f32x4 x0 = pre.x; x0 += v; *(f32x4*)xp = x0;
        float ss = (x0[0] * x0[0] + x0[1] * x0[1]) + (x0[2] * x0[2] + x0[3] * x0[3]);
        u32x2 w; w.x = cvt_pk_bf16(x0[0], x0[1]); w.y = cvt_pk_bf16(x0[2], x0[3]);
        *(u32x2*)(XB + (size_t)row * DM + col) = w;
        ss += shx(ss, 1, l16); ss += shx(ss, 2, l16); ss += shx(ss, 4, l16); ss += shx(ss, 8, l16);
        if ((l16 & 15) == 0) rss[(size_t)row * 16 + (col >> 6)] = ss;
    }
    __device__ __forceinline__ void operator()(const f32x4 (&acc)[2][2][4][2], const Unit& u, int wr, int wc, int fr, int fq) const {
        const int row0 = u.pm * BM + wr * 64 + fr, col0 = u.pn * BM + wc * 32 + 8 * fq;
#pragma unroll
        for (int ai = 0; ai < 2; ++ai)
#pragma unroll
            for (int mp = 0; mp < 2; ++mp) {
                f32x4 xv[2][2][2];
#pragma unroll
                for (int mm = 0; mm < 2; ++mm)
#pragma unroll
                    for (int bj = 0; bj < 2; ++bj) { const float* xp = X + (size_t)(row0 + ai * HALF + (2 * mp + mm) * 16) * DM + col0 + bj * HALF;
                        xv[mm][bj][0] = *(const f32x4*)xp; xv[mm][bj][1] = *(const f32x4*)(xp + 4); }
#pragma unroll
                for (int mm = 0; mm < 2; ++mm) {
                    const int m = 2 * mp + mm, row = row0 + ai * HALF + m * 16;
                    float* xp = X + (size_t)row * DM + col0; bf16_t* bp = XB + (size_t)row * DM + col0;
                    float ss = 0.f;
#pragma unroll
                    for (int bj = 0; bj < 2; ++bj) {
                        f32x4 x0 = xv[mm][bj][0], x1 = xv[mm][bj][1];
                        x0 += acc[ai][bj][m][0]; x1 += acc[ai][bj][m][1];
                        *(f32x4*)(xp + bj * HALF) = x0; *(f32x4*)(xp + bj * HALF + 4) = x1;
                        ss += (x0[0] * x0[0] + x0[1] * x0[1]) + (x0[2] * x0[2] + x0[3] * x0[3]) + (x1[0] * x1[0] + x1[1] * x1[1]) + (x1[2] * x1[2] + x1[3] * x1[3]);
                        u32x4 w; w.x = cvt_pk_bf16(x0[0], x0[1]); w.y = cvt_pk_bf16(x0[2], x0[3]); w.z = cvt_pk_bf16(x1[0], x1[1]); w.w = cvt_pk_bf16(x1[2], x1[3]);
                        *(u32x4*)(bp + bj * HALF) = w; }
                    ss += shx(ss, 16, fq * 16 + fr); ss += shx(ss, 32, fq * 16 + fr);
                    if (fq == 0) rss[(size_t)row * 16 + u.pn * 4 + wc] = ss;
                }
            }
    }
};

template <class Epi>
__device__ __forceinline__ void gemm_phase(LAS unsigned char* lds_in, int wave_in, const Gemm g, const StaticOrder& S, const Epi& E) {
    int lane = (int)__builtin_amdgcn_mbcnt_hi(~0u, __builtin_amdgcn_mbcnt_lo(~0u, 0u)); asm volatile("" : "+v"(lane));
    int wid = wave_in; asm volatile("" : "+s"(wid));
    const int tid = wid * 64 + lane;
    LAS unsigned char* lds = lds_in; asm volatile("" : "+s"(lds));
    const int wr = wid >> 2, wc = wid & 3, fr = lane & 15, fq = lane >> 4;
    const int K = g.K, nt = K / BK;
    unsigned voffA[2], voffB[2];
#pragma unroll
    for (int i = 0; i < 2; ++i) { int R, C; stage_rc(tid * 16 + i * 8192, R, C); const int Rb = (R & ~31) + perm32(R & 31);
        voffA[i] = (unsigned)(R * g.lda + C) * 2u; voffB[i] = (unsigned)(Rb * g.ldb + C) * 2u; }
    const size_t kstep = (size_t)(BK * 2);
    const size_t hstepA = (size_t)HALF * g.lda * 2, hstepB = (size_t)HALF * g.ldb * 2;
    const size_t tstepA = 2 * hstepA, tstepB = 2 * hstepB;
    const unsigned ldsw = (unsigned)wid * 1024u;
    const int aoff = lds_byte(wr * 64 + fr, fq * 8), boff = lds_byte(wc * 32 + fr, fq * 8);
#define PG8_SA(b, h) (((b) * 2 + (h)) * HTB)
#define PG8_SB(b, h) ((4 + (b) * 2 + (h)) * HTB)
#define PG8_STAGE(bufoff, gbase, voff) do { _Pragma("unroll") for (int _i = 0; _i < 2; ++_i) \
        __builtin_amdgcn_global_load_lds((const unsigned*)((const char*)(gbase) + (voff)[_i]), (LAS unsigned*)(lds + (bufoff) + ldsw + _i * 8192), 16, 0, 0); } while (0)
#define PG8_LDA(dst, b, h) do { _Pragma("unroll") for (int m = 0; m < 4; ++m) _Pragma("unroll") for (int k = 0; k < 2; ++k) dst[m][k] = *(const LAS bf16x8*)(lds + PG8_SA(b, h) + aoff + m * 2048 + k * 1024); } while (0)
#define PG8_LDB(dst, b, h) do { _Pragma("unroll") for (int n = 0; n < 2; ++n) _Pragma("unroll") for (int k = 0; k < 2; ++k) dst[n][k] = *(const LAS bf16x8*)(lds + PG8_SB(b, h) + boff + n * 2048 + k * 1024); } while (0)
#define PG8_MMA(ai, bj, At, Bt) do { __builtin_amdgcn_s_setprio(1); _Pragma("unroll") for (int m = 0; m < 4; ++m) _Pragma("unroll") for (int n = 0; n < 2; ++n) _Pragma("unroll") for (int k = 0; k < 2; ++k) \
        acc[ai][bj][m][n] = __builtin_amdgcn_mfma_f32_16x16x32_bf16(Bt[n][k], At[m][k], acc[ai][bj][m][n], 0, 0, 0); __builtin_amdgcn_s_setprio(0); } while (0)
#define PG8_WAIT_V(n) asm volatile("s_waitcnt vmcnt(" #n ")" ::: "memory")
#define PG8_WAIT_L(n) asm volatile("s_waitcnt lgkmcnt(" #n ")" ::: "memory")
#define PG8_BAR __builtin_amdgcn_s_barrier()
#define PG8_SCHED __builtin_amdgcn_sched_barrier(0)
    Unit cur, nxt; int ui = 0;
    if (!S.next(0, cur)) return;
    f32x4 acc[2][2][4][2];
#pragma unroll
    for (int a = 0; a < 2; ++a)
#pragma unroll
        for (int b = 0; b < 2; ++b)
#pragma unroll
            for (int m = 0; m < 4; ++m)
#pragma unroll
                for (int n = 0; n < 2; ++n) acc[a][b][m][n] = (f32x4){0.f, 0.f, 0.f, 0.f};
    bf16x8 At[4][2], B0[2][2], B1[2][2];
    const char* cA = (const char*)g.A + (size_t)cur.pm * tstepA + (size_t)cur.pn * g.a_pn_off * 2; const char* cB = (const char*)g.Bt + (size_t)cur.pn * tstepB;
    PG8_STAGE(PG8_SB(0, 0), cB, voffB); PG8_STAGE(PG8_SB(0, 1), cB + hstepB, voffB); PG8_STAGE(PG8_SA(0, 0), cA, voffA); PG8_STAGE(PG8_SA(0, 1), cA + hstepA, voffA);
    if (wr == 1) PG8_BAR;
    PG8_WAIT_V(2); PG8_BAR;
    PG8_STAGE(PG8_SB(1, 0), cB + kstep, voffB); PG8_STAGE(PG8_SA(1, 0), cA + kstep, voffA); PG8_STAGE(PG8_SB(1, 1), cB + hstepB + kstep, voffB);
    PG8_WAIT_V(6); PG8_BAR;
    for (;;) {
        const bool has_next = S.next(ui + 1, nxt);
        const char* nA = has_next ? (const char*)g.A + (size_t)nxt.pm * tstepA + (size_t)nxt.pn * g.a_pn_off * 2 : cA; const char* nB = has_next ? (const char*)g.Bt + (size_t)nxt.pn * tstepB : cB;
        for (int t = 0; t < nt; t += 2) {
            const bool last = (t == nt - 2);
            const char* a1 = cA + (size_t)(t + 1) * kstep;
            const char* a2 = last ? nA : cA + (size_t)(t + 2) * kstep; const char* b2 = last ? nB : cB + (size_t)(t + 2) * kstep;
            const char* a3 = a2 + kstep; const char* b3 = b2 + kstep;
            PG8_LDB(B0, 0, 0); PG8_LDB(B1, 0, 1); PG8_SCHED; PG8_LDA(At, 0, 0); PG8_STAGE(PG8_SA(1, 1), a1 + hstepA, voffA);
            PG8_WAIT_V(8); PG8_WAIT_L(0); PG8_BAR; PG8_MMA(0, 0, At, B0); PG8_MMA(0, 1, At, B1); PG8_BAR; PG8_SCHED;
            PG8_LDA(At, 0, 1); PG8_STAGE(PG8_SB(0, 0), b2, voffB); PG8_STAGE(PG8_SB(0, 1), b2 + hstepB, voffB); PG8_STAGE(PG8_SA(0, 0), a2, voffA);
            PG8_WAIT_V(8); PG8_WAIT_L(0); PG8_BAR; PG8_MMA(1, 0, At, B0); PG8_MMA(1, 1, At, B1); PG8_BAR; PG8_SCHED;
            PG8_LDB(B0, 1, 0); PG8_LDB(B1, 1, 1); PG8_SCHED; PG8_LDA(At, 1, 0); PG8_STAGE(PG8_SA(0, 1), a2 + hstepA, voffA);
            PG8_WAIT_V(8); PG8_WAIT_L(0); PG8_BAR; PG8_MMA(0, 0, At, B0); PG8_MMA(0, 1, At, B1); PG8_BAR; PG8_SCHED;
            PG8_LDA(At, 1, 1); PG8_STAGE(PG8_SB(1, 0), b3, voffB); PG8_STAGE(PG8_SB(1, 1), b3 + hstepB, voffB); PG8_STAGE(PG8_SA(1, 0), a3, voffA);
            PG8_WAIT_V(8); PG8_WAIT_L(0); PG8_BAR; PG8_MMA(1, 0, At, B0); PG8_MMA(1, 1, At, B1); PG8_BAR; PG8_SCHED;
        }
        if (wr == 0) PG8_BAR;
        E(acc, cur, wr, wc, fr, fq);
        if (!has_next) break;
#pragma unroll
        for (int a = 0; a < 2; ++a)
#pragma unroll
            for (int b = 0; b < 2; ++b)
#pragma unroll
                for (int m = 0; m < 4; ++m)
#pragma unroll
                    for (int n = 0; n < 2; ++n) acc[a][b][m][n] = (f32x4){0.f, 0.f, 0.f, 0.f};
        cur = nxt; cA = nA; cB = nB; ++ui;
        if (wr == 1) PG8_BAR;
    }
    PG8_WAIT_V(0);
    PG8_BAR;
#undef PG8_SA
#undef PG8_SB
#undef PG8_STAGE
#undef PG8_LDA
#undef PG8_LDB
#undef PG8_MMA
#undef PG8_WAIT_V
#undef PG8_WAIT_L
#undef PG8_BAR
#undef PG8_SCHED
}

constexpr int MTAIL0 = 16384;
template <class Epi>
__device__ __forceinline__ void gemm_tail(LAS unsigned char* lds_in, int wave_in, const Gemm g, const Epi& E) {
    int lane = (int)__builtin_amdgcn_mbcnt_hi(~0u, __builtin_amdgcn_mbcnt_lo(~0u, 0u)); asm volatile("" : "+v"(lane));
    int wid = wave_in; asm volatile("" : "+s"(wid));
    LAS unsigned char* lds = lds_in; asm volatile("" : "+s"(lds));
    int G = gridDim.x, bid = blockIdx.x; asm volatile("" : "+s"(G)); asm volatile("" : "+s"(bid));
    const int r = lane & 15, q = lane >> 4;
    constexpr int NRT = (MREAL - MTAIL0) / 32, NCT = 1024 / 64;
    const int klen = g.K / 8, kbeg = wid * klen;
    const int nx = (G % 8 == 0) ? 8 : 1, x = (nx == 8) ? (bid & 7) : 0, j = (nx == 8) ? (bid >> 3) : bid, nj = G / nx;
    const int ct_per = NCT / nx, ntile = NRT * ct_per;
    LAS float* red = (LAS float*)lds;
    const size_t a16 = (size_t)16 * g.lda, b16 = (size_t)16 * g.ldb;
    bf16x8 pa[4][2], pb[4][4];
#define TAIL_PTRS(tt_, rt_, ct_, row0_, col0_, ap_, bp_) const int rt_ = (tt_) % NRT, ct_ = x * ct_per + (tt_) / NRT, row0_ = MTAIL0 + 32 * rt_, col0_ = 64 * ct_; \
        const bf16_t* ap_ = g.A + (size_t)(row0_ + r) * g.lda + 8 * q + kbeg + (size_t)(col0_ >> 8) * g.a_pn_off; const bf16_t* bp_ = g.Bt + (size_t)(col0_ + r) * g.ldb + 8 * q + kbeg; (void)rt_; (void)ct_;
#define TAIL_PF(ap_, bp_) do { _Pragma("unroll") for (int s_ = 0; s_ < 4; ++s_) { _Pragma("unroll") for (int i = 0; i < 2; ++i) pa[s_][i] = *(const bf16x8*)((ap_) + i * a16 + 32 * s_); \
        _Pragma("unroll") for (int f = 0; f < 4; ++f) pb[s_][f] = *(const bf16x8*)((bp_) + f * b16 + 32 * s_); } } while (0)
    if (j < ntile) { TAIL_PTRS(j, rt0, ct0, row00, col00, ap0, bp0); (void)row00; TAIL_PF(ap0, bp0); }
    for (int tt = j; tt < ntile; tt += nj) {
        TAIL_PTRS(tt, rt, ct, row0, col0, ap, bp);
        const int rr = 4 * wid + (lane >> 4), cc = 4 * (lane & 15);
        const typename Epi::Pre pre = E.tail4_pre(row0 + rr, col0 + cc);
        f32x4 acc[2][4];
#pragma unroll
        for (int i = 0; i < 2; ++i)
#pragma unroll
            for (int f = 0; f < 4; ++f) acc[i][f] = (f32x4){0.f, 0.f, 0.f, 0.f};
#pragma unroll
        for (int s_ = 0; s_ < 4; ++s_)
#pragma unroll
            for (int i = 0; i < 2; ++i)
#pragma unroll
                for (int f = 0; f < 4; ++f) acc[i][f] = __builtin_amdgcn_mfma_f32_16x16x32_bf16(pb[s_][f], pa[s_][i], acc[i][f], 0, 0, 0);
#pragma unroll 4
        for (int k0 = 128; k0 < klen; k0 += 32) {
            bf16x8 a[2], b[4];
#pragma unroll
            for (int i = 0; i < 2; ++i) a[i] = *(const bf16x8*)(ap + i * a16 + k0);
#pragma unroll
            for (int f = 0; f < 4; ++f) b[f] = *(const bf16x8*)(bp + f * b16 + k0);
#pragma unroll
            for (int i = 0; i < 2; ++i)
#pragma unroll
                for (int f = 0; f < 4; ++f) acc[i][f] = __builtin_amdgcn_mfma_f32_16x16x32_bf16(b[f], a[i], acc[i][f], 0, 0, 0);
        }
        __builtin_amdgcn_sched_barrier(0);
        if (tt + nj < ntile) { TAIL_PTRS(tt + nj, rtn, ctn, row0n, col0n, apn, bpn); (void)row0n; TAIL_PF(apn, bpn); }
        __builtin_amdgcn_sched_barrier(0);
#pragma unroll
        for (int i = 0; i < 2; ++i)
#pragma unroll
            for (int f = 0; f < 4; ++f) *(LAS f32x4*)(red + wid * 2048 + (16 * i + r) * 64 + 16 * f + 4 * q) = acc[i][f];
        LBAR();
        {
            f32x4 v = (f32x4){0.f, 0.f, 0.f, 0.f};
#pragma unroll
            for (int w = 0; w < 8; ++w) v += *(const LAS f32x4*)(red + w * 2048 + rr * 64 + cc);
            E.tail4(v, pre, row0 + rr, col0 + cc, lane);
        }
        LBAR();
    }
#undef TAIL_PTRS
#undef TAIL_PF
}
}

struct Params { const float* in[26]; float* out; unsigned char* ws; };

typedef const Params __attribute__((address_space(4)))* KP;
__device__ __forceinline__ KP kparams() { KP p = (KP)__builtin_amdgcn_kernarg_segment_ptr(); asm volatile("" : "+s"(p)); return p; }
struct Ctx { int tid, lane, wave, G, bid; };
__device__ __forceinline__ Ctx get_ids(int wave_in) { Ctx I;
    int ln = (int)__builtin_amdgcn_mbcnt_hi(~0u, __builtin_amdgcn_mbcnt_lo(~0u, 0u)); asm volatile("" : "+v"(ln));
    int wv = wave_in; asm volatile("" : "+s"(wv));
    int gg = gridDim.x, bb = blockIdx.x; asm volatile("" : "+s"(gg)); asm volatile("" : "+s"(bb));
    I.lane = ln; I.wave = wv; I.tid = wv * 64 + ln; I.G = gg; I.bid = bb; return I; }

#define XB_TMO      128
#define XB_XCNT(j)  (256  + 64 * (j))
#define XB_XSUB(j)  (1280 + 64 * (j))
#define XB_XGEN(j)  (2304 + 64 * (j))
#define XB_TOP      3328
#define XB_TOPGEN   3392
#define XCD_BAR_WORDS 3456
#define XB_SPIN_CAP (1u << 20)
__device__ __forceinline__ unsigned xb_ld(unsigned* p)              { return __hip_atomic_load(p, __ATOMIC_RELAXED, __HIP_MEMORY_SCOPE_AGENT); }
__device__ __forceinline__ unsigned xb_add(unsigned* p, unsigned v) { return __hip_atomic_fetch_add(p, v, __ATOMIC_RELAXED, __HIP_MEMORY_SCOPE_AGENT); }
__device__ __forceinline__ unsigned xb_xcc_id() { return (unsigned)__builtin_amdgcn_s_getreg((3 << 11) | 20) & 0xFu; }
#define XB_SPIN(cond, bar) do { unsigned _sp = 0; while (cond) { __builtin_amdgcn_s_sleep(1); \
    if ((++_sp & 255u) == 0u) { if (xb_ld(&(bar)[XB_TMO])) break; if (_sp > XB_SPIN_CAP) { atomicAdd(&(bar)[XB_TMO], 1u); break; } } } } while (0)
__device__ __forceinline__ void xcd_barrier_complete(unsigned* bar, unsigned x, unsigned& nloc, unsigned& nx) {
    const unsigned G = gridDim.x;
    unsigned sum, cnt, mine, sp = 0u;
    for (;;) {
        sum = 0u; cnt = 0u; mine = 0u;
#pragma unroll
        for (unsigned j = 0; j < 16; ++j) { const unsigned c = xb_ld(&bar[XB_XCNT(j)]); sum += c; cnt += (c > 0u) ? 1u : 0u; mine = (j == x) ? c : mine; }
        if (sum == G) break;
        __builtin_amdgcn_s_sleep(1);
        if ((++sp & 255u) == 0u) { if (xb_ld(&bar[XB_TMO])) break; if (sp > XB_SPIN_CAP) { atomicAdd(&bar[XB_TMO], 1u); break; } }
    }
    nloc = mine > 0u ? mine : 1u; nx = cnt > 0u ? cnt : 1u;
}
__device__ __forceinline__ void grid_barrier(unsigned char* ws, LAS unsigned char* lds_in, int wave_in) {
    const Ctx C = get_ids(wave_in);
    unsigned* bar = (unsigned*)(ws + WS_CTL);
    volatile LAS unsigned* st = (volatile LAS unsigned*)(lds_in + LDS_ST_OFF);
    asm volatile("s_waitcnt vmcnt(0)" ::: "memory");
    __syncthreads();
    if (C.tid == 0) {
        __builtin_amdgcn_s_waitcnt(0);
        const unsigned x = xb_xcc_id();
        unsigned nloc = st[0], nx = st[1];
        if (nloc == 0u) { xcd_barrier_complete(bar, x, nloc, nx); st[0] = nloc; st[1] = nx; }
        const unsigned old = xb_add(&bar[XB_XSUB(x)], 1u);
        const unsigned gen = old / nloc;
        if (old + 1u == (gen + 1u) * nloc) {
            __builtin_amdgcn_fence(__ATOMIC_RELEASE, "agent");
            asm volatile("s_waitcnt vmcnt(0)" ::: "memory");
            const unsigned og = xb_add(&bar[XB_TOP], 1u);
            const unsigned tg = og / nx;
            if (og + 1u == (tg + 1u) * nx) xb_add(&bar[XB_TOPGEN], 1u);
            else XB_SPIN(xb_ld(&bar[XB_TOPGEN]) == tg, bar);
            __builtin_amdgcn_fence(__ATOMIC_ACQUIRE, "agent");
            xb_add(&bar[XB_XGEN(x)], 1u);
            asm volatile("s_waitcnt vmcnt(0)" ::: "memory");
        } else {
            XB_SPIN(xb_ld(&bar[XB_XGEN(x)]) == gen, bar);
            __builtin_amdgcn_fence(__ATOMIC_ACQUIRE, "agent");
            asm volatile("s_waitcnt vmcnt(0)" ::: "memory");
        }
    }
    __syncthreads();
}

#define IN_(i) (kp->in[i])
#define WSP(T, off) ((T*)(ws + (off)))

__device__ __forceinline__ void transpose_item(const float* W, int ldw, int col0, int k0, bf16_t* WT, int ldk, const float* ks, const float* ns, int ncol_valid, LAS float* scr, int lane) {
    const int c4 = (lane & 15) * 4, rsub = lane >> 4;
    const bool cv = c4 < ncol_valid;
    f32x4 nsv = (f32x4){1.f, 1.f, 1.f, 1.f}; if (ns && cv) nsv = *(const f32x4*)(ns + c4);
    f32x4 v[16];
#pragma unroll
    for (int i = 0; i < 16; ++i) v[i] = cv ? *(const f32x4*)(W + (size_t)(k0 + i * 4 + rsub) * ldw + col0 + c4) : (f32x4){0.f, 0.f, 0.f, 0.f};
#pragma unroll
    for (int i = 0; i < 16; ++i) { const int kk = i * 4 + rsub; f32x4 x = v[i] * nsv; if (ks) x = x * ks[k0 + kk];
        LAS float* d = scr + kk * 65 + c4; d[0] = x.x; d[1] = x.y; d[2] = x.z; d[3] = x.w; }
    LDS_WAIT(); asm volatile("" ::: "memory");
    const int c = lane & 7;
#pragma unroll
    for (int j = 0; j < 8; ++j) { const int n = (lane >> 3) + 8 * j; const LAS float* s = scr + (8 * c) * 65 + n;
        u32x4 o; o.x = pk2(s[0 * 65], s[1 * 65]); o.y = pk2(s[2 * 65], s[3 * 65]); o.z = pk2(s[4 * 65], s[5 * 65]); o.w = pk2(s[6 * 65], s[7 * 65]);
        *(u32x4*)(WT + (size_t)n * ldk + k0 + 8 * c) = o; }
    LDS_WAIT(); asm volatile("" ::: "memory");
}

__device__ __forceinline__ void prologue(const Ctx& C_, LAS unsigned char* lds) {
    const Ctx C = get_ids(C_.wave);
    KP kp = kparams(); unsigned char* ws = kp->ws; (void)ws;
    const float* const L_x_prompt = kp->in[0];
    const float* const L_x_sample = kp->in[1];
    const float* const L_meta = kp->in[6];
    const float* const L_norm1_w = kp->in[7];
    const float* const L_w_in = kp->in[8];
    const float* const L_pool_w = kp->in[9];
    const float* const L_pool_scale = kp->in[10];
    const float* const L_w_pool_out = kp->in[11];
    const float* const L_ssd_norm_w = kp->in[17];
    const float* const L_w_ssd_out = kp->in[18];
    const float* const L_w_o = kp->in[19];
    const float* const L_norm2_w = kp->in[20];
    const float* const L_w_up = kp->in[21];
    const float* const L_w_down = kp->in[24];
    bf16_t* const L_W1T = (bf16_t*)(ws + WS_W1T);
    bf16_t* const L_PWT = (bf16_t*)(ws + WS_PWT);
    bf16_t* const L_WPOT = (bf16_t*)(ws + WS_WPOT);
    bf16_t* const L_WSOT = (bf16_t*)(ws + WS_WSOT);
    bf16_t* const L_WOT = (bf16_t*)(ws + WS_WOT);
    bf16_t* const L_WUPT = (bf16_t*)(ws + WS_WUPT);
    bf16_t* const L_WDT = (bf16_t*)(ws + WS_WDT);
    bf16_t* const L_XB = (bf16_t*)(ws + WS_XB);
    float* const L_X = (float*)(ws + WS_X);
    float* const L_RSS = (float*)(ws + WS_RSS);
    LAS float* scr = (LAS float*)(lds + C.wave * 16640);
    const int gw = C.bid * NWAVES + C.wave, NGW = C.G * NWAVES, lane = C.lane;
    constexpr int NB1 = NPROJ / 64;
    constexpr int I_W1 = 16 * NB1, I_PW = 4 * 4 * 4, I_PO = 16 * 16, I_SO = 32 * 16, I_O = 16 * 16, I_UP = 16 * (DUP / 64), I_D = (DFF / 64) * 16;
    constexpr int I_LAYER = I_W1 + I_PW + I_PO + I_SO + I_O + I_UP + I_D;
    for (int it = gw; it < DEPTH * I_LAYER; it += NGW) {
        const int l = it / I_LAYER; int r = it - l * I_LAYER;
        if (r < I_W1) {
            const int nb = r % NB1, kb = r / NB1, n0 = nb * 64, k0 = kb * 64;
            bf16_t* dst = L_W1T + ((size_t)l * NPROJ + n0) * 1024;
            if (n0 >= PC_DT + 64) {
                const int c = lane & 7;
#pragma unroll
                for (int j = 0; j < 8; ++j) { const int n = (lane >> 3) + 8 * j; *(u32x4*)(dst + (size_t)n * 1024 + k0 + 8 * c) = (u32x4){0u, 0u, 0u, 0u}; }
            } else {
                int sc, nv = 64;
                if (n0 < PC_GA) sc = n0; else if (n0 < PC_GB) sc = 6176 + (n0 - PC_GA); else if (n0 < PC_DT) sc = 7200 + (n0 - PC_GB); else { sc = 6144; nv = 32; }
                transpose_item(L_w_in + (size_t)l * 1024 * 8224, 8224, sc, k0, dst, 1024, L_norm1_w + l * 1024, nullptr, nv, scr, lane);
            }
            continue;
        }
        r -= I_W1;
        if (r < I_PW) {
            const int g = r / 16, rr = r % 16, kb = rr / 4, nb = rr % 4;
            transpose_item(L_pool_w + ((size_t)(l * 4 + g) * 256) * 256, 256, nb * 64, kb * 64, L_PWT + ((size_t)l * 1024 + g * 256 + nb * 64) * 256, 256, nullptr, L_pool_scale + l * 1024 + g * 256 + nb * 64, 64, scr, lane);
            continue;
        }
        r -= I_PW;
        if (r < I_PO) { const int kb = r / 16, nb = r % 16;
            transpose_item(L_w_pool_out + (size_t)l * 1024 * 1024, 1024, nb * 64, kb * 64, L_WPOT + ((size_t)l * 1024 + nb * 64) * 1024, 1024, nullptr, nullptr, 64, scr, lane); continue; }
        r -= I_PO;
        if (r < I_SO) { const int kb = r / 16, nb = r % 16;
            transpose_item(L_w_ssd_out + (size_t)l * 2048 * 1024, 1024, nb * 64, kb * 64, L_WSOT + ((size_t)l * 1024 + nb * 64) * 2048, 2048, L_ssd_norm_w + l * 2048, nullptr, 64, scr, lane); continue; }
        r -= I_SO;
        if (r < I_O) { const int kb = r / 16, nb = r % 16;
            transpose_item(L_w_o + (size_t)l * 1024 * 1024, 1024, nb * 64, kb * 64, L_WOT + ((size_t)l * 1024 + nb * 64) * 1024, 1024, nullptr, nullptr, 64, scr, lane); continue; }
        r -= I_O;
        if (r < I_UP) { const int kb = r / (DUP / 64), nb = r % (DUP / 64);
            transpose_item(L_w_up + (size_t)l * 1024 * DUP, DUP, nb * 64, kb * 64, L_WUPT + ((size_t)l * DUP + nb * 64) * 1024, 1024, L_norm2_w + l * 1024, nullptr, 64, scr, lane); continue; }
        r -= I_UP;
        { const int kb = r / 16, nb = r % 16;
            transpose_item(L_w_down + (size_t)l * DFF * 1024, 1024, nb * 64, kb * 64, L_WDT + ((size_t)l * 1024 + nb * 64) * DFF, DFF, nullptr, nullptr, 64, scr, lane); }
    }
    for (int m = gw; m < MP; m += NGW) {
        const float* src = nullptr;
        if (m < MPROMPT) { const int b = m / LP, t = m - b * LP; src = (t < NMETA) ? L_meta + (size_t)t * DM : L_x_prompt + ((size_t)b * SEQ + (t - NMETA)) * DM; }
        else if (m < MREAL) src = L_x_sample + (size_t)(m - MPROMPT) * DM;
        float ss = 0.f;
#pragma unroll
        for (int j = 0; j < 4; ++j) {
            f32x4 v = src ? ((const f32x4*)src)[lane + 64 * j] : (f32x4){0.f, 0.f, 0.f, 0.f};
            ss += (v.x * v.x + v.y * v.y) + (v.z * v.z + v.w * v.w);
            ((f32x4*)(L_X + (size_t)m * DM))[lane + 64 * j] = v;
            u32x2 w; w.x = pk2(v.x, v.y); w.y = pk2(v.z, v.w);
            ((u32x2*)(L_XB + (size_t)m * DM))[lane + 64 * j] = w;
        }
        ss = wave_sum(ss);
        if (lane < 16) L_RSS[(size_t)m * 16 + lane] = (lane == 0) ? ss : 0.f;
    }
}

__device__ __forceinline__ void conv_pass(const Ctx& C_, int l) {
    const Ctx C = get_ids(C_.wave);
    KP kp = kparams(); unsigned char* ws = kp->ws;
    const float* const L_state_conv = kp->in[3];
    const float* const L_conv_w = kp->in[12];
    const float* const L_conv_b = kp->in[13];
    const float* const L_dt_bias = kp->in[14];
    const bf16_t* const L_PROJ = (const bf16_t*)(ws + WS_PROJ);
    bf16_t* const L_XBCC = (bf16_t*)(ws + WS_XBCC);
    const float* const L_DT = (const float*)(ws + WS_DT);
    float* const L_DTS = (float*)(ws + WS_DTS);
    const int gtid = C.bid * NTHREADS + C.tid, NT = C.G * NTHREADS;
    constexpr int NV = CONVD / 8, NSTRIP = MREAL / 8;
    const int NGRP = NT / NV;
    const int v = gtid % NV, sg = gtid / NV, ch = v * 8;
    if (sg < NGRP) {
        f32x4 cw[4][2], cbias[2];
#pragma unroll
        for (int k = 0; k < 4; ++k) { cw[k][0] = *(const f32x4*)(L_conv_w + ((size_t)l * 4 + k) * CONVD + ch); cw[k][1] = *(const f32x4*)(L_conv_w + ((size_t)l * 4 + k) * CONVD + ch + 4); }
        cbias[0] = *(const f32x4*)(L_conv_b + (size_t)l * CONVD + ch); cbias[1] = *(const f32x4*)(L_conv_b + (size_t)l * CONVD + ch + 4);
        u32x4 raw[11], nraw[11];
#define CONV_LOAD(dst_, strip_) do { const int m0_ = (strip_) * 8; const bool smp_ = m0_ >= MPROMPT; const int t0_ = smp_ ? 0 : (m0_ % LP); \
            const bf16_t* rb_ = L_PROJ + ((size_t)m0_ - 3) * NPROJ + PC_XBC + ch; \
            _Pragma("unroll") for (int i = 0; i < 11; ++i) dst_[i] = *(const u32x4*)(rb_ + (size_t)((t0_ + i - 3 >= 0) ? i : 3) * NPROJ); } while (0)
        int strip = sg;
        if (strip < NSTRIP) CONV_LOAD(raw, strip);
        for (; strip < NSTRIP; strip += NGRP) {
            const int m0 = strip * 8;
            const bool sample = m0 >= MPROMPT;
            const int t0 = sample ? 0 : (m0 % LP), b = sample ? (m0 - MPROMPT) / DS : 0;
            const bool more = strip + NGRP < NSTRIP;
            if (more) CONV_LOAD(nraw, strip + NGRP);
            if (t0 < 3) {
#pragma unroll
                for (int i = 0; i < 3; ++i) if (t0 + i - 3 < 0) {
                    u32x4 rv = (u32x4){0u, 0u, 0u, 0u};
                    if (sample) { const float* pp = L_state_conv + ((size_t)(l * DB + b) * 3 + i) * CONVD + ch; rv = pack8v(*(const f32x4*)pp, *(const f32x4*)(pp + 4)); }
                    raw[i] = rv; }
            }
            float oacc[4][8];
#pragma unroll
            for (int i = 0; i < 11; ++i) {
                float xv[8]; unpack8(raw[i], xv);
                if (i < 8) {
#pragma unroll
                    for (int e = 0; e < 8; ++e) oacc[i & 3][e] = 0.f;
                }
#pragma unroll
                for (int k = 0; k < 4; ++k) { const int j = i - k;
                    if (j >= 0 && j < 8) { float* o = oacc[j & 3];
                        o[0] += cw[k][0].x * xv[0]; o[1] += cw[k][0].y * xv[1]; o[2] += cw[k][0].z * xv[2]; o[3] += cw[k][0].w * xv[3];
                        o[4] += cw[k][1].x * xv[4]; o[5] += cw[k][1].y * xv[5]; o[6] += cw[k][1].z * xv[6]; o[7] += cw[k][1].w * xv[7]; } }
                if (i >= 3) {
                    const int j = i - 3; const float* oa = oacc[j & 3];
                    float o[8];
                    o[0] = siluf_(oa[0] + cbias[0].x); o[1] = siluf_(oa[1] + cbias[0].y); o[2] = siluf_(oa[2] + cbias[0].z); o[3] = siluf_(oa[3] + cbias[0].w);
                    o[4] = siluf_(oa[4] + cbias[1].x); o[5] = siluf_(oa[5] + cbias[1].y); o[6] = siluf_(oa[6] + cbias[1].z); o[7] = siluf_(oa[7] + cbias[1].w);
                    *(u32x4*)(L_XBCC + (size_t)(m0 + j) * CONVD + ch) = pack8(o);
                }
            }
            if (more) {
#pragma unroll
                for (int i = 0; i < 11; ++i) raw[i] = nraw[i];
            }
        }
#undef CONV_LOAD
    }
    for (int idx = gtid; idx < MREAL * NH; idx += NT) {
        const float rw = L_DT[idx] + L_dt_bias[l * NH + (idx & 31)];
        L_DTS[(size_t)(idx & 31) * MP + (idx >> 5)] = rw > 20.f ? rw : __logf(1.0f + __expf(rw));
    }
}

constexpr int LD128 = 136, LD64 = 72;
constexpr int S_C = 0, S_CS = 17408, S_B = 34816, S_BWT = 52224, S_XDT = 70656, S_XS = 79872, S_M = 89088, S_H = 98304, S_Z = 115712  , S_DTV = 124928, S_CUM = 125440, S_SSQ = 125952;

#define SSD_PREFETCH(r0_, ntok_, h_, xoff_, zoff_, boff_, c0n) do { \
    const int nqn_ = ((ntok_) - (c0n)) < 64 ? ((ntok_) - (c0n)) : 64; \
    const bf16_t* xb_ = L_XBCC + (size_t)((r0_) + (c0n)) * CONVD; \
    { unsigned z_ = 0u; asm volatile("" : "+v"(z_)); rx = (u32x4){z_, z_, z_, z_}; } zraw = rx; rB[0] = rx; rB[1] = rx; rC[0] = rx; rC[1] = rx;     \
    if (zt < nqn_) zraw = *(const u32x4*)(L_PROJ + (size_t)((r0_) + (c0n)) * NPROJ + (zoff_)); \
    if (zt < nqn_) rx = *(const u32x4*)(xb_ + (xoff_)); \
    _Pragma("unroll") for (int i_ = 0; i_ < 2; ++i_) if (bt + 32 * i_ < nqn_) { rB[i_] = *(const u32x4*)(xb_ + (boff_) + (size_t)i_ * 32 * CONVD); rC[i_] = *(const u32x4*)(xb_ + (boff_) + 512 + (size_t)i_ * 32 * CONVD); } \
    dtraw = (lane < nqn_) ? L_DTS[(size_t)(h_) * MP + (unsigned)((r0_) + (c0n) + lane)] : 0.f; \
} while (0)
#define SSD_UNIT(u_, smp_, b_, h_, r0_, ntok_, xoff_, zoff_, boff_) do { \
    smp_ = (u_) >= NBATCH * NH; const int k_ = smp_ ? (u_) - NBATCH * NH : (u_); b_ = k_ / NH; h_ = k_ - b_ * NH; \
    r0_ = smp_ ? MPROMPT + b_ * DS : b_ * LP; ntok_ = smp_ ? DS : LP; \
    xoff_ = (unsigned)zt * CONVD + h_ * 64 + zv * 8; zoff_ = (unsigned)zt * NPROJ + PC_Z + h_ * 64 + zv * 8; boff_ = (unsigned)bt * CONVD + 2048 + (h_ >> 3) * 128 + bv * 8; \
} while (0)

__device__ __forceinline__ void ssd_phase(const Ctx& C_, LAS unsigned char* lds_in, int l) {
    const Ctx C = get_ids(C_.wave);
    LAS unsigned char* lds = lds_in; asm volatile("" : "+s"(lds));
    KP kp = kparams(); unsigned char* ws = kp->ws;
    const float* const L_state_ssm = kp->in[4];
    float* const L_out = kp->out;
    const bf16_t* const L_PROJ = (const bf16_t*)(ws + WS_PROJ);
    const bf16_t* const L_XBCC = (const bf16_t*)(ws + WS_XBCC);
    bf16_t* const L_YN = (bf16_t*)(ws + WS_YN);
    const float* const L_DTS = (const float*)(ws + WS_DTS);
    float* const L_SSQ = (float*)(ws + WS_SSQ);
    const float* const L_a_log = kp->in[15] + l * NH; const float* const L_d_skip = kp->in[16] + l * NH;
    const int tid = C.tid, lane = C.lane, wave = C.wave, r = lane & 15, q = lane >> 4;
    LAS bf16_t* sC = (LAS bf16_t*)(lds + S_C); LAS bf16_t* sCs = (LAS bf16_t*)(lds + S_CS); LAS bf16_t* sB = (LAS bf16_t*)(lds + S_B);
    LAS bf16_t* sBwT = (LAS bf16_t*)(lds + S_BWT); LAS bf16_t* sXdT = (LAS bf16_t*)(lds + S_XDT); LAS bf16_t* sXs = (LAS bf16_t*)(lds + S_XS);
    LAS bf16_t* sM = (LAS bf16_t*)(lds + S_M); LAS bf16_t* sH = (LAS bf16_t*)(lds + S_H); LAS bf16_t* sZ = (LAS bf16_t*)(lds + S_Z);
    LAS float* scum = (LAS float*)(lds + S_CUM); LAS float* sssq = (LAS float*)(lds + S_SSQ);
    const int zt = tid >> 3, zv = tid & 7, bt = tid >> 4, bv = tid & 15;
    const int pjs = wave & 3, ni0 = (wave >> 2) * 4;
    const int NU = NBATCH * NH;
    int u = C.bid; if (u >= NU) return;
    bool sample; int b, h, r0, ntok; unsigned xoff, zoff, boff;
    SSD_UNIT(u, sample, b, h, r0, ntok, xoff, zoff, boff);
    u32x4 rx, zraw, rB[2], rC[2]; float dtraw = 0.f;
    SSD_PREFETCH(r0, ntok, h, xoff, zoff, boff, 0);
    if (tid < 64) sssq[tid] = 0.f;
  for (;;) {
    const float a_h = -__expf(L_a_log[h]), dsk = L_d_skip[h];
    f32x4 H[4];
    if (sample) { const float* h0 = L_state_ssm + ((size_t)(l * DB + b) * NH + h) * (HD * NST);
#pragma unroll
        for (int j = 0; j < 4; ++j) H[j] = *(const f32x4*)(h0 + (16 * pjs + r) * NST + 16 * (ni0 + j) + 4 * q);
    } else {
        float z_ = 0.f; asm volatile("" : "+v"(z_));
#pragma unroll
        for (int j = 0; j < 4; ++j) H[j] = (f32x4){z_, z_, z_, z_};
    }
    const int un = u + C.G; const bool has_next = un < NU;
    LBAR();

    int par = 0;
    for (int c0 = 0; c0 < ntok; c0 += 64, par ^= 1) {
        const int nq = (ntok - c0) < 64 ? (ntok - c0) : 64;
        const bool more = (c0 + 64) < ntok;
        const LAS float* cumc = scum;
        const float d = dtraw;
        float cs = d * a_h;
#pragma unroll
        for (int o_ = 1; o_ < 64; o_ <<= 1) { const float v_ = shup(cs, o_, lane); if (lane >= o_) cs += v_; }
        const float clast = shidx(cs, 63);
        if (wave == 7) scum[lane] = cs;
#define SWZ(row_, tok_) ((row_) * LD64 + (((((tok_) >> 3) ^ (((row_) >> 3) & 7)) << 3) | ((tok_) & 7)))
        {
            const float dz = shidx(d, zt), wcs0 = shidx(cs, bt), wcs1 = shidx(cs, bt + 32);
            float xv[8]; unpack8(rx, xv);
            *(LAS u32x4*)(sXs + zt * LD64 + zv * 8) = rx;
            *(LAS u32x4*)(sZ + zt * LD64 + zv * 8) = zraw;
#pragma unroll
            for (int e = 0; e < 8; ++e) sXdT[SWZ(zv * 8 + e, zt)] = (bf16_t)f2bf(xv[e] * dz);
#pragma unroll
            for (int i = 0; i < 2; ++i) {
                const int st = bt + 32 * i; const float csx = i == 0 ? wcs0 : wcs1;
                const float wb = __expf(clast - csx), wc = __expf(csx);
                float bvv[8]; unpack8(rB[i], bvv);
                *(LAS u32x4*)(sB + st * LD128 + bv * 8) = rB[i];
#pragma unroll
                for (int e = 0; e < 8; ++e) sBwT[SWZ(bv * 8 + e, st)] = (bf16_t)f2bf(bvv[e] * wb);
                float cvv[8]; unpack8(rC[i], cvv);
                *(LAS u32x4*)(sC + st * LD128 + bv * 8) = rC[i];
#pragma unroll
                for (int e = 0; e < 8; ++e) cvv[e] *= wc;
                *(LAS u32x4*)(sCs + st * LD128 + bv * 8) = pack8(cvv);
            }
        }
        __builtin_amdgcn_sched_barrier(0);
        if (more) { SSD_PREFETCH(r0, ntok, h, xoff, zoff, boff, c0 + 64); }
        else if (has_next) {
            bool sample_n; int b_n, h_n, r0_n, ntok_n; unsigned xoff_n, zoff_n, boff_n;
            SSD_UNIT(un, sample_n, b_n, h_n, r0_n, ntok_n, xoff_n, zoff_n, boff_n);
            SSD_PREFETCH(r0_n, ntok_n, h_n, xoff_n, zoff_n, boff_n, 0);
        }
        LBAR();
        {
            const int ti = wave >> 1, sj0 = (wave & 1) * 2;
            if (16 * ti < nq) {
                bf16x8 fa[4], fb[2][4];
#pragma unroll
                for (int kk = 0; kk < 4; ++kk) {
                    fa[kk] = *(const LAS bf16x8*)(sC + (16 * ti + r) * LD128 + kk * 32 + q * 8);
                    fb[0][kk] = *(const LAS bf16x8*)(sB + (16 * sj0 + r) * LD128 + kk * 32 + q * 8);
                    fb[1][kk] = *(const LAS bf16x8*)(sB + (16 * (sj0 + 1) + r) * LD128 + kk * 32 + q * 8);
                }
                const int t = 16 * ti + r; const float ctv = cumc[t];
                const f32x4 cs0 = *(const LAS f32x4*)(cumc + 16 * sj0 + 4 * q), cs1 = *(const LAS f32x4*)(cumc + 16 * (sj0 + 1) + 4 * q);
                __builtin_amdgcn_sched_barrier(0);
                f32x4 S0 = (f32x4){0.f, 0.f, 0.f, 0.f}, S1 = S0;
#pragma unroll
                for (int kk = 0; kk < 4; ++kk) { S0 = __builtin_amdgcn_mfma_f32_16x16x32_bf16(fb[0][kk], fa[kk], S0, 0, 0, 0); S1 = __builtin_amdgcn_mfma_f32_16x16x32_bf16(fb[1][kk], fa[kk], S1, 0, 0, 0); }
                {
                    float m0[4], m1[4];
#pragma unroll
                    for (int jj = 0; jj < 4; ++jj) {
                        const int s0 = 16 * sj0 + 4 * q + jj, s1 = s0 + 16;
                        m0[jj] = (s0 <= t) ? S0[jj] * __expf(fminf(ctv - cs0[jj], 0.f)) : 0.f;
                        m1[jj] = (s1 <= t) ? S1[jj] * __expf(fminf(ctv - cs1[jj], 0.f)) : 0.f;
                    }
                    u32x2 w0, w1; w0.x = pk2(m0[0], m0[1]); w0.y = pk2(m0[2], m0[3]); w1.x = pk2(m1[0], m1[1]); w1.y = pk2(m1[2], m1[3]);
                    *(LAS u32x2*)(sM + t * LD64 + 16 * sj0 + 4 * q) = w0; *(LAS u32x2*)(sM + t * LD64 + 16 * (sj0 + 1) + 4 * q) = w1;
                }
            }
        }
        if (c0 == 0) {
#pragma unroll
            for (int j = 0; j < 4; ++j) { u32x2 w; w.x = pk2(H[j][0], H[j][1]); w.y = pk2(H[j][2], H[j][3]); *(LAS u32x2*)(sH + (16 * pjs + r) * LD128 + 16 * (ni0 + j) + 4 * q) = w; }
        }
        LBAR();
        {
            const int ti = wave >> 1, pj0 = (wave & 1) * 2;
            const bool yv = 16 * ti < nq;
            bf16x8 sA[4][2], sBf[2];
            f32x4 Y[2];
            Y[0] = (f32x4){0.f, 0.f, 0.f, 0.f}; Y[1] = Y[0];
            if (yv) {
                {
                    bf16x8 aM[2], bX[2][2];
#pragma unroll
                    for (int kk = 0; kk < 2; ++kk) { aM[kk] = *(const LAS bf16x8*)(sM + (16 * ti + r) * LD64 + kk * 32 + q * 8);
                        bX[0][kk] = *(const LAS bf16x8*)(sXdT + SWZ(16 * pj0 + r, kk * 32 + q * 8)); bX[1][kk] = *(const LAS bf16x8*)(sXdT + SWZ(16 * (pj0 + 1) + r, kk * 32 + q * 8)); }
                    __builtin_amdgcn_sched_barrier(0);
#pragma unroll
                    for (int kk = 0; kk < 2; ++kk) { Y[0] = __builtin_amdgcn_mfma_f32_16x16x32_bf16(bX[0][kk], aM[kk], Y[0], 0, 0, 0); Y[1] = __builtin_amdgcn_mfma_f32_16x16x32_bf16(bX[1][kk], aM[kk], Y[1], 0, 0, 0); }
                }
                __builtin_amdgcn_sched_barrier(0);
                {
                    bf16x8 aC[4], bH[2][4];
#pragma unroll
                    for (int kk = 0; kk < 4; ++kk) { aC[kk] = *(const LAS bf16x8*)(sCs + (16 * ti + r) * LD128 + kk * 32 + q * 8);
                        bH[0][kk] = *(const LAS bf16x8*)(sH + (16 * pj0 + r) * LD128 + kk * 32 + q * 8); bH[1][kk] = *(const LAS bf16x8*)(sH + (16 * (pj0 + 1) + r) * LD128 + kk * 32 + q * 8); }
                    __builtin_amdgcn_sched_barrier(0);
#pragma unroll
                    for (int kk = 0; kk < 4; ++kk) { Y[0] = __builtin_amdgcn_mfma_f32_16x16x32_bf16(bH[0][kk], aC[kk], Y[0], 0, 0, 0); Y[1] = __builtin_amdgcn_mfma_f32_16x16x32_bf16(bH[1][kk], aC[kk], Y[1], 0, 0, 0); }
                }
            }
            __builtin_amdgcn_sched_barrier(0);
#pragma unroll
            for (int kk = 0; kk < 2; ++kk) { sBf[kk] = *(const LAS bf16x8*)(sXdT + SWZ(16 * pjs + r, kk * 32 + q * 8));
#pragma unroll
                for (int j = 0; j < 4; ++j) sA[j][kk] = *(const LAS bf16x8*)(sBwT + SWZ(16 * (ni0 + j) + r, kk * 32 + q * 8)); }
            __builtin_amdgcn_sched_barrier(0);
            {
                const float dec = __expf(clast);
#pragma unroll
                for (int j = 0; j < 4; ++j) H[j] = H[j] * dec;
#pragma unroll
                for (int kk = 0; kk < 2; ++kk)
#pragma unroll
                    for (int j = 0; j < 4; ++j) H[j] = __builtin_amdgcn_mfma_f32_16x16x32_bf16(sA[j][kk], sBf[kk], H[j], 0, 0, 0);
            }
            if (yv) {
                const int t = 16 * ti + r;
                float ss = 0.f;
#pragma unroll
                for (int j = 0; j < 2; ++j) {
                    const int p0 = 16 * (pj0 + j) + 4 * q;
                    const u32x2 xw = *(const LAS u32x2*)(sXs + t * LD64 + p0), zw = *(const LAS u32x2*)(sZ + t * LD64 + p0);
                    const float y0 = (Y[j][0] + dsk * bflo(xw.x)) * siluf_(bflo(zw.x)), y1 = (Y[j][1] + dsk * bfhi(xw.x)) * siluf_(bfhi(zw.x));
                    const float y2 = (Y[j][2] + dsk * bflo(xw.y)) * siluf_(bflo(zw.y)), y3 = (Y[j][3] + dsk * bfhi(xw.y)) * siluf_(bfhi(zw.y));
                    ss += (y0 * y0 + y1 * y1) + (y2 * y2 + y3 * y3);
                    u32x2 w; w.x = pk2(y0, y1); w.y = pk2(y2, y3);
                    *(LAS u32x2*)(sZ + t * LD64 + p0) = w;
                }
                ss += shx(ss, 16, lane); ss += shx(ss, 32, lane);
                if (q == 0 && t < nq) (void)__hip_atomic_fetch_add(sssq + t, ss, __ATOMIC_RELAXED, __HIP_MEMORY_SCOPE_WORKGROUP);
            }
        }
        LBAR();
#pragma unroll
        for (int j = 0; j < 4; ++j) { u32x2 w; w.x = pk2(H[j][0], H[j][1]); w.y = pk2(H[j][2], H[j][3]); *(LAS u32x2*)(sH + (16 * pjs + r) * LD128 + 16 * (ni0 + j) + 4 * q) = w; }
        if (zt < nq) *(u32x4*)(L_YN + (size_t)(r0 + c0 + zt) * DINNER + h * 64 + zv * 8) = *(const LAS u32x4*)(sZ + zt * LD64 + zv * 8);
        if (tid < 64) { if (tid < nq) L_SSQ[(size_t)(r0 + c0 + tid) * 32 + h] = sssq[tid]; sssq[tid] = 0.f; }
        __builtin_amdgcn_sched_barrier(0);
    }
    float* so = L_out + (sample ? O_SSSM + ((size_t)(l * DB + b) * NH + h) * (HD * NST) : O_PSSM + ((size_t)(l * NBATCH + b) * NH + h) * (HD * NST));
#pragma unroll
    for (int j = 0; j < 4; ++j) *(f32x4*)(so + (16 * pjs + r) * NST + 16 * (ni0 + j) + 4 * q) = H[j];
    if (!has_next) break;
    u = un; SSD_UNIT(u, sample, b, h, r0, ntok, xoff, zoff, boff);
  }
    LBAR();
}

constexpr int SMP_WAVE_LDS = 14592;
__device__ __forceinline__ void ssd_sample(const Ctx& C_, LAS unsigned char* lds_in, int l) {
    const Ctx C = get_ids(C_.wave);
    LAS unsigned char* lds = lds_in; asm volatile("" : "+s"(lds));
    KP kp = kparams(); unsigned char* ws = kp->ws;
    const float* const L_state_ssm = kp->in[4];
    float* const L_out = kp->out;
    const bf16_t* const L_PROJ = (const bf16_t*)(ws + WS_PROJ);
    const bf16_t* const L_XBCC = (const bf16_t*)(ws + WS_XBCC);
    bf16_t* const L_YN = (bf16_t*)(ws + WS_YN);
    const float* const L_DTS = (const float*)(ws + WS_DTS);
    float* const L_SSQ = (float*)(ws + WS_SSQ);
    const float* const L_a_log = kp->in[15] + l * NH; const float* const L_d_skip = kp->in[16] + l * NH;
    const int lane = C.lane, wave = C.wave, r = lane & 15, q = lane >> 4;
    LAS float* sBf = (LAS float*)(lds + wave * SMP_WAVE_LDS); LAS float* sCf = sBf + 1024; LAS float* sXf = sBf + 2048; LAS float* sZf = sBf + 2560; LAS float* sY2 = sBf + 3072;
    LAS float* sdt = sBf + 3584; LAS float* sdA = sBf + 3592;
    for (int k = C.bid * NWAVES + wave; k < DB * NH; k += C.G * NWAVES) {
        const int b = k / NH, h = k - b * NH, g = h >> 3, r0 = MPROMPT + b * DS;
        const float a_h = -__expf(L_a_log[h]), dsk = L_d_skip[h];
        int ln = lane; asm volatile("" : "+v"(ln));
#pragma unroll 1
        for (int i = 0; i < 5; ++i) {
            const int idx = ln + 64 * i, t = idx / 40, v = idx - t * 40;
            int ch; LAS float* dst;
            if (v < 8) { ch = h * 64 + v * 8; dst = sXf + t * 64 + v * 8; } else if (v < 24) { ch = 2048 + g * 128 + (v - 8) * 8; dst = sBf + t * 128 + (v - 8) * 8; } else { ch = 2560 + g * 128 + (v - 24) * 8; dst = sCf + t * 128 + (v - 24) * 8; }
            const u32x4 w = *(const u32x4*)(L_XBCC + (size_t)(r0 + t) * CONVD + ch); float o[8]; unpack8(w, o);
            *(LAS f32x4*)dst = (f32x4){o[0], o[1], o[2], o[3]}; *(LAS f32x4*)(dst + 4) = (f32x4){o[4], o[5], o[6], o[7]};
        }
        { const int t = ln >> 3, v = ln & 7;
            const u32x4 w = *(const u32x4*)(L_PROJ + (size_t)(r0 + t) * NPROJ + PC_Z + h * 64 + v * 8); float o[8]; unpack8(w, o);
            *(LAS f32x4*)(sZf + t * 64 + v * 8) = (f32x4){o[0], o[1], o[2], o[3]}; *(LAS f32x4*)(sZf + t * 64 + v * 8 + 4) = (f32x4){o[4], o[5], o[6], o[7]}; }
        if (ln < 8) { const float dtv = L_DTS[(size_t)h * MP + r0 + ln]; sdt[ln] = dtv; sdA[ln] = __expf(dtv * a_h); }
        const float* h0 = L_state_ssm + ((size_t)(l * DB + b) * NH + h) * (HD * NST);
        f32x4 hs[4][4][2];
        unsigned hoff = (unsigned)(r * NST + 8 * q); asm volatile("" : "+v"(hoff));
#pragma unroll
        for (int pj = 0; pj < 4; ++pj)
#pragma unroll
            for (int kk = 0; kk < 4; ++kk) { const float* p = h0 + hoff + (16 * pj * NST + 32 * kk); hs[pj][kk][0] = *(const f32x4*)p; hs[pj][kk][1] = *(const f32x4*)(p + 4); }
        LDS_WAIT(); asm volatile("" ::: "memory");
#pragma unroll 1
        for (int t = 0; t < DS; ++t) {
            const float dt = sdt[t], dA = sdA[t];
            float xd[4], y[4];
#pragma unroll
            for (int pj = 0; pj < 4; ++pj) { xd[pj] = sXf[t * 64 + 16 * pj + r] * dt; y[pj] = 0.f; }
#pragma unroll
            for (int kk = 0; kk < 4; ++kk) {
                const f32x4 B0 = *(const LAS f32x4*)(sBf + t * 128 + 32 * kk + 8 * q), B1 = *(const LAS f32x4*)(sBf + t * 128 + 32 * kk + 8 * q + 4);
                const f32x4 C0 = *(const LAS f32x4*)(sCf + t * 128 + 32 * kk + 8 * q), C1 = *(const LAS f32x4*)(sCf + t * 128 + 32 * kk + 8 * q + 4);
#pragma unroll
                for (int pj = 0; pj < 4; ++pj) {
                    f32x4 h0v = hs[pj][kk][0] * dA + B0 * xd[pj], h1v = hs[pj][kk][1] * dA + B1 * xd[pj];
                    hs[pj][kk][0] = h0v; hs[pj][kk][1] = h1v;
                    const f32x4 m0 = C0 * h0v, m1 = C1 * h1v;
                    y[pj] += ((m0.x + m0.y) + (m0.z + m0.w)) + ((m1.x + m1.y) + (m1.z + m1.w));
                }
            }
#pragma unroll
            for (int pj = 0; pj < 4; ++pj) { y[pj] += shx(y[pj], 16, lane); y[pj] += shx(y[pj], 32, lane); }
            const float yv = q == 0 ? y[0] : (q == 1 ? y[1] : (q == 2 ? y[2] : y[3]));
            const float yg = (yv + dsk * sXf[t * 64 + lane]) * siluf_(sZf[t * 64 + lane]);
            L_YN[(size_t)(r0 + t) * DINNER + h * 64 + lane] = (bf16_t)f2bf(yg);
            sY2[t * 64 + lane] = yg * yg;
        }
        LDS_WAIT(); asm volatile("" ::: "memory");
        {
            const LAS float* p = sY2 + (lane >> 3) * 64 + (lane & 7) * 8;
            const f32x4 a = *(const LAS f32x4*)p, c = *(const LAS f32x4*)(p + 4);
            float ss = ((a.x + a.y) + (a.z + a.w)) + ((c.x + c.y) + (c.z + c.w));
            ss += shx(ss, 1, lane); ss += shx(ss, 2, lane); ss += shx(ss, 4, lane);
            if ((lane & 7) == 0) L_SSQ[(size_t)(r0 + (lane >> 3)) * 32 + h] = ss;
        }
        float* so = L_out + O_SSSM + ((size_t)(l * DB + b) * NH + h) * (HD * NST);
#pragma unroll
        for (int pj = 0; pj < 4; ++pj)
#pragma unroll
            for (int kk = 0; kk < 4; ++kk) { float* p = so + hoff + (16 * pj * NST + 32 * kk); *(f32x4*)p = hs[pj][kk][0]; *(f32x4*)(p + 4) = hs[pj][kk][1]; }
        LDS_WAIT(); asm volatile("" ::: "memory");
    }
}

__device__ __forceinline__ void row_bf16_to_f32(const bf16_t* src, float* dst, int ncol, int lane) {
    for (int v = lane; v < ncol / 8; v += 64) { const u32x4 w = *(const u32x4*)(src + v * 8); float o[8]; unpack8(w, o);
        *(f32x4*)(dst + v * 8) = (f32x4){o[0], o[1], o[2], o[3]}; *(f32x4*)(dst + v * 8 + 4) = (f32x4){o[4], o[5], o[6], o[7]}; }
}
__device__ __forceinline__ void row_f32_copy(const float* src, float* dst, int ncol, int lane) {
    for (int v = lane; v < ncol / 4; v += 64) *(f32x4*)(dst + v * 4) = *(const f32x4*)(src + v * 4);
}

template <int MAXW>
__device__ __forceinline__ void pool_load(const bf16_t* PROJ, const float* state_pool, int l, int m, bool sample, int b, int t, int ch, int win, u32x4 (&rw)[MAXW]) {
#pragma unroll
    for (int j = 0; j < MAXW; ++j) { const bool need = (j < win) && (t - j >= 0);
        const u32x4 rv = *(const u32x4*)(PROJ + (size_t)(m - (need ? j : 0)) * NPROJ + PC_U + ch);
        rw[j] = need ? rv : (u32x4){0u, 0u, 0u, 0u}; }
    if (sample && t < win - 1) {
#pragma unroll
        for (int j = 1; j < MAXW; ++j) if (j < win && t - j < 0) {
            const float* pp = state_pool + ((size_t)(l * DB + b) * 15 + (15 + t - j)) * 1024 + ch; rw[j] = pack8v(*(const f32x4*)pp, *(const f32x4*)(pp + 4)); }
    }
}
template <int MAXW>
__device__ __forceinline__ void pool_finish(bf16_t* DBUF, int m, bool sample, int t, int ch, int win, const u32x4 (&rw)[MAXW]) {
    float acc[8], u0[8];
    unpack8(rw[0], u0);
#pragma unroll
    for (int e = 0; e < 8; ++e) acc[e] = u0[e];
#pragma unroll
    for (int j = 1; j < MAXW; ++j) { float xv[8]; unpack8(rw[j], xv);
#pragma unroll
        for (int e = 0; e < 8; ++e) acc[e] += xv[e]; }
    const int cnt = sample ? win : ((t + 1) < win ? (t + 1) : win);
    const float inv = 1.0f / (float)cnt;
    float d[8];
#pragma unroll
    for (int e = 0; e < 8; ++e) d[e] = acc[e] * inv - u0[e];
    *(u32x4*)(DBUF + (size_t)m * 1024 + ch) = pack8(d);
}

__device__ __forceinline__ void mixer_elementwise(const Ctx& C_, int l) {
    const Ctx C = get_ids(C_.wave);
    KP kp = kparams(); unsigned char* ws = kp->ws;
    const float* const L_state_pool = kp->in[2];
    float* const L_out = kp->out;
    const bf16_t* const L_PROJ = (const bf16_t*)(ws + WS_PROJ);
    bf16_t* const L_DBUF = (bf16_t*)(ws + WS_DBUF);
    const int gw = C.bid * NWAVES + C.wave, NGW = C.G * NWAVES, lane = C.lane;
    for (int m = gw; m < MREAL; m += NGW) {
        const bool sample = m >= MPROMPT;
        int b, t; if (sample) { b = (m - MPROMPT) / DS; t = (m - MPROMPT) - b * DS; } else { b = m / LP; t = m - b * LP; }
        const int chA = lane * 8, chB = (lane + 64) * 8, winA = 2 << (chA >> 8), winB = 2 << (chB >> 8);
        u32x4 rwA[4], rwB[16];
        pool_load<4>(L_PROJ, L_state_pool, l, m, sample, b, t, chA, winA, rwA);
        pool_load<16>(L_PROJ, L_state_pool, l, m, sample, b, t, chB, winB, rwB);
        pool_finish<4>(L_DBUF, m, sample, t, chA, winA, rwA);
        pool_finish<16>(L_DBUF, m, sample, t, chB, winB, rwB);
    }
    for (int it = gw; it < (NBATCH + DB) * 15; it += NGW) {
        if (it < NBATCH * 15) { const int b = it / 15, i = it - b * 15;
            row_bf16_to_f32(L_PROJ + (size_t)(b * LP + LP - 15 + i) * NPROJ + PC_U, L_out + O_PPOOL + ((size_t)(l * NBATCH + b) * 15 + i) * 1024, 1024, lane);
        } else { const int k = it - NBATCH * 15, b = k / 15, i = k - b * 15;
            float* dst = L_out + O_SPOOL + ((size_t)(l * DB + b) * 15 + i) * 1024;
            if (i < 7) row_f32_copy(L_state_pool + ((size_t)(l * DB + b) * 15 + 8 + i) * 1024, dst, 1024, lane);
            else row_bf16_to_f32(L_PROJ + (size_t)(MPROMPT + b * DS + (i - 7)) * NPROJ + PC_U, dst, 1024, lane); }
    }
    for (int it = gw; it < (NBATCH + DB) * 3; it += NGW) {
        if (it < NBATCH * 3) { const int b = it / 3, i = it - b * 3;
            row_bf16_to_f32(L_PROJ + (size_t)(b * LP + LP - 3 + i) * NPROJ + PC_XBC, L_out + O_PCONV + ((size_t)(l * NBATCH + b) * 3 + i) * CONVD, CONVD, lane);
        } else { const int k = it - NBATCH * 3, b = k / 3, i = k - b * 3;
            row_bf16_to_f32(L_PROJ + (size_t)(MPROMPT + b * DS + 5 + i) * NPROJ + PC_XBC, L_out + O_SCONV + ((size_t)(l * DB + b) * 3 + i) * CONVD, CONVD, lane); }
    }
}

__device__ __forceinline__ void yn_normalize(const Ctx& C_) {
    const Ctx C = get_ids(C_.wave);
    KP kp = kparams(); unsigned char* ws = kp->ws; (void)ws;
    bf16_t* const L_YN = (bf16_t*)(ws + WS_YN);
    float* const L_SSQ = (float*)(ws + WS_SSQ);
    const int gw = C.bid * NWAVES + C.wave, NGW = C.G * NWAVES, lane = C.lane;
    for (int m = gw; m < MREAL; m += NGW) {
        const f32x4* sp = (const f32x4*)(L_SSQ + (size_t)m * 32);
        float rs[4];
#pragma unroll
        for (int gi = 0; gi < 4; ++gi) { const f32x4 a = sp[2 * gi], b = sp[2 * gi + 1]; rs[gi] = rsqrtf((((a.x + a.y) + (a.z + a.w)) + ((b.x + b.y) + (b.z + b.w))) * (1.0f / 512.0f) + EPS); }
#pragma unroll
        for (int i = 0; i < 4; ++i) {
            const int v = lane + 64 * i;
            u32x4* p = (u32x4*)(L_YN + (size_t)m * DINNER + v * 8);
            float o[8]; unpack8(*p, o);
            const float s = rs[i];
#pragma unroll
            for (int e = 0; e < 8; ++e) o[e] *= s;
            *p = pack8(o);
        }
    }
}

__device__ __forceinline__ void ffn_half(const bf16_t* UP, const float* state_ffn, const float* fw, const float* fb, int l, int m0, int t0, bool sample, int b, int col, float (&res)[8][8]) {
    u32x4 raw[10];
#pragma unroll
    for (int i = 0; i < 10; ++i) raw[i] = *(const u32x4*)(UP + (size_t)(m0 + ((t0 + i - 2 >= 0) ? i - 2 : 0)) * DUP + col);
    if (t0 < 2) {
#pragma unroll
        for (int i = 0; i < 2; ++i) if (t0 + i - 2 < 0) {
            u32x4 rv = (u32x4){0u, 0u, 0u, 0u};
            if (sample) { const float* pp = state_ffn + ((size_t)(l * DB + b) * 2 + i) * DUP + col; rv = pack8v(*(const f32x4*)pp, *(const f32x4*)(pp + 4)); }
            raw[i] = rv; }
    }
    f32x4 w[3][2], bs[2];
#pragma unroll
    for (int k = 0; k < 3; ++k) { w[k][0] = *(const f32x4*)(fw + (size_t)k * DUP + col); w[k][1] = *(const f32x4*)(fw + (size_t)k * DUP + col + 4); }
    bs[0] = *(const f32x4*)(fb + col); bs[1] = *(const f32x4*)(fb + col + 4);
#pragma unroll
    for (int j = 0; j < 8; ++j) { res[j][0] = bs[0].x; res[j][1] = bs[0].y; res[j][2] = bs[0].z; res[j][3] = bs[0].w; res[j][4] = bs[1].x; res[j][5] = bs[1].y; res[j][6] = bs[1].z; res[j][7] = bs[1].w; }
#pragma unroll
    for (int i = 0; i < 10; ++i) {
        float xv[8]; unpack8(raw[i], xv);
#pragma unroll
        for (int k = 0; k < 3; ++k) { const int j = i - k;
            if (j >= 0 && j < 8) {
                res[j][0] += w[k][0].x * xv[0]; res[j][1] += w[k][0].y * xv[1]; res[j][2] += w[k][0].z * xv[2]; res[j][3] += w[k][0].w * xv[3];
                res[j][4] += w[k][1].x * xv[4]; res[j][5] += w[k][1].y * xv[5]; res[j][6] += w[k][1].z * xv[6]; res[j][7] += w[k][1].w * xv[7]; } }
    }
}

__device__ __forceinline__ void ffn_elementwise(const Ctx& C_, int l) {
    const Ctx C = get_ids(C_.wave);
    KP kp = kparams(); unsigned char* ws = kp->ws;
    const float* const L_state_ffn = kp->in[5];
    float* const L_out = kp->out;
    const bf16_t* const L_UP = (const bf16_t*)(ws + WS_UP);
    bf16_t* const L_ACT = (bf16_t*)(ws + WS_ACT);
    const float* fw = kp->in[22] + (size_t)l * 3 * DUP; const float* fb = kp->in[23] + (size_t)l * DUP;
    const int gtid = C.bid * NTHREADS + C.tid, NT = C.G * NTHREADS;
    constexpr int NV = DFF / 8, NSTRIP = MREAL / 8;
    for (int it = gtid; it < NSTRIP * NV; it += NT) {
        const int strip = it / NV, v = it - strip * NV, m0 = strip * 8;
        const bool sample = m0 >= MPROMPT;
        const int t0 = sample ? 0 : (m0 % LP), b = sample ? (m0 - MPROMPT) / DS : 0;
        float gate[8][8], val[8][8];
        ffn_half(L_UP, L_state_ffn, fw, fb, l, m0, t0, sample, b, v * 8, gate);
#pragma unroll
        for (int j = 0; j < 8; ++j)
#pragma unroll
            for (int e = 0; e < 8; ++e) gate[j][e] = siluf_(gate[j][e]);
        ffn_half(L_UP, L_state_ffn, fw, fb, l, m0, t0, sample, b, DFF + v * 8, val);
#pragma unroll
        for (int j = 0; j < 8; ++j) { float a[8];
#pragma unroll
            for (int e = 0; e < 8; ++e) a[e] = gate[j][e] * val[j][e];
            *(u32x4*)(L_ACT + (size_t)(m0 + j) * DFF + v * 8) = pack8(a); }
    }
    const int gw = C.bid * NWAVES + C.wave, NGW = C.G * NWAVES, lane = C.lane;
    for (int it = gw; it < (NBATCH + DB) * 2; it += NGW) {
        if (it < NBATCH * 2) { const int b = it / 2, i = it - b * 2;
            row_bf16_to_f32(L_UP + (size_t)(b * LP + LP - 2 + i) * DUP, L_out + O_PFFN + ((size_t)(l * NBATCH + b) * 2 + i) * DUP, DUP, lane);
        } else { const int k = it - NBATCH * 2, b = k / 2, i = k - b * 2;
            row_bf16_to_f32(L_UP + (size_t)(MPROMPT + b * DS + 6 + i) * DUP, L_out + O_SFFN + ((size_t)(l * DB + b) * 2 + i) * DUP, DUP, lane); }
    }
}

__device__ __forceinline__ void final_norm(const Ctx& C_) {
    const Ctx C = get_ids(C_.wave);
    KP kp = kparams(); unsigned char* ws = kp->ws; (void)ws;
    const float* const L_final_norm_w = kp->in[25];
    float* const L_X = (float*)(ws + WS_X);
    float* const L_RSS = (float*)(ws + WS_RSS);
    float* const L_out = kp->out;
    const int gw = C.bid * NWAVES + C.wave, NGW = C.G * NWAVES, lane = C.lane;
    for (int m = gw; m < MREAL; m += NGW) {
        float* dst;
        if (m < MPROMPT) { const int b = m / LP, t = m - b * LP; if (t < NMETA) continue; dst = L_out + O_YP + ((size_t)b * SEQ + (t - NMETA)) * DM; }
        else dst = L_out + O_YS + (size_t)(m - MPROMPT) * DM;
        const f32x4* p = (const f32x4*)(L_RSS + (size_t)m * 16); const f32x4 a = p[0], b4 = p[1], c = p[2], d = p[3];
        const float s = ((a.x + a.y) + (a.z + a.w)) + ((b4.x + b4.y) + (b4.z + b4.w)) + ((c.x + c.y) + (c.z + c.w)) + ((d.x + d.y) + (d.z + d.w));
        const float rstd = rsqrtf(s * (1.0f / 1024.0f) + EPS);
#pragma unroll
        for (int j = 0; j < 4; ++j) { const f32x4 x = ((const f32x4*)(L_X + (size_t)m * DM))[lane + 64 * j], w = ((const f32x4*)L_final_norm_w)[lane + 64 * j];
            ((f32x4*)dst)[lane + 64 * j] = x * rstd * w; }
    }
}

__global__ void __launch_bounds__(NTHREADS, 2) hybrid_fwd(Params P) {
    extern __shared__ __attribute__((aligned(16))) unsigned char lds_raw[];
    LAS unsigned char* lds = (LAS unsigned char*)lds_raw;
    Ctx C;
    {
        const int t0 = threadIdx.x;
        C.tid = t0; C.lane = t0 & 63; C.wave = __builtin_amdgcn_readfirstlane(t0 >> 6); C.G = gridDim.x; C.bid = blockIdx.x;
        if (t0 < 4) ((LAS unsigned*)(lds + LDS_ST_OFF))[t0] = 0u;
        if (t0 == 0) { KP kp0 = kparams(); (void)xb_add((unsigned*)(kp0->ws + WS_CTL) + XB_XCNT(xb_xcc_id()), 1u); }
        __syncthreads();
        cg::this_grid().sync();
    }
#define LG_(x) ({ int v_ = (x); asm volatile("" : "+s"(v_)); v_; })
#define GRID_SYNC() do { KP kpb_ = kparams(); grid_barrier(kpb_->ws, lds, C.wave); } while (0)
    prologue(C, lds);
    GRID_SYNC();

    for (int l = 0; l < DEPTH; ++l) {
        { KP kp = kparams(); unsigned char* ws = kp->ws; pg8::StaticOrder S;
          pg8::Gemm g{WSP(bf16_t, WS_XB), WSP(bf16_t, WS_W1T) + (size_t)l * NPROJ * 1024, 1024, 1024, 1024, 0}; S.init(MP, NPROJ, LG_(C.G), LG_(C.bid));
          pg8::EpiScale E{WSP(bf16_t, WS_PROJ), NPROJ, WSP(float, WS_RSS), WSP(float, WS_DT), PC_DT / 256};
          pg8::gemm_phase(lds, C.wave, g, S, E); }
        GRID_SYNC();
        conv_pass(C, l);
        mixer_elementwise(C, l);
        GRID_SYNC();
        ssd_phase(C, lds, l);
        ssd_sample(C, lds, l);
        __syncthreads();
        { KP kp = kparams(); unsigned char* ws = kp->ws; pg8::StaticOrder S;
          pg8::Gemm g{WSP(bf16_t, WS_DBUF), WSP(bf16_t, WS_PWT) + (size_t)l * 1024 * 256, 1024, 256, 256, 256}; S.init(MP, 1024, LG_(C.G), LG_(C.bid));
          pg8::EpiScale E{WSP(bf16_t, WS_POOLED), 1024, nullptr, nullptr, -1};
          pg8::gemm_phase(lds, C.wave, g, S, E); }
        GRID_SYNC();
        yn_normalize(C);
        { KP kp = kparams(); unsigned char* ws = kp->ws; pg8::StaticOrder S;
          pg8::Gemm g{WSP(bf16_t, WS_POOLED), WSP(bf16_t, WS_WPOT) + (size_t)l * 1024 * 1024, 1024, 1024, 1024, 0}; S.init(pg8::MTAIL0, 1024, LG_(C.G), LG_(C.bid));
          pg8::EpiGate<0> E{WSP(bf16_t, WS_MERGED), 1024, WSP(bf16_t, WS_PROJ) + PC_GA, NPROJ};
          pg8::gemm_phase(lds, C.wave, g, S, E); pg8::gemm_tail(lds, C.wave, g, E); }
        GRID_SYNC();
        { KP kp = kparams(); unsigned char* ws = kp->ws; pg8::StaticOrder S;
          pg8::Gemm g{WSP(bf16_t, WS_YN), WSP(bf16_t, WS_WSOT) + (size_t)l * 1024 * 2048, 2048, 2048, 2048, 0}; S.init(pg8::MTAIL0, 1024, LG_(C.G), LG_(C.bid));
          pg8::EpiGate<1> E{WSP(bf16_t, WS_MERGED), 1024, WSP(bf16_t, WS_PROJ) + PC_GB, NPROJ};
          pg8::gemm_phase(lds, C.wave, g, S, E); pg8::gemm_tail(lds, C.wave, g, E); }
        GRID_SYNC();
        { KP kp = kparams(); unsigned char* ws = kp->ws; pg8::StaticOrder S;
          pg8::Gemm g{WSP(bf16_t, WS_MERGED), WSP(bf16_t, WS_WOT) + (size_t)l * 1024 * 1024, 1024, 1024, 1024, 0}; S.init(pg8::MTAIL0, 1024, LG_(C.G), LG_(C.bid));
          pg8::EpiResid E{WSP(float, WS_X), WSP(bf16_t, WS_XB), WSP(float, WS_RSS)};
          pg8::gemm_phase(lds, C.wave, g, S, E); pg8::gemm_tail(lds, C.wave, g, E); }
        GRID_SYNC();
        { KP kp = kparams(); unsigned char* ws = kp->ws; pg8::StaticOrder S;
          pg8::Gemm g{WSP(bf16_t, WS_XB), WSP(bf16_t, WS_WUPT) + (size_t)l * DUP * 1024, 1024, 1024, 1024, 0}; S.init(MP, DUP, LG_(C.G), LG_(C.bid));
          pg8::EpiScale E{WSP(bf16_t, WS_UP), DUP, WSP(float, WS_RSS), nullptr, -1};
          pg8::gemm_phase(lds, C.wave, g, S, E); }
        GRID_SYNC();
        ffn_elementwise(C, l);
        GRID_SYNC();
        { KP kp = kparams(); unsigned char* ws = kp->ws; pg8::StaticOrder S;
          pg8::Gemm g{WSP(bf16_t, WS_ACT), WSP(bf16_t, WS_WDT) + (size_t)l * 1024 * DFF, DFF, DFF, DFF, 0}; S.init(pg8::MTAIL0, 1024, LG_(C.G), LG_(C.bid));
          pg8::EpiResid E{WSP(float, WS_X), WSP(bf16_t, WS_XB), WSP(float, WS_RSS)};
          pg8::gemm_phase(lds, C.wave, g, S, E); pg8::gemm_tail(lds, C.wave, g, E); }
        GRID_SYNC();
    }
    final_norm(C);
}

extern "C" void kernel_launch(void* const* d_in, const int* in_sizes, int n_in, void* d_out, int out_size, void* d_ws, size_t ws_size, hipStream_t stream) {
    static int grid_blocks = 0;
    if (grid_blocks == 0) {
        if (n_in != 26 || (size_t)out_size != O_END || ws_size < WS_END) {
            fprintf(stderr, "kernel_launch: unexpected shapes: n_in %d out %d (want %zu) ws %zu (want %zu)\n", n_in, out_size, (size_t)O_END, ws_size, (size_t)WS_END); grid_blocks = -1; return; }
        int dev = 0, cus = 0, per_cu = 0;
        hipGetDevice(&dev);
        hipDeviceGetAttribute(&cus, hipDeviceAttributeMultiprocessorCount, dev);
        if (hipFuncSetAttribute((const void*)hybrid_fwd, hipFuncAttributeMaxDynamicSharedMemorySize, LDS_BYTES) != hipSuccess) { fprintf(stderr, "kernel_launch: hipFuncSetAttribute failed\n"); grid_blocks = -1; return; }
        if (hipOccupancyMaxActiveBlocksPerMultiprocessor(&per_cu, (const void*)hybrid_fwd, NTHREADS, LDS_BYTES) != hipSuccess || per_cu < 1) { fprintf(stderr, "kernel_launch: occupancy query gave %d\n", per_cu); per_cu = 1; }
        (void)hipGetLastError();
        grid_blocks = cus * per_cu;
    }
    if (grid_blocks < 0) return;
    if (hipMemsetAsync((char*)d_ws + WS_CTL, 0, WS_CTL_BYTES, stream) != hipSuccess) { fprintf(stderr, "kernel_launch: memset of barrier words failed\n"); return; }
    Params p{};
    for (int i = 0; i < 26; ++i) p.in[i] = (const float*)d_in[i];
    p.out = (float*)d_out; p.ws = (unsigned char*)d_ws;
    void* args[] = {&p};
    hipError_t e = hipLaunchCooperativeKernel((const void*)hybrid_fwd, dim3(grid_blocks), dim3(NTHREADS), args, LDS_BYTES, stream);
    if (e != hipSuccess) fprintf(stderr, "cooperative launch failed: %s (grid %d)\n", hipGetErrorString(e), grid_blocks);
}
```

```cpp
#include <hip/hip_runtime.h>
#include <hip/hip_cooperative_groups.h>
#include <cstdio>
#include <cstdint>
namespace cg = cooperative_groups;

#define LAS __attribute__((address_space(3)))
typedef unsigned short bf16_t;
typedef short bf16x8 __attribute__((ext_vector_type(8)));
typedef float f32x4 __attribute__((ext_vector_type(4)));
typedef unsigned u32x4 __attribute__((ext_vector_type(4)));
typedef unsigned u32x2 __attribute__((ext_vector_type(2)));

constexpr int DM = 1024, NBATCH = 8, SEQ = 2048, NMETA = 16, LP = SEQ + NMETA, DEPTH = 4, DB = 128, DS = 8;
constexpr int MPROMPT = NBATCH * LP;
constexpr int MREAL = MPROMPT + DB * DS;
constexpr int MP = 17664;
constexpr int NH = 32, HD = 64, NG = 4, NST = 128, CONVD = 3072, DFF = 2816, DUP = 5632, DINNER = 2048;
constexpr int NPROJ = 8448;
constexpr int PC_U = 0, PC_Z = 1024, PC_XBC = 3072, PC_GA = 6144, PC_GB = 7168, PC_DT = 8192;
constexpr float EPS = 1e-6f;
constexpr int NTHREADS = 512, NWAVES = 8;
constexpr int LDS_BYTES = 147456;
constexpr int LDS_ST_OFF = LDS_BYTES - 16;

constexpr size_t al256(size_t x) { return (x + 255) & ~(size_t)255; }
constexpr size_t WS_W1T = 0;
constexpr size_t WS_PWT = WS_W1T + al256((size_t)DEPTH * NPROJ * 1024 * 2);
constexpr size_t WS_WPOT = WS_PWT + al256((size_t)DEPTH * 1024 * 256 * 2);
constexpr size_t WS_WSOT = WS_WPOT + al256((size_t)DEPTH * 1024 * 1024 * 2);
constexpr size_t WS_WOT = WS_WSOT + al256((size_t)DEPTH * 1024 * 2048 * 2);
constexpr size_t WS_WUPT = WS_WOT + al256((size_t)DEPTH * 1024 * 1024 * 2);
constexpr size_t WS_WDT = WS_WUPT + al256((size_t)DEPTH * DUP * 1024 * 2);
constexpr size_t WS_X = WS_WDT + al256((size_t)DEPTH * 1024 * DFF * 2);
constexpr size_t WS_XB = WS_X + al256((size_t)MP * 1024 * 4);
constexpr size_t WS_RSS = WS_XB + al256((size_t)MP * 1024 * 2);
constexpr size_t WS_PROJ = WS_RSS + al256((size_t)MP * 16 * 4);
constexpr size_t WS_DT = WS_PROJ + al256((size_t)MP * NPROJ * 2);
constexpr size_t WS_DBUF = WS_DT + al256((size_t)MP * 32 * 4);
constexpr size_t WS_POOLED = WS_DBUF + al256((size_t)MP * 1024 * 2);
constexpr size_t WS_YN = WS_POOLED + al256((size_t)MP * 1024 * 2);
constexpr size_t WS_SSQ = WS_YN + al256((size_t)MP * 2048 * 2);
constexpr size_t WS_MERGED = WS_SSQ + al256((size_t)MP * 32 * 4);
constexpr size_t WS_UP = WS_MERGED + al256((size_t)MP * 1024 * 2);
constexpr size_t WS_ACT = WS_UP + al256((size_t)MP * DUP * 2);
constexpr size_t WS_XBCC = WS_ACT + al256((size_t)MP * DFF * 2);
constexpr size_t WS_DTS = WS_XBCC + al256((size_t)MP * CONVD * 2);
constexpr size_t WS_CTL = WS_DTS + al256((size_t)MP * 32 * 4);
constexpr size_t WS_CTL_BYTES = 16384;
constexpr size_t WS_END = WS_CTL + WS_CTL_BYTES;

constexpr size_t O_YP = 0;
constexpr size_t O_YS = O_YP + (size_t)NBATCH * SEQ * DM;
constexpr size_t O_PPOOL = O_YS + (size_t)DB * DS * DM;
constexpr size_t O_PCONV = O_PPOOL + (size_t)DEPTH * NBATCH * 15 * 1024;
constexpr size_t O_PSSM = O_PCONV + (size_t)DEPTH * NBATCH * 3 * CONVD;
constexpr size_t O_PFFN = O_PSSM + (size_t)DEPTH * NBATCH * NH * HD * NST;
constexpr size_t O_SPOOL = O_PFFN + (size_t)DEPTH * NBATCH * 2 * DUP;
constexpr size_t O_SCONV = O_SPOOL + (size_t)DEPTH * DB * 15 * 1024;
constexpr size_t O_SSSM = O_SCONV + (size_t)DEPTH * DB * 3 * CONVD;
constexpr size_t O_SFFN = O_SSSM + (size_t)DEPTH * DB * NH * HD * NST;
constexpr size_t O_END = O_SFFN + (size_t)DEPTH * DB * 2 * DUP;

__device__ __forceinline__ unsigned cvt_pk_bf16(float lo, float hi) { unsigned r; asm("v_cvt_pk_bf16_f32 %0, %1, %2" : "=v"(r) : "v"(lo), "v"(hi)); return r; }
__device__ __forceinline__ unsigned f2bf(float f) { return cvt_pk_bf16(f, f) & 0xffffu; }
__device__ __forceinline__ unsigned pk2(float lo, float hi) { return cvt_pk_bf16(lo, hi); }
__device__ __forceinline__ float bflo(unsigned w) { return __builtin_bit_cast(float, w << 16); }
__device__ __forceinline__ float bfhi(unsigned w) { return __builtin_bit_cast(float, w & 0xffff0000u); }
__device__ __forceinline__ float bf1(bf16_t h) { return __builtin_bit_cast(float, ((unsigned)h) << 16); }
__device__ __forceinline__ float sigmoidf_(float x) { return __builtin_amdgcn_rcpf(1.0f + __expf(-x)); }
__device__ __forceinline__ float siluf_(float x) { return x * sigmoidf_(x); }
__device__ __forceinline__ void unpack8(const u32x4 w, float (&o)[8]) {
    o[0] = bflo(w.x); o[1] = bfhi(w.x); o[2] = bflo(w.y); o[3] = bfhi(w.y); o[4] = bflo(w.z); o[5] = bfhi(w.z); o[6] = bflo(w.w); o[7] = bfhi(w.w);
}
__device__ __forceinline__ u32x4 pack8(const float (&o)[8]) {
    u32x4 w; w.x = pk2(o[0], o[1]); w.y = pk2(o[2], o[3]); w.z = pk2(o[4], o[5]); w.w = pk2(o[6], o[7]); return w;
}
__device__ __forceinline__ float shx(float v, int m, int lane) { return __builtin_bit_cast(float, __builtin_amdgcn_ds_bpermute((lane ^ m) << 2, __builtin_bit_cast(int, v))); }
__device__ __forceinline__ float shup(float v, int d, int lane) { return __builtin_bit_cast(float, __builtin_amdgcn_ds_bpermute((lane - d) << 2, __builtin_bit_cast(int, v))); }
__device__ __forceinline__ float shidx(float v, int src) { return __builtin_bit_cast(float, __builtin_amdgcn_ds_bpermute(src << 2, __builtin_bit_cast(int, v))); }
__device__ __forceinline__ float wave_sum(float v) {
#pragma unroll
    for (int o = 1; o < 64; o <<= 1) v += __shfl_xor(v, o);
    return v;
}
__device__ __forceinline__ u32x4 pack8v(const f32x4 a, const f32x4 b) { u32x4 w; w.x = pk2(a.x, a.y); w.y = pk2(a.z, a.w); w.z = pk2(b.x, b.y); w.w = pk2(b.z, b.w); return w; }
#define LDS_WAIT() asm volatile("s_waitcnt lgkmcnt(0)" ::: "memory")
#define LBAR() do { asm volatile("s_waitcnt lgkmcnt(0)" ::: "memory"); __builtin_amdgcn_s_barrier(); asm volatile("" ::: "memory"); } while (0)

namespace pg8 {
constexpr int BM = 256, BK = 64, HALF = 128, HTB = HALF * BK * 2, STAGE_BYTES = 8 * HTB, NXCD = 8, WGM = 8;
__host__ __device__ __forceinline__ int lds_byte(int r, int c) { const int st = (r >> 4) * 2 + (c >> 5), rr = r & 15, cc = c & 31, ob = rr * 64 + cc * 2; return st * 1024 + (ob ^ (((ob >> 9) & 1) << 5)); }
__host__ __device__ __forceinline__ void stage_rc(int b, int& R, int& C) { const int st = b / 1024, sb = b % 1024, swz = sb ^ (((sb >> 9) & 1) << 5); R = (st >> 1) * 16 + swz / 64; C = (st & 1) * 32 + (swz % 64) / 2; }
__host__ __device__ __forceinline__ int perm32(int rho) { const int n = rho >> 4, i = rho & 15; return 8 * (i >> 2) + 4 * n + (i & 3); }

struct Unit { int pm, pn; };
struct Gemm { const bf16_t* A; const bf16_t* Bt; int lda, ldb, K, a_pn_off; };

struct StaticOrder {
    int nM, nN, nwg, G, c;
    __device__ void init(int M, int N, int G_, int c_) { nM = M / BM; nN = N / BM; nwg = nM * nN; G = G_; c = c_; }
    __device__ bool next(int i, Unit& u) const {
        const long L = (long)i * G + c; if (L >= nwg) return false;
        int wgid = (int)L; { const int q = nwg / NXCD, r = nwg % NXCD, xcd = wgid % NXCD, off = wgid / NXCD; wgid = (xcd < r ? xcd * (q + 1) : r * (q + 1) + (xcd - r) * q) + off; }
        const int nig = WGM * nN, gid = wgid / nig, fm = gid * WGM, gsz = (nM - fm) < WGM ? (nM - fm) : WGM;
        u.pm = fm + ((wgid % nig) % gsz); u.pn = (wgid % nig) / gsz; return true;
    }
};


struct EpiScale {
    bf16_t* O; int ldc; const float* rss; float* dtf; int dt_pn;
    __device__ __forceinline__ void operator()(const f32x4 (&acc)[2][2][4][2], const Unit& u, int wr, int wc, int fr, int fq) const {
        const int row0 = u.pm * BM + wr * 64 + fr, col0 = u.pn * BM + wc * 32 + 8 * fq;
#pragma unroll
        for (int ai = 0; ai < 2; ++ai)
#pragma unroll
            for (int m = 0; m < 4; ++m) {
                const int row = row0 + ai * HALF + m * 16;
                float sc = 1.f;
                if (rss) { const f32x4* p = (const f32x4*)(rss + (size_t)row * 16); const f32x4 a = p[0], b = p[1], c = p[2], d = p[3];
                    const float s = ((a.x + a.y) + (a.z + a.w)) + ((b.x + b.y) + (b.z + b.w)) + ((c.x + c.y) + (c.z + c.w)) + ((d.x + d.y) + (d.z + d.w));
                    sc = rsqrtf(s * (1.0f / 1024.0f) + EPS); }
                bf16_t* rowp = O + (size_t)row * ldc + col0;
#pragma unroll
                for (int bj = 0; bj < 2; ++bj) { const f32x4 v0 = acc[ai][bj][m][0] * sc, v1 = acc[ai][bj][m][1] * sc;
                    u32x4 w; w.x = cvt_pk_bf16(v0[0], v0[1]); w.y = cvt_pk_bf16(v0[2], v0[3]); w.z = cvt_pk_bf16(v1[0], v1[1]); w.w = cvt_pk_bf16(v1[2], v1[3]);
                    *(u32x4*)(rowp + bj * HALF) = w;
                    if (bj == 0 && dtf != nullptr && u.pn == dt_pn && wc == 0) { float* dp = dtf + (size_t)row * 32 + 8 * fq; *(f32x4*)dp = v0; *(f32x4*)(dp + 4) = v1; } }
            }
    }
};
template <int MODE> struct EpiGate {
    bf16_t* O; int ldc; const bf16_t* gate; int ldg;
    struct Pre { u32x2 gw, ow; };
    __device__ __forceinline__ Pre tail4_pre(int row, int col) const { Pre p; p.gw = *(const u32x2*)(gate + (size_t)row * ldg + col); p.ow = (u32x2){0u, 0u};
        if (MODE == 1) p.ow = *(const u32x2*)(O + (size_t)row * ldc + col); return p; }
    __device__ __forceinline__ void tail4(const f32x4 v, const Pre& pre, int row, int col, int l16) const {
        const u32x2 gw = pre.gw;
        float v0 = sigmoidf_(bflo(gw.x)) * v[0], v1 = sigmoidf_(bfhi(gw.x)) * v[1], v2 = sigmoidf_(bflo(gw.y)) * v[2], v3 = sigmoidf_(bfhi(gw.y)) * v[3];
        bf16_t* op = O + (size_t)row * ldc + col;
        if (MODE == 1) { const u32x2 ow = pre.ow; v0 += bflo(ow.x); v1 += bfhi(ow.x); v2 += bflo(ow.y); v3 += bfhi(ow.y); }
        u32x2 w; w.x = cvt_pk_bf16(v0, v1); w.y = cvt_pk_bf16(v2, v3);
        *(u32x2*)op = w;
    }
    __device__ __forceinline__ void operator()(const f32x4 (&acc)[2][2][4][2], const Unit& u, int wr, int wc, int fr, int fq) const {
        const int row0 = u.pm * BM + wr * 64 + fr, col0 = u.pn * BM + wc * 32 + 8 * fq;
#pragma unroll
        for (int ai = 0; ai < 2; ++ai) {
            u32x4 gwv[4][2], owv[4][2];
#pragma unroll
            for (int m = 0; m < 4; ++m)
#pragma unroll
                for (int bj = 0; bj < 2; ++bj) { const size_t row = (size_t)(row0 + ai * HALF + m * 16);
                    gwv[m][bj] = *(const u32x4*)(gate + row * ldg + col0 + bj * HALF);
                    if (MODE == 1) owv[m][bj] = *(const u32x4*)(O + row * ldc + col0 + bj * HALF); }
#pragma unroll
            for (int m = 0; m < 4; ++m) {
                bf16_t* rowp = O + (size_t)(row0 + ai * HALF + m * 16) * ldc + col0;
#pragma unroll
                for (int bj = 0; bj < 2; ++bj) {
                    float g[8]; unpack8(gwv[m][bj], g);
                    const f32x4 a0 = acc[ai][bj][m][0], a1 = acc[ai][bj][m][1];
                    float v[8];
                    v[0] = sigmoidf_(g[0]) * a0[0]; v[1] = sigmoidf_(g[1]) * a0[1]; v[2] = sigmoidf_(g[2]) * a0[2]; v[3] = sigmoidf_(g[3]) * a0[3];
                    v[4] = sigmoidf_(g[4]) * a1[0]; v[5] = sigmoidf_(g[5]) * a1[1]; v[6] = sigmoidf_(g[6]) * a1[2]; v[7] = sigmoidf_(g[7]) * a1[3];
                    if (MODE == 1) { float o[8]; unpack8(owv[m][bj], o);
#pragma unroll
                        for (int e = 0; e < 8; ++e) v[e] += o[e]; }
                    u32x4 w; w.x = cvt_pk_bf16(v[0], v[1]); w.y = cvt_pk_bf16(v[2], v[3]); w.z = cvt_pk_bf16(v[4], v[5]); w.w = cvt_pk_bf16(v[6], v[7]);
                    *(u32x4*)(rowp + bj * HALF) = w; }
            }
        }
    }
};
struct EpiResid {
    float* X; bf16_t* XB; float* rss;
    struct Pre { f32x4 x; };
    __device__ __forceinline__ Pre tail4_pre(int row, int col) const { Pre p; p.x = *(const f32x4*)(X + (size_t)row * DM + col); return p; }
    __device__ __forceinline__ void tail4(const f32x4 v, const Pre& pre, int row, int col, int l16) const {
        float* xp = X + (size_t)row * DM + col;
        f32x4 x0 = pre.x; x0 += v; *(f32x4*)xp = x0;
        float ss = (x0[0] * x0[0] + x0[1] * x0[1]) + (x0[2] * x0[2] + x0[3] * x0[3]);
        u32x2 w; w.x = cvt_pk_bf16(x0[0], x0[1]); w.y = cvt_pk_bf16(x0[2], x0[3]);
        *(u32x2*)(XB + (size_t)row * DM + col) = w;
        ss += shx(ss, 1, l16); ss += shx(ss, 2, l16); ss += shx(ss, 4, l16); ss += shx(ss, 8, l16);
        if ((l16 & 15) == 0) rss[(size_t)row * 16 + (col >> 6)] = ss;
    }
    __device__ __forceinline__ void operator()(const f32x4 (&acc)[2][2][4][2], const Unit& u, int wr, int wc, int fr, int fq) const {
        const int row0 = u.pm * BM + wr * 64 + fr, col0 = u.pn * BM + wc * 32 + 8 * fq;
#pragma unroll
        for (int ai = 0; ai < 2; ++ai)
#pragma unroll
            for (int mp = 0; mp < 2; ++mp) {
                f32x4 xv[2][2][2];
#pragma unroll
                for (int mm = 0; mm < 2; ++mm)
#pragma unroll
                    for (int bj = 0; bj < 2; ++bj) { const float* xp = X + (size_t)(row0 + ai * HALF + (2 * mp + mm) * 16) * DM + col0 + bj * HALF;
                        xv[mm][bj][0] = *(const f32x4*)xp; xv[mm][bj][1] = *(const f32x4*)(xp + 4); }
#pragma unroll
                for (int mm = 0; mm < 2; ++mm) {
                    const int m = 2 * mp + mm, row = row0 + ai * HALF + m * 16;
                    float* xp = X + (size_t)row * DM + col0; bf16_t* bp = XB + (size_t)row * DM + col0;
                    float ss = 0.f;
#pragma unroll
                    for (int bj = 0; bj < 2; ++bj) {
                        f32x4 x0 = xv[mm][bj][0], x1 = xv[mm][bj][1];
                        x0 += acc[ai][bj][m][0]; x1 += acc[ai][bj][m][1];
                        *(f32x4*)(xp + bj * HALF) = x0; *(f32x4*)(xp + bj * HALF + 4) = x1;
                        ss += (x0[0] * x0[0] + x0[1] * x0[1]) + (x0[2] * x0[2] + x0[3] * x0[3]) + (x1[0] * x1[0] + x1[1] * x1[1]) + (x1[2] * x1[2] + x1[3] * x1[3]);
                        u32x4 w; w.x = cvt_pk_bf16(x0[0], x0[1]); w.y = cvt_pk_bf16(x0[2], x0[3]); w.z = cvt_pk_bf16(x1[0], x1[1]); w.w = cvt_pk_bf16(x1[2], x1[3]);
                        *(u32x4*)(bp + bj * HALF) = w; }
                    ss += shx(ss, 16, fq * 16 + fr); ss += shx(ss, 32, fq * 16 + fr);
                    if (fq == 0) rss[(size_t)row * 16 + u.pn * 4 + wc] = ss;
                }
            }
    }
};

template <class Epi>
__device__ __forceinline__ void gemm_phase(LAS unsigned char* lds_in, int wave_in, const Gemm g, const StaticOrder& S, const Epi& E) {
    int lane = (int)__builtin_amdgcn_mbcnt_hi(~0u, __builtin_amdgcn_mbcnt_lo(~0u, 0u)); asm volatile("" : "+v"(lane));
    int wid = wave_in; asm volatile("" : "+s"(wid));
    const int tid = wid * 64 + lane;
    LAS unsigned char* lds = lds_in; asm volatile("" : "+s"(lds));
    const int wr = wid >> 2, wc = wid & 3, fr = lane & 15, fq = lane >> 4;
    const int K = g.K, nt = K / BK;
    unsigned voffA[2], voffB[2];
#pragma unroll
    for (int i = 0; i < 2; ++i) { int R, C; stage_rc(tid * 16 + i * 8192, R, C); const int Rb = (R & ~31) + perm32(R & 31);
        voffA[i] = (unsigned)(R * g.lda + C) * 2u; voffB[i] = (unsigned)(Rb * g.ldb + C) * 2u; }
    const size_t kstep = (size_t)(BK * 2);
    const size_t hstepA = (size_t)HALF * g.lda * 2, hstepB = (size_t)HALF * g.ldb * 2;
    const size_t tstepA = 2 * hstepA, tstepB = 2 * hstepB;
    const unsigned ldsw = (unsigned)wid * 1024u;
    const int aoff = lds_byte(wr * 64 + fr, fq * 8), boff = lds_byte(wc * 32 + fr, fq * 8);
#define PG8_SA(b, h) (((b) * 2 + (h)) * HTB)
#define PG8_SB(b, h) ((4 + (b) * 2 + (h)) * HTB)
#define PG8_STAGE(bufoff, gbase, voff) do { _Pragma("unroll") for (int _i = 0; _i < 2; ++_i) \
        __builtin_amdgcn_global_load_lds((const unsigned*)((const char*)(gbase) + (voff)[_i]), (LAS unsigned*)(lds + (bufoff) + ldsw + _i * 8192), 16, 0, 0); } while (0)
#define PG8_LDA(dst, b, h) do { _Pragma("unroll") for (int m = 0; m < 4; ++m) _Pragma("unroll") for (int k = 0; k < 2; ++k) dst[m][k] = *(const LAS bf16x8*)(lds + PG8_SA(b, h) + aoff + m * 2048 + k * 1024); } while (0)
#define PG8_LDB(dst, b, h) do { _Pragma("unroll") for (int n = 0; n < 2; ++n) _Pragma("unroll") for (int k = 0; k < 2; ++k) dst[n][k] = *(const LAS bf16x8*)(lds + PG8_SB(b, h) + boff + n * 2048 + k * 1024); } while (0)
#define PG8_MMA(ai, bj, At, Bt) do { __builtin_amdgcn_s_setprio(1); _Pragma("unroll") for (int m = 0; m < 4; ++m) _Pragma("unroll") for (int n = 0; n < 2; ++n) _Pragma("unroll") for (int k = 0; k < 2; ++k) \
        acc[ai][bj][m][n] = __builtin_amdgcn_mfma_f32_16x16x32_bf16(Bt[n][k], At[m][k], acc[ai][bj][m][n], 0, 0, 0); __builtin_amdgcn_s_setprio(0); } while (0)
#define PG8_WAIT_V(n) asm volatile("s_waitcnt vmcnt(" #n ")" ::: "memory")
#define PG8_WAIT_L(n) asm volatile("s_waitcnt lgkmcnt(" #n ")" ::: "memory")
#define PG8_BAR __builtin_amdgcn_s_barrier()
#define PG8_SCHED __builtin_amdgcn_sched_barrier(0)
    Unit cur, nxt; int ui = 0;
    if (!S.next(0, cur)) return;
    f32x4 acc[2][2][4][2];
#pragma unroll
    for (int a = 0; a < 2; ++a)
#pragma unroll
        for (int b = 0; b < 2; ++b)
#pragma unroll
            for (int m = 0; m < 4; ++m)
#pragma unroll
                for (int n = 0; n < 2; ++n) acc[a][b][m][n] = (f32x4){0.f, 0.f, 0.f, 0.f};
    bf16x8 At[4][2], B0[2][2], B1[2][2];
    const char* cA = (const char*)g.A + (size_t)cur.pm * tstepA + (size_t)cur.pn * g.a_pn_off * 2; const char* cB = (const char*)g.Bt + (size_t)cur.pn * tstepB;
    PG8_STAGE(PG8_SB(0, 0), cB, voffB); PG8_STAGE(PG8_SB(0, 1), cB + hstepB, voffB); PG8_STAGE(PG8_SA(0, 0), cA, voffA); PG8_STAGE(PG8_SA(0, 1), cA + hstepA, voffA);
    if (wr == 1) PG8_BAR;
    PG8_WAIT_V(2); PG8_BAR;
    PG8_STAGE(PG8_SB(1, 0), cB + kstep, voffB); PG8_STAGE(PG8_SA(1, 0), cA + kstep, voffA); PG8_STAGE(PG8_SB(1, 1), cB + hstepB + kstep, voffB);
    PG8_WAIT_V(6); PG8_BAR;
    for (;;) {
        const bool has_next = S.next(ui + 1, nxt);
        const char* nA = has_next ? (const char*)g.A + (size_t)nxt.pm * tstepA + (size_t)nxt.pn * g.a_pn_off * 2 : cA; const char* nB = has_next ? (const char*)g.Bt + (size_t)nxt.pn * tstepB : cB;
        for (int t = 0; t < nt; t += 2) {
            const bool last = (t == nt - 2);
            const char* a1 = cA + (size_t)(t + 1) * kstep;
            const char* a2 = last ? nA : cA + (size_t)(t + 2) * kstep; const char* b2 = last ? nB : cB + (size_t)(t + 2) * kstep;
            const char* a3 = a2 + kstep; const char* b3 = b2 + kstep;
            PG8_LDB(B0, 0, 0); PG8_LDB(B1, 0, 1); PG8_SCHED; PG8_LDA(At, 0, 0); PG8_STAGE(PG8_SA(1, 1), a1 + hstepA, voffA);
            PG8_WAIT_V(8); PG8_WAIT_L(0); PG8_BAR; PG8_MMA(0, 0, At, B0); PG8_MMA(0, 1, At, B1); PG8_BAR; PG8_SCHED;
            PG8_LDA(At, 0, 1); PG8_STAGE(PG8_SB(0, 0), b2, voffB); PG8_STAGE(PG8_SB(0, 1), b2 + hstepB, voffB); PG8_STAGE(PG8_SA(0, 0), a2, voffA);
            PG8_WAIT_V(8); PG8_WAIT_L(0); PG8_BAR; PG8_MMA(1, 0, At, B0); PG8_MMA(1, 1, At, B1); PG8_BAR; PG8_SCHED;
            PG8_LDB(B0, 1, 0); PG8_LDB(B1, 1, 1); PG8_SCHED; PG8_LDA(At, 1, 0); PG8_STAGE(PG8_SA(0, 1), a2 + hstepA, voffA);
            PG8_WAIT_V(8); PG8_WAIT_L(0); PG8_BAR; PG8_MMA(0, 0, At, B0); PG8_MMA(0, 1, At, B1); PG8_BAR; PG8_SCHED;
            PG8_LDA(At, 1, 1); PG8_STAGE(PG8_SB(1, 0), b3, voffB); PG8_STAGE(PG8_SB(1, 1), b3 + hstepB, voffB); PG8_STAGE(PG8_SA(1, 0), a3, voffA);
            PG8_WAIT_V(8); PG8_WAIT_L(0); PG8_BAR; PG8_MMA(1, 0, At, B0); PG8_MMA(1, 1, At, B1); PG8_BAR; PG8_SCHED;
        }
        if (wr == 0) PG8_BAR;
        E(acc, cur, wr, wc, fr, fq);
        if (!has_next) break;
#pragma unroll
        for (int a = 0; a < 2; ++a)
#pragma unroll
            for (int b = 0; b < 2; ++b)
#pragma unroll
                for (int m = 0; m < 4; ++m)
#pragma unroll
                    for (int n = 0; n < 2; ++n) acc[a][b][m][n] = (f32x4){0.f, 0.f, 0.f, 0.f};
        cur = nxt; cA = nA; cB = nB; ++ui;
        if (wr == 1) PG8_BAR;
    }
    PG8_WAIT_V(0);
    PG8_BAR;
#undef PG8_SA
#undef PG8_SB
#undef PG8_STAGE
#undef PG8_LDA
#undef PG8_LDB
#undef PG8_MMA
#undef PG8_WAIT_V
#undef PG8_WAIT_L
#undef PG8_BAR
#undef PG8_SCHED
}

constexpr int MTAIL0 = 16384;
template <class Epi>
__device__ __forceinline__ void gemm_tail(LAS unsigned char* lds_in, int wave_in, const Gemm g, const Epi& E) {
    int lane = (int)__builtin_amdgcn_mbcnt_hi(~0u, __builtin_amdgcn_mbcnt_lo(~0u, 0u)); asm volatile("" : "+v"(lane));
    int wid = wave_in; asm volatile("" : "+s"(wid));
    LAS unsigned char* lds = lds_in; asm volatile("" : "+s"(lds));
    int G = gridDim.x, bid = blockIdx.x; asm volatile("" : "+s"(G)); asm volatile("" : "+s"(bid));
    const int r = lane & 15, q = lane >> 4;
    constexpr int NRT = (MREAL - MTAIL0) / 32, NCT = 1024 / 64;
    const int klen = g.K / 8, kbeg = wid * klen;
    const int nx = (G % 8 == 0) ? 8 : 1, x = (nx == 8) ? (bid & 7) : 0, j = (nx == 8) ? (bid >> 3) : bid, nj = G / nx;
    const int ct_per = NCT / nx, ntile = NRT * ct_per;
    LAS float* red = (LAS float*)lds;
    const size_t a16 = (size_t)16 * g.lda, b16 = (size_t)16 * g.ldb;
    bf16x8 pa[4][2], pb[4][4];
#define TAIL_PTRS(tt_, rt_, ct_, row0_, col0_, ap_, bp_) const int rt_ = (tt_) % NRT, ct_ = x * ct_per + (tt_) / NRT, row0_ = MTAIL0 + 32 * rt_, col0_ = 64 * ct_; \
        const bf16_t* ap_ = g.A + (size_t)(row0_ + r) * g.lda + 8 * q + kbeg + (size_t)(col0_ >> 8) * g.a_pn_off; const bf16_t* bp_ = g.Bt + (size_t)(col0_ + r) * g.ldb + 8 * q + kbeg; (void)rt_; (void)ct_;
#define TAIL_PF(ap_, bp_) do { _Pragma("unroll") for (int s_ = 0; s_ < 4; ++s_) { _Pragma("unroll") for (int i = 0; i < 2; ++i) pa[s_][i] = *(const bf16x8*)((ap_) + i * a16 + 32 * s_); \
        _Pragma("unroll") for (int f = 0; f < 4; ++f) pb[s_][f] = *(const bf16x8*)((bp_) + f * b16 + 32 * s_); } } while (0)
    if (j < ntile) { TAIL_PTRS(j, rt0, ct0, row00, col00, ap0, bp0); (void)row00; TAIL_PF(ap0, bp0); }
    for (int tt = j; tt < ntile; tt += nj) {
        TAIL_PTRS(tt, rt, ct, row0, col0, ap, bp);
        const int rr = 4 * wid + (lane >> 4), cc = 4 * (lane & 15);
        const typename Epi::Pre pre = E.tail4_pre(row0 + rr, col0 + cc);
        f32x4 acc[2][4];
#pragma unroll
        for (int i = 0; i < 2; ++i)
#pragma unroll
            for (int f = 0; f < 4; ++f) acc[i][f] = (f32x4){0.f, 0.f, 0.f, 0.f};
#pragma unroll
        for (int s_ = 0; s_ < 4; ++s_)
#pragma unroll
            for (int i = 0; i < 2; ++i)
#pragma unroll
                for (int f = 0; f < 4; ++f) acc[i][f] = __builtin_amdgcn_mfma_f32_16x16x32_bf16(pb[s_][f], pa[s_][i], acc[i][f], 0, 0, 0);
#pragma unroll 4
        for (int k0 = 128; k0 < klen; k0 += 32) {
            bf16x8 a[2], b[4];
#pragma unroll
            for (int i = 0; i < 2; ++i) a[i] = *(const bf16x8*)(ap + i * a16 + k0);
#pragma unroll
            for (int f = 0; f < 4; ++f) b[f] = *(const bf16x8*)(bp + f * b16 + k0);
#pragma unroll
            for (int i = 0; i < 2; ++i)
#pragma unroll
                for (int f = 0; f < 4; ++f) acc[i][f] = __builtin_amdgcn_mfma_f32_16x16x32_bf16(b[f], a[i], acc[i][f], 0, 0, 0);
        }
        __builtin_amdgcn_sched_barrier(0);
        if (tt + nj < ntile) { TAIL_PTRS(tt + nj, rtn, ctn, row0n, col0n, apn, bpn); (void)row0n; TAIL_PF(apn, bpn); }
        __builtin_amdgcn_sched_barrier(0);
#pragma unroll
        for (int i = 0; i < 2; ++i)
#pragma unroll
            for (int f = 0; f < 4; ++f) *(LAS f32x4*)(red + wid * 2048 + (16 * i + r) * 64 + 16 * f + 4 * q) = acc[i][f];
        LBAR();
        {
            f32x4 v = (f32x4){0.f, 0.f, 0.f, 0.f};
#pragma unroll
            for (int w = 0; w < 8; ++w) v += *(const LAS f32x4*)(red + w * 2048 + rr * 64 + cc);
            E.tail4(v, pre, row0 + rr, col0 + cc, lane);
        }
        LBAR();
    }
#undef TAIL_PTRS
#undef TAIL_PF
}
}

struct Params { const float* in[26]; float* out; unsigned char* ws; };

typedef const Params __attribute__((address_space(4)))* KP;
__device__ __forceinline__ KP kparams() { KP p = (KP)__builtin_amdgcn_kernarg_segment_ptr(); asm volatile("" : "+s"(p)); return p; }
struct Ctx { int tid, lane, wave, G, bid; };
__device__ __forceinline__ Ctx get_ids(int wave_in) { Ctx I;
    int ln = (int)__builtin_amdgcn_mbcnt_hi(~0u, __builtin_amdgcn_mbcnt_lo(~0u, 0u)); asm volatile("" : "+v"(ln));
    int wv = wave_in; asm volatile("" : "+s"(wv));
    int gg = gridDim.x, bb = blockIdx.x; asm volatile("" : "+s"(gg)); asm volatile("" : "+s"(bb));
    I.lane = ln; I.wave = wv; I.tid = wv * 64 + ln; I.G = gg; I.bid = bb; return I; }

#define XB_TMO      128
#define XB_XCNT(j)  (256  + 64 * (j))
#define XB_XSUB(j)  (1280 + 64 * (j))
#define XB_XGEN(j)  (2304 + 64 * (j))
#define XB_TOP      3328
#define XB_TOPGEN   3392
#define XCD_BAR_WORDS 3456
#define XB_SPIN_CAP (1u << 20)
__device__ __forceinline__ unsigned xb_ld(unsigned* p)              { return __hip_atomic_load(p, __ATOMIC_RELAXED, __HIP_MEMORY_SCOPE_AGENT); }
__device__ __forceinline__ unsigned xb_add(unsigned* p, unsigned v) { return __hip_atomic_fetch_add(p, v, __ATOMIC_RELAXED, __HIP_MEMORY_SCOPE_AGENT); }
__device__ __forceinline__ unsigned xb_xcc_id() { return (unsigned)__builtin_amdgcn_s_getreg((3 << 11) | 20) & 0xFu; }
#define XB_SPIN(cond, bar) do { unsigned _sp = 0; while (cond) { __builtin_amdgcn_s_sleep(1); \
    if ((++_sp & 255u) == 0u) { if (xb_ld(&(bar)[XB_TMO])) break; if (_sp > XB_SPIN_CAP) { atomicAdd(&(bar)[XB_TMO], 1u); break; } } } } while (0)
__device__ __forceinline__ void xcd_barrier_complete(unsigned* bar, unsigned x, unsigned& nloc, unsigned& nx) {
    const unsigned G = gridDim.x;
    unsigned sum, cnt, mine, sp = 0u;
    for (;;) {
        sum = 0u; cnt = 0u; mine = 0u;
#pragma unroll
        for (unsigned j = 0; j < 16; ++j) { const unsigned c = xb_ld(&bar[XB_XCNT(j)]); sum += c; cnt += (c > 0u) ? 1u : 0u; mine = (j == x) ? c : mine; }
        if (sum == G) break;
        __builtin_amdgcn_s_sleep(1);
        if ((++sp & 255u) == 0u) { if (xb_ld(&bar[XB_TMO])) break; if (sp > XB_SPIN_CAP) { atomicAdd(&bar[XB_TMO], 1u); break; } }
    }
    nloc = mine > 0u ? mine : 1u; nx = cnt > 0u ? cnt : 1u;
}
__device__ __forceinline__ void grid_barrier(unsigned char* ws, LAS unsigned char* lds_in, int wave_in) {
    const Ctx C = get_ids(wave_in);
    unsigned* bar = (unsigned*)(ws + WS_CTL);
    volatile LAS unsigned* st = (volatile LAS unsigned*)(lds_in + LDS_ST_OFF);
    asm volatile("s_waitcnt vmcnt(0)" ::: "memory");
    __syncthreads();
    if (C.tid == 0) {
        __builtin_amdgcn_s_waitcnt(0);
        const unsigned x = xb_xcc_id();
        unsigned nloc = st[0], nx = st[1];
        if (nloc == 0u) { xcd_barrier_complete(bar, x, nloc, nx); st[0] = nloc; st[1] = nx; }
        const unsigned old = xb_add(&bar[XB_XSUB(x)], 1u);
        const unsigned gen = old / nloc;
        if (old + 1u == (gen + 1u) * nloc) {
            __builtin_amdgcn_fence(__ATOMIC_RELEASE, "agent");
            asm volatile("s_waitcnt vmcnt(0)" ::: "memory");
            const unsigned og = xb_add(&bar[XB_TOP], 1u);
            const unsigned tg = og / nx;
            if (og + 1u == (tg + 1u) * nx) xb_add(&bar[XB_TOPGEN], 1u);
            else XB_SPIN(xb_ld(&bar[XB_TOPGEN]) == tg, bar);
            __builtin_amdgcn_fence(__ATOMIC_ACQUIRE, "agent");
            xb_add(&bar[XB_XGEN(x)], 1u);
            asm volatile("s_waitcnt vmcnt(0)" ::: "memory");
        } else {
            XB_SPIN(xb_ld(&bar[XB_XGEN(x)]) == gen, bar);
            __builtin_amdgcn_fence(__ATOMIC_ACQUIRE, "agent");
            asm volatile("s_waitcnt vmcnt(0)" ::: "memory");
        }
    }
    __syncthreads();
}

#define IN_(i) (kp->in[i])
#define WSP(T, off) ((T*)(ws + (off)))

__device__ __forceinline__ void transpose_item(const float* W, int ldw, int col0, int k0, bf16_t* WT, int ldk, const float* ks, const float* ns, int ncol_valid, LAS float* scr, int lane) {
    const int c4 = (lane & 15) * 4, rsub = lane >> 4;
    const bool cv = c4 < ncol_valid;
    f32x4 nsv = (f32x4){1.f, 1.f, 1.f, 1.f}; if (ns && cv) nsv = *(const f32x4*)(ns + c4);
    f32x4 v[16];
#pragma unroll
    for (int i = 0; i < 16; ++i) v[i] = cv ? *(const f32x4*)(W + (size_t)(k0 + i * 4 + rsub) * ldw + col0 + c4) : (f32x4){0.f, 0.f, 0.f, 0.f};
#pragma unroll
    for (int i = 0; i < 16; ++i) { const int kk = i * 4 + rsub; f32x4 x = v[i] * nsv; if (ks) x = x * ks[k0 + kk];
        LAS float* d = scr + kk * 65 + c4; d[0] = x.x; d[1] = x.y; d[2] = x.z; d[3] = x.w; }
    LDS_WAIT(); asm volatile("" ::: "memory");
    const int c = lane & 7;
#pragma unroll
    for (int j = 0; j < 8; ++j) { const int n = (lane >> 3) + 8 * j; const LAS float* s = scr + (8 * c) * 65 + n;
        u32x4 o; o.x = pk2(s[0 * 65], s[1 * 65]); o.y = pk2(s[2 * 65], s[3 * 65]); o.z = pk2(s[4 * 65], s[5 * 65]); o.w = pk2(s[6 * 65], s[7 * 65]);
        *(u32x4*)(WT + (size_t)n * ldk + k0 + 8 * c) = o; }
    LDS_WAIT(); asm volatile("" ::: "memory");
}

__device__ __forceinline__ void prologue(const Ctx& C_, LAS unsigned char* lds) {
    const Ctx C = get_ids(C_.wave);
    KP kp = kparams(); unsigned char* ws = kp->ws; (void)ws;
    const float* const L_x_prompt = kp->in[0];
    const float* const L_x_sample = kp->in[1];
    const float* const L_meta = kp->in[6];
    const float* const L_norm1_w = kp->in[7];
    const float* const L_w_in = kp->in[8];
    const float* const L_pool_w = kp->in[9];
    const float* const L_pool_scale = kp->in[10];
    const float* const L_w_pool_out = kp->in[11];
    const float* const L_ssd_norm_w = kp->in[17];
    const float* const L_w_ssd_out = kp->in[18];
    const float* const L_w_o = kp->in[19];
    const float* const L_norm2_w = kp->in[20];
    const float* const L_w_up = kp->in[21];
    const float* const L_w_down = kp->in[24];
    bf16_t* const L_W1T = (bf16_t*)(ws + WS_W1T);
    bf16_t* const L_PWT = (bf16_t*)(ws + WS_PWT);
    bf16_t* const L_WPOT = (bf16_t*)(ws + WS_WPOT);
    bf16_t* const L_WSOT = (bf16_t*)(ws + WS_WSOT);
    bf16_t* const L_WOT = (bf16_t*)(ws + WS_WOT);
    bf16_t* const L_WUPT = (bf16_t*)(ws + WS_WUPT);
    bf16_t* const L_WDT = (bf16_t*)(ws + WS_WDT);
    bf16_t* const L_XB = (bf16_t*)(ws + WS_XB);
    float* const L_X = (float*)(ws + WS_X);
    float* const L_RSS = (float*)(ws + WS_RSS);
    LAS float* scr = (LAS float*)(lds + C.wave * 16640);
    const int gw = C.bid * NWAVES + C.wave, NGW = C.G * NWAVES, lane = C.lane;
    constexpr int NB1 = NPROJ / 64;
    constexpr int I_W1 = 16 * NB1, I_PW = 4 * 4 * 4, I_PO = 16 * 16, I_SO = 32 * 16, I_O = 16 * 16, I_UP = 16 * (DUP / 64), I_D = (DFF / 64) * 16;
    constexpr int I_LAYER = I_W1 + I_PW + I_PO + I_SO + I_O + I_UP + I_D;
    for (int it = gw; it < DEPTH * I_LAYER; it += NGW) {
        const int l = it / I_LAYER; int r = it - l * I_LAYER;
        if (r < I_W1) {
            const int nb = r % NB1, kb = r / NB1, n0 = nb * 64, k0 = kb * 64;
            bf16_t* dst = L_W1T + ((size_t)l * NPROJ + n0) * 1024;
            if (n0 >= PC_DT + 64) {
                const int c = lane & 7;
#pragma unroll
                for (int j = 0; j < 8; ++j) { const int n = (lane >> 3) + 8 * j; *(u32x4*)(dst + (size_t)n * 1024 + k0 + 8 * c) = (u32x4){0u, 0u, 0u, 0u}; }
            } else {
                int sc, nv = 64;
                if (n0 < PC_GA) sc = n0; else if (n0 < PC_GB) sc = 6176 + (n0 - PC_GA); else if (n0 < PC_DT) sc = 7200 + (n0 - PC_GB); else { sc = 6144; nv = 32; }
                transpose_item(L_w_in + (size_t)l * 1024 * 8224, 8224, sc, k0, dst, 1024, L_norm1_w + l * 1024, nullptr, nv, scr, lane);
            }
            continue;
        }
        r -= I_W1;
        if (r < I_PW) {
            const int g = r / 16, rr = r % 16, kb = rr / 4, nb = rr % 4;
            transpose_item(L_pool_w + ((size_t)(l * 4 + g) * 256) * 256, 256, nb * 64, kb * 64, L_PWT + ((size_t)l * 1024 + g * 256 + nb * 64) * 256, 256, nullptr, L_pool_scale + l * 1024 + g * 256 + nb * 64, 64, scr, lane);
            continue;
        }
        r -= I_PW;
        if (r < I_PO) { const int kb = r / 16, nb = r % 16;
            transpose_item(L_w_pool_out + (size_t)l * 1024 * 1024, 1024, nb * 64, kb * 64, L_WPOT + ((size_t)l * 1024 + nb * 64) * 1024, 1024, nullptr, nullptr, 64, scr, lane); continue; }
        r -= I_PO;
        if (r < I_SO) { const int kb = r / 16, nb = r % 16;
            transpose_item(L_w_ssd_out + (size_t)l * 2048 * 1024, 1024, nb * 64, kb * 64, L_WSOT + ((size_t)l * 1024 + nb * 64) * 2048, 2048, L_ssd_norm_w + l * 2048, nullptr, 64, scr, lane); continue; }
        r -= I_SO;
        if (r < I_O) { const int kb = r / 16, nb = r % 16;
            transpose_item(L_w_o + (size_t)l * 1024 * 1024, 1024, nb * 64, kb * 64, L_WOT + ((size_t)l * 1024 + nb * 64) * 1024, 1024, nullptr, nullptr, 64, scr, lane); continue; }
        r -= I_O;
        if (r < I_UP) { const int kb = r / (DUP / 64), nb = r % (DUP / 64);
            transpose_item(L_w_up + (size_t)l * 1024 * DUP, DUP, nb * 64, kb * 64, L_WUPT + ((size_t)l * DUP + nb * 64) * 1024, 1024, L_norm2_w + l * 1024, nullptr, 64, scr, lane); continue; }
        r -= I_UP;
        { const int kb = r / 16, nb = r % 16;
            transpose_item(L_w_down + (size_t)l * DFF * 1024, 1024, nb * 64, kb * 64, L_WDT + ((size_t)l * 1024 + nb * 64) * DFF, DFF, nullptr, nullptr, 64, scr, lane); }
    }
    for (int m = gw; m < MP; m += NGW) {
        const float* src = nullptr;
        if (m < MPROMPT) { const int b = m / LP, t = m - b * LP; src = (t < NMETA) ? L_meta + (size_t)t * DM : L_x_prompt + ((size_t)b * SEQ + (t - NMETA)) * DM; }
        else if (m < MREAL) src = L_x_sample + (size_t)(m - MPROMPT) * DM;
        float ss = 0.f;
#pragma unroll
        for (int j = 0; j < 4; ++j) {
            f32x4 v = src ? ((const f32x4*)src)[lane + 64 * j] : (f32x4){0.f, 0.f, 0.f, 0.f};
            ss += (v.x * v.x + v.y * v.y) + (v.z * v.z + v.w * v.w);
            ((f32x4*)(L_X + (size_t)m * DM))[lane + 64 * j] = v;
            u32x2 w; w.x = pk2(v.x, v.y); w.y = pk2(v.z, v.w);
            ((u32x2*)(L_XB + (size_t)m * DM))[lane + 64 * j] = w;
        }
        ss = wave_sum(ss);
        if (lane < 16) L_RSS[(size_t)m * 16 + lane] = (lane == 0) ? ss : 0.f;
    }
}

__device__ __forceinline__ void conv_pass(const Ctx& C_, int l) {
    const Ctx C = get_ids(C_.wave);
    KP kp = kparams(); unsigned char* ws = kp->ws;
    const float* const L_state_conv = kp->in[3];
    const float* const L_conv_w = kp->in[12];
    const float* const L_conv_b = kp->in[13];
    const float* const L_dt_bias = kp->in[14];
    const bf16_t* const L_PROJ = (const bf16_t*)(ws + WS_PROJ);
    bf16_t* const L_XBCC = (bf16_t*)(ws + WS_XBCC);
    const float* const L_DT = (const float*)(ws + WS_DT);
    float* const L_DTS = (float*)(ws + WS_DTS);
    const int gtid = C.bid * NTHREADS + C.tid, NT = C.G * NTHREADS;
    constexpr int NV = CONVD / 8, NSTRIP = MREAL / 8;
    const int NGRP = NT / NV;
    const int v = gtid % NV, sg = gtid / NV, ch = v * 8;
    if (sg < NGRP) {
        f32x4 cw[4][2], cbias[2];
#pragma unroll
        for (int k = 0; k < 4; ++k) { cw[k][0] = *(const f32x4*)(L_conv_w + ((size_t)l * 4 + k) * CONVD + ch); cw[k][1] = *(const f32x4*)(L_conv_w + ((size_t)l * 4 + k) * CONVD + ch + 4); }
        cbias[0] = *(const f32x4*)(L_conv_b + (size_t)l * CONVD + ch); cbias[1] = *(const f32x4*)(L_conv_b + (size_t)l * CONVD + ch + 4);
        u32x4 raw[11], nraw[11];
#define CONV_LOAD(dst_, strip_) do { const int m0_ = (strip_) * 8; const bool smp_ = m0_ >= MPROMPT; const int t0_ = smp_ ? 0 : (m0_ % LP); \
            const bf16_t* rb_ = L_PROJ + ((size_t)m0_ - 3) * NPROJ + PC_XBC + ch; \
            _Pragma("unroll") for (int i = 0; i < 11; ++i) dst_[i] = *(const u32x4*)(rb_ + (size_t)((t0_ + i - 3 >= 0) ? i : 3) * NPROJ); } while (0)
        int strip = sg;
        if (strip < NSTRIP) CONV_LOAD(raw, strip);
        for (; strip < NSTRIP; strip += NGRP) {
            const int m0 = strip * 8;
            const bool sample = m0 >= MPROMPT;
            const int t0 = sample ? 0 : (m0 % LP), b = sample ? (m0 - MPROMPT) / DS : 0;
            const bool more = strip + NGRP < NSTRIP;
            if (more) CONV_LOAD(nraw, strip + NGRP);
            if (t0 < 3) {
#pragma unroll
                for (int i = 0; i < 3; ++i) if (t0 + i - 3 < 0) {
                    u32x4 rv = (u32x4){0u, 0u, 0u, 0u};
                    if (sample) { const float* pp = L_state_conv + ((size_t)(l * DB + b) * 3 + i) * CONVD + ch; rv = pack8v(*(const f32x4*)pp, *(const f32x4*)(pp + 4)); }
                    raw[i] = rv; }
            }
            float oacc[4][8];
#pragma unroll
            for (int i = 0; i < 11; ++i) {
                float xv[8]; unpack8(raw[i], xv);
                if (i < 8) {
#pragma unroll
                    for (int e = 0; e < 8; ++e) oacc[i & 3][e] = 0.f;
                }
#pragma unroll
                for (int k = 0; k < 4; ++k) { const int j = i - k;
                    if (j >= 0 && j < 8) { float* o = oacc[j & 3];
                        o[0] += cw[k][0].x * xv[0]; o[1] += cw[k][0].y * xv[1]; o[2] += cw[k][0].z * xv[2]; o[3] += cw[k][0].w * xv[3];
                        o[4] += cw[k][1].x * xv[4]; o[5] += cw[k][1].y * xv[5]; o[6] += cw[k][1].z * xv[6]; o[7] += cw[k][1].w * xv[7]; } }
                if (i >= 3) {
                    const int j = i - 3; const float* oa = oacc[j & 3];
                    float o[8];
                    o[0] = siluf_(oa[0] + cbias[0].x); o[1] = siluf_(oa[1] + cbias[0].y); o[2] = siluf_(oa[2] + cbias[0].z); o[3] = siluf_(oa[3] + cbias[0].w);
                    o[4] = siluf_(oa[4] + cbias[1].x); o[5] = siluf_(oa[5] + cbias[1].y); o[6] = siluf_(oa[6] + cbias[1].z); o[7] = siluf_(oa[7] + cbias[1].w);
                    *(u32x4*)(L_XBCC + (size_t)(m0 + j) * CONVD + ch) = pack8(o);
                }
            }
            if (more) {
#pragma unroll
                for (int i = 0; i < 11; ++i) raw[i] = nraw[i];
            }
        }
#undef CONV_LOAD
    }
    for (int idx = gtid; idx < MREAL * NH; idx += NT) {
        const float rw = L_DT[idx] + L_dt_bias[l * NH + (idx & 31)];
        L_DTS[(size_t)(idx & 31) * MP + (idx >> 5)] = rw > 20.f ? rw : __logf(1.0f + __expf(rw));
    }
}

constexpr int LD128 = 136, LD64 = 72;
constexpr int S_C = 0, S_CS = 17408, S_B = 34816, S_BWT = 52224, S_XDT = 70656, S_XS = 79872, S_M = 89088, S_H = 98304, S_Z = 115712  , S_DTV = 124928, S_CUM = 125440, S_SSQ = 125952;

#define SSD_PREFETCH(r0_, ntok_, h_, xoff_, zoff_, boff_, c0n) do { \
    const int nqn_ = ((ntok_) - (c0n)) < 64 ? ((ntok_) - (c0n)) : 64; \
    const bf16_t* xb_ = L_XBCC + (size_t)((r0_) + (c0n)) * CONVD; \
    { unsigned z_ = 0u; asm volatile("" : "+v"(z_)); rx = (u32x4){z_, z_, z_, z_}; } zraw = rx; rB[0] = rx; rB[1] = rx; rC[0] = rx; rC[1] = rx;     \
    if (zt < nqn_) zraw = *(const u32x4*)(L_PROJ + (size_t)((r0_) + (c0n)) * NPROJ + (zoff_)); \
    if (zt < nqn_) rx = *(const u32x4*)(xb_ + (xoff_)); \
    _Pragma("unroll") for (int i_ = 0; i_ < 2; ++i_) if (bt + 32 * i_ < nqn_) { rB[i_] = *(const u32x4*)(xb_ + (boff_) + (size_t)i_ * 32 * CONVD); rC[i_] = *(const u32x4*)(xb_ + (boff_) + 512 + (size_t)i_ * 32 * CONVD); } \
    dtraw = (lane < nqn_) ? L_DTS[(size_t)(h_) * MP + (unsigned)((r0_) + (c0n) + lane)] : 0.f; \
} while (0)
#define SSD_UNIT(u_, smp_, b_, h_, r0_, ntok_, xoff_, zoff_, boff_) do { \
    smp_ = (u_) >= NBATCH * NH; const int k_ = smp_ ? (u_) - NBATCH * NH : (u_); b_ = k_ / NH; h_ = k_ - b_ * NH; \
    r0_ = smp_ ? MPROMPT + b_ * DS : b_ * LP; ntok_ = smp_ ? DS : LP; \
    xoff_ = (unsigned)zt * CONVD + h_ * 64 + zv * 8; zoff_ = (unsigned)zt * NPROJ + PC_Z + h_ * 64 + zv * 8; boff_ = (unsigned)bt * CONVD + 2048 + (h_ >> 3) * 128 + bv * 8; \
} while (0)

__device__ __forceinline__ void ssd_phase(const Ctx& C_, LAS unsigned char* lds_in, int l) {
    const Ctx C = get_ids(C_.wave);
    LAS unsigned char* lds = lds_in; asm volatile("" : "+s"(lds));
    KP kp = kparams(); unsigned char* ws = kp->ws;
    const float* const L_state_ssm = kp->in[4];
    float* const L_out = kp->out;
    const bf16_t* const L_PROJ = (const bf16_t*)(ws + WS_PROJ);
    const bf16_t* const L_XBCC = (const bf16_t*)(ws + WS_XBCC);
    bf16_t* const L_YN = (bf16_t*)(ws + WS_YN);
    const float* const L_DTS = (const float*)(ws + WS_DTS);
    float* const L_SSQ = (float*)(ws + WS_SSQ);
    const float* const L_a_log = kp->in[15] + l * NH; const float* const L_d_skip = kp->in[16] + l * NH;
    const int tid = C.tid, lane = C.lane, wave = C.wave, r = lane & 15, q = lane >> 4;
    LAS bf16_t* sC = (LAS bf16_t*)(lds + S_C); LAS bf16_t* sCs = (LAS bf16_t*)(lds + S_CS); LAS bf16_t* sB = (LAS bf16_t*)(lds + S_B);
    LAS bf16_t* sBwT = (LAS bf16_t*)(lds + S_BWT); LAS bf16_t* sXdT = (LAS bf16_t*)(lds + S_XDT); LAS bf16_t* sXs = (LAS bf16_t*)(lds + S_XS);
    LAS bf16_t* sM = (LAS bf16_t*)(lds + S_M); LAS bf16_t* sH = (LAS bf16_t*)(lds + S_H); LAS bf16_t* sZ = (LAS bf16_t*)(lds + S_Z);
    LAS float* scum = (LAS float*)(lds + S_CUM); LAS float* sssq = (LAS float*)(lds + S_SSQ);
    const int zt = tid >> 3, zv = tid & 7, bt = tid >> 4, bv = tid & 15;
    const int pjs = wave & 3, ni0 = (wave >> 2) * 4;
    const int NU = NBATCH * NH;
    int u = C.bid; if (u >= NU) return;
    bool sample; int b, h, r0, ntok; unsigned xoff, zoff, boff;
    SSD_UNIT(u, sample, b, h, r0, ntok, xoff, zoff, boff);
    u32x4 rx, zraw, rB[2], rC[2]; float dtraw = 0.f;
    SSD_PREFETCH(r0, ntok, h, xoff, zoff, boff, 0);
    if (tid < 64) sssq[tid] = 0.f;
  for (;;) {
    const float a_h = -__expf(L_a_log[h]), dsk = L_d_skip[h];
    f32x4 H[4];
    if (sample) { const float* h0 = L_state_ssm + ((size_t)(l * DB + b) * NH + h) * (HD * NST);
#pragma unroll
        for (int j = 0; j < 4; ++j) H[j] = *(const f32x4*)(h0 + (16 * pjs + r) * NST + 16 * (ni0 + j) + 4 * q);
    } else {
        float z_ = 0.f; asm volatile("" : "+v"(z_));
#pragma unroll
        for (int j = 0; j < 4; ++j) H[j] = (f32x4){z_, z_, z_, z_};
    }
    const int un = u + C.G; const bool has_next = un < NU;
    LBAR();

    int par = 0;
    for (int c0 = 0; c0 < ntok; c0 += 64, par ^= 1) {
        const int nq = (ntok - c0) < 64 ? (ntok - c0) : 64;
        const bool more = (c0 + 64) < ntok;
        const LAS float* cumc = scum;
        const float d = dtraw;
        float cs = d * a_h;
#pragma unroll
        for (int o_ = 1; o_ < 64; o_ <<= 1) { const float v_ = shup(cs, o_, lane); if (lane >= o_) cs += v_; }
        const float clast = shidx(cs, 63);
        if (wave == 7) scum[lane] = cs;
#define SWZ(row_, tok_) ((row_) * LD64 + (((((tok_) >> 3) ^ (((row_) >> 3) & 7)) << 3) | ((tok_) & 7)))
        {
            const float dz = shidx(d, zt), wcs0 = shidx(cs, bt), wcs1 = shidx(cs, bt + 32);
            float xv[8]; unpack8(rx, xv);
            *(LAS u32x4*)(sXs + zt * LD64 + zv * 8) = rx;
            *(LAS u32x4*)(sZ + zt * LD64 + zv * 8) = zraw;
#pragma unroll
            for (int e = 0; e < 8; ++e) sXdT[SWZ(zv * 8 + e, zt)] = (bf16_t)f2bf(xv[e] * dz);
#pragma unroll
            for (int i = 0; i < 2; ++i) {
                const int st = bt + 32 * i; const float csx = i == 0 ? wcs0 : wcs1;
                const float wb = __expf(clast - csx), wc = __expf(csx);
                float bvv[8]; unpack8(rB[i], bvv);
                *(LAS u32x4*)(sB + st * LD128 + bv * 8) = rB[i];
#pragma unroll
                for (int e = 0; e < 8; ++e) sBwT[SWZ(bv * 8 + e, st)] = (bf16_t)f2bf(bvv[e] * wb);
                float cvv[8]; unpack8(rC[i], cvv);
                *(LAS u32x4*)(sC + st * LD128 + bv * 8) = rC[i];
#pragma unroll
                for (int e = 0; e < 8; ++e) cvv[e] *= wc;
                *(LAS u32x4*)(sCs + st * LD128 + bv * 8) = pack8(cvv);
            }
        }
        __builtin_amdgcn_sched_barrier(0);
        if (more) { SSD_PREFETCH(r0, ntok, h, xoff, zoff, boff, c0 + 64); }
        else if (has_next) {
            bool sample_n; int b_n, h_n, r0_n, ntok_n; unsigned xoff_n, zoff_n, boff_n;
            SSD_UNIT(un, sample_n, b_n, h_n, r0_n, ntok_n, xoff_n, zoff_n, boff_n);
            SSD_PREFETCH(r0_n, ntok_n, h_n, xoff_n, zoff_n, boff_n, 0);
        }
        LBAR();
        {
            const int ti = wave >> 1, sj0 = (wave & 1) * 2;
            if (16 * ti < nq) {
                bf16x8 fa[4], fb[2][4];
#pragma unroll
                for (int kk = 0; kk < 4; ++kk) {
                    fa[kk] = *(const LAS bf16x8*)(sC + (16 * ti + r) * LD128 + kk * 32 + q * 8);
                    fb[0][kk] = *(const LAS bf16x8*)(sB + (16 * sj0 + r) * LD128 + kk * 32 + q * 8);
                    fb[1][kk] = *(const LAS bf16x8*)(sB + (16 * (sj0 + 1) + r) * LD128 + kk * 32 + q * 8);
                }
                const int t = 16 * ti + r; const float ctv = cumc[t];
                const f32x4 cs0 = *(const LAS f32x4*)(cumc + 16 * sj0 + 4 * q), cs1 = *(const LAS f32x4*)(cumc + 16 * (sj0 + 1) + 4 * q);
                __builtin_amdgcn_sched_barrier(0);
                f32x4 S0 = (f32x4){0.f, 0.f, 0.f, 0.f}, S1 = S0;
#pragma unroll
                for (int kk = 0; kk < 4; ++kk) { S0 = __builtin_amdgcn_mfma_f32_16x16x32_bf16(fb[0][kk], fa[kk], S0, 0, 0, 0); S1 = __builtin_amdgcn_mfma_f32_16x16x32_bf16(fb[1][kk], fa[kk], S1, 0, 0, 0); }
                {
                    float m0[4], m1[4];
#pragma unroll
                    for (int jj = 0; jj < 4; ++jj) {
                        const int s0 = 16 * sj0 + 4 * q + jj, s1 = s0 + 16;
                        m0[jj] = (s0 <= t) ? S0[jj] * __expf(fminf(ctv - cs0[jj], 0.f)) : 0.f;
                        m1[jj] = (s1 <= t) ? S1[jj] * __expf(fminf(ctv - cs1[jj], 0.f)) : 0.f;
                    }
                    u32x2 w0, w1; w0.x = pk2(m0[0], m0[1]); w0.y = pk2(m0[2], m0[3]); w1.x = pk2(m1[0], m1[1]); w1.y = pk2(m1[2], m1[3]);
                    *(LAS u32x2*)(sM + t * LD64 + 16 * sj0 + 4 * q) = w0; *(LAS u32x2*)(sM + t * LD64 + 16 * (sj0 + 1) + 4 * q) = w1;
                }
            }
        }
        if (c0 == 0) {
#pragma unroll
            for (int j = 0; j < 4; ++j) { u32x2 w; w.x = pk2(H[j][0], H[j][1]); w.y = pk2(H[j][2], H[j][3]); *(LAS u32x2*)(sH + (16 * pjs + r) * LD128 + 16 * (ni0 + j) + 4 * q) = w; }
        }
        LBAR();
        {
            const int ti = wave >> 1, pj0 = (wave & 1) * 2;
            const bool yv = 16 * ti < nq;
            bf16x8 sA[4][2], sBf[2];
            f32x4 Y[2];
            Y[0] = (f32x4){0.f, 0.f, 0.f, 0.f}; Y[1] = Y[0];
            if (yv) {
                {
                    bf16x8 aM[2], bX[2][2];
#pragma unroll
                    for (int kk = 0; kk < 2; ++kk) { aM[kk] = *(const LAS bf16x8*)(sM + (16 * ti + r) * LD64 + kk * 32 + q * 8);
                        bX[0][kk] = *(const LAS bf16x8*)(sXdT + SWZ(16 * pj0 + r, kk * 32 + q * 8)); bX[1][kk] = *(const LAS bf16x8*)(sXdT + SWZ(16 * (pj0 + 1) + r, kk * 32 + q * 8)); }
                    __builtin_amdgcn_sched_barrier(0);
#pragma unroll
                    for (int kk = 0; kk < 2; ++kk) { Y[0] = __builtin_amdgcn_mfma_f32_16x16x32_bf16(bX[0][kk], aM[kk], Y[0], 0, 0, 0); Y[1] = __builtin_amdgcn_mfma_f32_16x16x32_bf16(bX[1][kk], aM[kk], Y[1], 0, 0, 0); }
                }
                __builtin_amdgcn_sched_barrier(0);
                {
                    bf16x8 aC[4], bH[2][4];
#pragma unroll
                    for (int kk = 0; kk < 4; ++kk) { aC[kk] = *(const LAS bf16x8*)(sCs + (16 * ti + r) * LD128 + kk * 32 + q * 8);
                        bH[0][kk] = *(const LAS bf16x8*)(sH + (16 * pj0 + r) * LD128 + kk * 32 + q * 8); bH[1][kk] = *(const LAS bf16x8*)(sH + (16 * (pj0 + 1) + r) * LD128 + kk * 32 + q * 8); }
                    __builtin_amdgcn_sched_barrier(0);
#pragma unroll
                    for (int kk = 0; kk < 4; ++kk) { Y[0] = __builtin_amdgcn_mfma_f32_16x16x32_bf16(bH[0][kk], aC[kk], Y[0], 0, 0, 0); Y[1] = __builtin_amdgcn_mfma_f32_16x16x32_bf16(bH[1][kk], aC[kk], Y[1], 0, 0, 0); }
                }
            }
            __builtin_amdgcn_sched_barrier(0);
#pragma unroll
            for (int kk = 0; kk < 2; ++kk) { sBf[kk] = *(const LAS bf16x8*)(sXdT + SWZ(16 * pjs + r, kk * 32 + q * 8));
#pragma unroll
                for (int j = 0; j < 4; ++j) sA[j][kk] = *(const LAS bf16x8*)(sBwT + SWZ(16 * (ni0 + j) + r, kk * 32 + q * 8)); }
            __builtin_amdgcn_sched_barrier(0);
            {
                const float dec = __expf(clast);
#pragma unroll
                for (int j = 0; j < 4; ++j) H[j] = H[j] * dec;
#pragma unroll
                for (int kk = 0; kk < 2; ++kk)
#pragma unroll
                    for (int j = 0; j < 4; ++j) H[j] = __builtin_amdgcn_mfma_f32_16x16x32_bf16(sA[j][kk], sBf[kk], H[j], 0, 0, 0);
            }
            if (yv) {
                const int t = 16 * ti + r;
                float ss = 0.f;
#pragma unroll
                for (int j = 0; j < 2; ++j) {
                    const int p0 = 16 * (pj0 + j) + 4 * q;
                    const u32x2 xw = *(const LAS u32x2*)(sXs + t * LD64 + p0), zw = *(const LAS u32x2*)(sZ + t * LD64 + p0);
                    const float y0 = (Y[j][0] + dsk * bflo(xw.x)) * siluf_(bflo(zw.x)), y1 = (Y[j][1] + dsk * bfhi(xw.x)) * siluf_(bfhi(zw.x));
                    const float y2 = (Y[j][2] + dsk * bflo(xw.y)) * siluf_(bflo(zw.y)), y3 = (Y[j][3] + dsk * bfhi(xw.y)) * siluf_(bfhi(zw.y));
                    ss += (y0 * y0 + y1 * y1) + (y2 * y2 + y3 * y3);
                    u32x2 w; w.x = pk2(y0, y1); w.y = pk2(y2, y3);
                    *(LAS u32x2*)(sZ + t * LD64 + p0) = w;
                }
                ss += shx(ss, 16, lane); ss += shx(ss, 32, lane);
                if (q == 0 && t < nq) (void)__hip_atomic_fetch_add(sssq + t, ss, __ATOMIC_RELAXED, __HIP_MEMORY_SCOPE_WORKGROUP);
            }
        }
        LBAR();
#pragma unroll
        for (int j = 0; j < 4; ++j) { u32x2 w; w.x = pk2(H[j][0], H[j][1]); w.y = pk2(H[j][2], H[j][3]); *(LAS u32x2*)(sH + (16 * pjs + r) * LD128 + 16 * (ni0 + j) + 4 * q) = w; }
        if (zt < nq) *(u32x4*)(L_YN + (size_t)(r0 + c0 + zt) * DINNER + h * 64 + zv * 8) = *(const LAS u32x4*)(sZ + zt * LD64 + zv * 8);
        if (tid < 64) { if (tid < nq) L_SSQ[(size_t)(r0 + c0 + tid) * 32 + h] = sssq[tid]; sssq[tid] = 0.f; }
        __builtin_amdgcn_sched_barrier(0);
    }
    float* so = L_out + (sample ? O_SSSM + ((size_t)(l * DB + b) * NH + h) * (HD * NST) : O_PSSM + ((size_t)(l * NBATCH + b) * NH + h) * (HD * NST));
#pragma unroll
    for (int j = 0; j < 4; ++j) *(f32x4*)(so + (16 * pjs + r) * NST + 16 * (ni0 + j) + 4 * q) = H[j];
    if (!has_next) break;
    u = un; SSD_UNIT(u, sample, b, h, r0, ntok, xoff, zoff, boff);
  }
    LBAR();
}

constexpr int SMP_WAVE_LDS = 14592;
__device__ __forceinline__ void ssd_sample(const Ctx& C_, LAS unsigned char* lds_in, int l) {
    const Ctx C = get_ids(C_.wave);
    LAS unsigned char* lds = lds_in; asm volatile("" : "+s"(lds));
    KP kp = kparams(); unsigned char* ws = kp->ws;
    const float* const L_state_ssm = kp->in[4];
    float* const L_out = kp->out;
    const bf16_t* const L_PROJ = (const bf16_t*)(ws + WS_PROJ);
    const bf16_t* const L_XBCC = (const bf16_t*)(ws + WS_XBCC);
    bf16_t* const L_YN = (bf16_t*)(ws + WS_YN);
    const float* const L_DTS = (const float*)(ws + WS_DTS);
    float* const L_SSQ = (float*)(ws + WS_SSQ);
    const float* const L_a_log = kp->in[15] + l * NH; const float* const L_d_skip = kp->in[16] + l * NH;
    const int lane = C.lane, wave = C.wave, r = lane & 15, q = lane >> 4;
    LAS float* sBf = (LAS float*)(lds + wave * SMP_WAVE_LDS); LAS float* sCf = sBf + 1024; LAS float* sXf = sBf + 2048; LAS float* sZf = sBf + 2560; LAS float* sY2 = sBf + 3072;
    LAS float* sdt = sBf + 3584; LAS float* sdA = sBf + 3592;
    for (int k = C.bid * NWAVES + wave; k < DB * NH; k += C.G * NWAVES) {
        const int b = k / NH, h = k - b * NH, g = h >> 3, r0 = MPROMPT + b * DS;
        const float a_h = -__expf(L_a_log[h]), dsk = L_d_skip[h];
        int ln = lane; asm volatile("" : "+v"(ln));
#pragma unroll 1
        for (int i = 0; i < 5; ++i) {
            const int idx = ln + 64 * i, t = idx / 40, v = idx - t * 40;
            int ch; LAS float* dst;
            if (v < 8) { ch = h * 64 + v * 8; dst = sXf + t * 64 + v * 8; } else if (v < 24) { ch = 2048 + g * 128 + (v - 8) * 8; dst = sBf + t * 128 + (v - 8) * 8; } else { ch = 2560 + g * 128 + (v - 24) * 8; dst = sCf + t * 128 + (v - 24) * 8; }
            const u32x4 w = *(const u32x4*)(L_XBCC + (size_t)(r0 + t) * CONVD + ch); float o[8]; unpack8(w, o);
            *(LAS f32x4*)dst = (f32x4){o[0], o[1], o[2], o[3]}; *(LAS f32x4*)(dst + 4) = (f32x4){o[4], o[5], o[6], o[7]};
        }
        { const int t = ln >> 3, v = ln & 7;
            const u32x4 w = *(const u32x4*)(L_PROJ + (size_t)(r0 + t) * NPROJ + PC_Z + h * 64 + v * 8); float o[8]; unpack8(w, o);
            *(LAS f32x4*)(sZf + t * 64 + v * 8) = (f32x4){o[0], o[1], o[2], o[3]}; *(LAS f32x4*)(sZf + t * 64 + v * 8 + 4) = (f32x4){o[4], o[5], o[6], o[7]}; }
        if (ln < 8) { const float dtv = L_DTS[(size_t)h * MP + r0 + ln]; sdt[ln] = dtv; sdA[ln] = __expf(dtv * a_h); }
        const float* h0 = L_state_ssm + ((size_t)(l * DB + b) * NH + h) * (HD * NST);
        f32x4 hs[4][4][2];
        unsigned hoff = (unsigned)(r * NST + 8 * q); asm volatile("" : "+v"(hoff));
#pragma unroll
        for (int pj = 0; pj < 4; ++pj)
#pragma unroll
            for (int kk = 0; kk < 4; ++kk) { const float* p = h0 + hoff + (16 * pj * NST + 32 * kk); hs[pj][kk][0] = *(const f32x4*)p; hs[pj][kk][1] = *(const f32x4*)(p + 4); }
        LDS_WAIT(); asm volatile("" ::: "memory");
#pragma unroll 1
        for (int t = 0; t < DS; ++t) {
            const float dt = sdt[t], dA = sdA[t];
            float xd[4], y[4];
#pragma unroll
            for (int pj = 0; pj < 4; ++pj) { xd[pj] = sXf[t * 64 + 16 * pj + r] * dt; y[pj] = 0.f; }
#pragma unroll
            for (int kk = 0; kk < 4; ++kk) {
                const f32x4 B0 = *(const LAS f32x4*)(sBf + t * 128 + 32 * kk + 8 * q), B1 = *(const LAS f32x4*)(sBf + t * 128 + 32 * kk + 8 * q + 4);
                const f32x4 C0 = *(const LAS f32x4*)(sCf + t * 128 + 32 * kk + 8 * q), C1 = *(const LAS f32x4*)(sCf + t * 128 + 32 * kk + 8 * q + 4);
#pragma unroll
                for (int pj = 0; pj < 4; ++pj) {
                    f32x4 h0v = hs[pj][kk][0] * dA + B0 * xd[pj], h1v = hs[pj][kk][1] * dA + B1 * xd[pj];
                    hs[pj][kk][0] = h0v; hs[pj][kk][1] = h1v;
                    const f32x4 m0 = C0 * h0v, m1 = C1 * h1v;
                    y[pj] += ((m0.x + m0.y) + (m0.z + m0.w)) + ((m1.x + m1.y) + (m1.z + m1.w));
                }
            }
#pragma unroll
            for (int pj = 0; pj < 4; ++pj) { y[pj] += shx(y[pj], 16, lane); y[pj] += shx(y[pj], 32, lane); }
            const float yv = q == 0 ? y[0] : (q == 1 ? y[1] : (q == 2 ? y[2] : y[3]));
            const float yg = (yv + dsk * sXf[t * 64 + lane]) * siluf_(sZf[t * 64 + lane]);
            L_YN[(size_t)(r0 + t) * DINNER + h * 64 + lane] = (bf16_t)f2bf(yg);
            sY2[t * 64 + lane] = yg * yg;
        }
        LDS_WAIT(); asm volatile("" ::: "memory");
        {
            const LAS float* p = sY2 + (lane >> 3) * 64 + (lane & 7) * 8;
            const f32x4 a = *(const LAS f32x4*)p, c = *(const LAS f32x4*)(p + 4);
            float ss = ((a.x + a.y) + (a.z + a.w)) + ((c.x + c.y) + (c.z + c.w));
            ss += shx(ss, 1, lane); ss += shx(ss, 2, lane); ss += shx(ss, 4, lane);
            if ((lane & 7) == 0) L_SSQ[(size_t)(r0 + (lane >> 3)) * 32 + h] = ss;
        }
        float* so = L_out + O_SSSM + ((size_t)(l * DB + b) * NH + h) * (HD * NST);
#pragma unroll
        for (int pj = 0; pj < 4; ++pj)
#pragma unroll
            for (int kk = 0; kk < 4; ++kk) { float* p = so + hoff + (16 * pj * NST + 32 * kk); *(f32x4*)p = hs[pj][kk][0]; *(f32x4*)(p + 4) = hs[pj][kk][1]; }
        LDS_WAIT(); asm volatile("" ::: "memory");
    }
}

__device__ __forceinline__ void row_bf16_to_f32(const bf16_t* src, float* dst, int ncol, int lane) {
    for (int v = lane; v < ncol / 8; v += 64) { const u32x4 w = *(const u32x4*)(src + v * 8); float o[8]; unpack8(w, o);
        *(f32x4*)(dst + v * 8) = (f32x4){o[0], o[1], o[2], o[3]}; *(f32x4*)(dst + v * 8 + 4) = (f32x4){o[4], o[5], o[6], o[7]}; }
}
__device__ __forceinline__ void row_f32_copy(const float* src, float* dst, int ncol, int lane) {
    for (int v = lane; v < ncol / 4; v += 64) *(f32x4*)(dst + v * 4) = *(const f32x4*)(src + v * 4);
}

template <int MAXW>
__device__ __forceinline__ void pool_load(const bf16_t* PROJ, const float* state_pool, int l, int m, bool sample, int b, int t, int ch, int win, u32x4 (&rw)[MAXW]) {
#pragma unroll
    for (int j = 0; j < MAXW; ++j) { const bool need = (j < win) && (t - j >= 0);
        const u32x4 rv = *(const u32x4*)(PROJ + (size_t)(m - (need ? j : 0)) * NPROJ + PC_U + ch);
        rw[j] = need ? rv : (u32x4){0u, 0u, 0u, 0u}; }
    if (sample && t < win - 1) {
#pragma unroll
        for (int j = 1; j < MAXW; ++j) if (j < win && t - j < 0) {
            const float* pp = state_pool + ((size_t)(l * DB + b) * 15 + (15 + t - j)) * 1024 + ch; rw[j] = pack8v(*(const f32x4*)pp, *(const f32x4*)(pp + 4)); }
    }
}
template <int MAXW>
__device__ __forceinline__ void pool_finish(bf16_t* DBUF, int m, bool sample, int t, int ch, int win, const u32x4 (&rw)[MAXW]) {
    float acc[8], u0[8];
    unpack8(rw[0], u0);
#pragma unroll
    for (int e = 0; e < 8; ++e) acc[e] = u0[e];
#pragma unroll
    for (int j = 1; j < MAXW; ++j) { float xv[8]; unpack8(rw[j], xv);
#pragma unroll
        for (int e = 0; e < 8; ++e) acc[e] += xv[e]; }
    const int cnt = sample ? win : ((t + 1) < win ? (t + 1) : win);
    const float inv = 1.0f / (float)cnt;
    float d[8];
#pragma unroll
    for (int e = 0; e < 8; ++e) d[e] = acc[e] * inv - u0[e];
    *(u32x4*)(DBUF + (size_t)m * 1024 + ch) = pack8(d);
}

__device__ __forceinline__ void mixer_elementwise(const Ctx& C_, int l) {
    const Ctx C = get_ids(C_.wave);
    KP kp = kparams(); unsigned char* ws = kp->ws;
    const float* const L_state_pool = kp->in[2];
    float* const L_out = kp->out;
    const bf16_t* const L_PROJ = (const bf16_t*)(ws + WS_PROJ);
    bf16_t* const L_DBUF = (bf16_t*)(ws + WS_DBUF);
    const int gw = C.bid * NWAVES + C.wave, NGW = C.G * NWAVES, lane = C.lane;
    for (int m = gw; m < MREAL; m += NGW) {
        const bool sample = m >= MPROMPT;
        int b, t; if (sample) { b = (m - MPROMPT) / DS; t = (m - MPROMPT) - b * DS; } else { b = m / LP; t = m - b * LP; }
        const int chA = lane * 8, chB = (lane + 64) * 8, winA = 2 << (chA >> 8), winB = 2 << (chB >> 8);
        u32x4 rwA[4], rwB[16];
        pool_load<4>(L_PROJ, L_state_pool, l, m, sample, b, t, chA, winA, rwA);
        pool_load<16>(L_PROJ, L_state_pool, l, m, sample, b, t, chB, winB, rwB);
        pool_finish<4>(L_DBUF, m, sample, t, chA, winA, rwA);
        pool_finish<16>(L_DBUF, m, sample, t, chB, winB, rwB);
    }
    for (int it = gw; it < (NBATCH + DB) * 15; it += NGW) {
        if (it < NBATCH * 15) { const int b = it / 15, i = it - b * 15;
            row_bf16_to_f32(L_PROJ + (size_t)(b * LP + LP - 15 + i) * NPROJ + PC_U, L_out + O_PPOOL + ((size_t)(l * NBATCH + b) * 15 + i) * 1024, 1024, lane);
        } else { const int k = it - NBATCH * 15, b = k / 15, i = k - b * 15;
            float* dst = L_out + O_SPOOL + ((size_t)(l * DB + b) * 15 + i) * 1024;
            if (i < 7) row_f32_copy(L_state_pool + ((size_t)(l * DB + b) * 15 + 8 + i) * 1024, dst, 1024, lane);
            else row_bf16_to_f32(L_PROJ + (size_t)(MPROMPT + b * DS + (i - 7)) * NPROJ + PC_U, dst, 1024, lane); }
    }
    for (int it = gw; it < (NBATCH + DB) * 3; it += NGW) {
        if (it < NBATCH * 3) { const int b = it / 3, i = it - b * 3;
            row_bf16_to_f32(L_PROJ + (size_t)(b * LP + LP - 3 + i) * NPROJ + PC_XBC, L_out + O_PCONV + ((size_t)(l * NBATCH + b) * 3 + i) * CONVD, CONVD, lane);
        } else { const int k = it - NBATCH * 3, b = k / 3, i = k - b * 3;
            row_bf16_to_f32(L_PROJ + (size_t)(MPROMPT + b * DS + 5 + i) * NPROJ + PC_XBC, L_out + O_SCONV + ((size_t)(l * DB + b) * 3 + i) * CONVD, CONVD, lane); }
    }
}

__device__ __forceinline__ void yn_normalize(const Ctx& C_) {
    const Ctx C = get_ids(C_.wave);
    KP kp = kparams(); unsigned char* ws = kp->ws; (void)ws;
    bf16_t* const L_YN = (bf16_t*)(ws + WS_YN);
    float* const L_SSQ = (float*)(ws + WS_SSQ);
    const int gw = C.bid * NWAVES + C.wave, NGW = C.G * NWAVES, lane = C.lane;
    for (int m = gw; m < MREAL; m += NGW) {
        const f32x4* sp = (const f32x4*)(L_SSQ + (size_t)m * 32);
        float rs[4];
#pragma unroll
        for (int gi = 0; gi < 4; ++gi) { const f32x4 a = sp[2 * gi], b = sp[2 * gi + 1]; rs[gi] = rsqrtf((((a.x + a.y) + (a.z + a.w)) + ((b.x + b.y) + (b.z + b.w))) * (1.0f / 512.0f) + EPS); }
#pragma unroll
        for (int i = 0; i < 4; ++i) {
            const int v = lane + 64 * i;
            u32x4* p = (u32x4*)(L_YN + (size_t)m * DINNER + v * 8);
            float o[8]; unpack8(*p, o);
            const float s = rs[i];
#pragma unroll
            for (int e = 0; e < 8; ++e) o[e] *= s;
            *p = pack8(o);
        }
    }
}

__device__ __forceinline__ void ffn_half(const bf16_t* UP, const float* state_ffn, const f32x4 (&w)[3][2], const f32x4 (&bs)[2], int l, int m0, int t0, bool sample, int b, int col, float (&res)[8][8]) {
    u32x4 raw[10];
#pragma unroll
    for (int i = 0; i < 10; ++i) raw[i] = *(const u32x4*)(UP + (size_t)(m0 + ((t0 + i - 2 >= 0) ? i - 2 : 0)) * DUP + col);
    if (t0 < 2) {
#pragma unroll
        for (int i = 0; i < 2; ++i) if (t0 + i - 2 < 0) {
            u32x4 rv = (u32x4){0u, 0u, 0u, 0u};
            if (sample) { const float* pp = state_ffn + ((size_t)(l * DB + b) * 2 + i) * DUP + col; rv = pack8v(*(const f32x4*)pp, *(const f32x4*)(pp + 4)); }
            raw[i] = rv; }
    }
#pragma unroll
    for (int j = 0; j < 8; ++j) { res[j][0] = bs[0].x; res[j][1] = bs[0].y; res[j][2] = bs[0].z; res[j][3] = bs[0].w; res[j][4] = bs[1].x; res[j][5] = bs[1].y; res[j][6] = bs[1].z; res[j][7] = bs[1].w; }
#pragma unroll
    for (int i = 0; i < 10; ++i) {
        float xv[8]; unpack8(raw[i], xv);
#pragma unroll
        for (int k = 0; k < 3; ++k) { const int j = i - k;
            if (j >= 0 && j < 8) {
                res[j][0] += w[k][0].x * xv[0]; res[j][1] += w[k][0].y * xv[1]; res[j][2] += w[k][0].z * xv[2]; res[j][3] += w[k][0].w * xv[3];
                res[j][4] += w[k][1].x * xv[4]; res[j][5] += w[k][1].y * xv[5]; res[j][6] += w[k][1].z * xv[6]; res[j][7] += w[k][1].w * xv[7]; } }
    }
}

__device__ __forceinline__ void ffn_elementwise(const Ctx& C_, int l) {
    const Ctx C = get_ids(C_.wave);
    KP kp = kparams(); unsigned char* ws = kp->ws;
    const float* const L_state_ffn = kp->in[5];
    float* const L_out = kp->out;
    const bf16_t* const L_UP = (const bf16_t*)(ws + WS_UP);
    bf16_t* const L_ACT = (bf16_t*)(ws + WS_ACT);
    const float* fw = kp->in[22] + (size_t)l * 3 * DUP; const float* fb = kp->in[23] + (size_t)l * DUP;
    const int gtid = C.bid * NTHREADS + C.tid, NT = C.G * NTHREADS;
    constexpr int NV = DFF / 8, NSTRIP = MREAL / 8;
    const int NGRP = NT / NV, v = gtid % NV, sg = gtid / NV;
    f32x4 wg[3][2], bg[2];
    if (sg < NGRP) {
#pragma unroll
        for (int k = 0; k < 3; ++k) { wg[k][0] = *(const f32x4*)(fw + (size_t)k * DUP + v * 8); wg[k][1] = *(const f32x4*)(fw + (size_t)k * DUP + v * 8 + 4); }
        bg[0] = *(const f32x4*)(fb + v * 8); bg[1] = *(const f32x4*)(fb + v * 8 + 4);
    }
    for (int strip = sg; sg < NGRP && strip < NSTRIP; strip += NGRP) {
        const int m0 = strip * 8;
        const bool sample = m0 >= MPROMPT;
        const int t0 = sample ? 0 : (m0 % LP), b = sample ? (m0 - MPROMPT) / DS : 0;
        float gate[8][8], val[8][8];
        ffn_half(L_UP, L_state_ffn, wg, bg, l, m0, t0, sample, b, v * 8, gate);
#pragma unroll
        for (int j = 0; j < 8; ++j)
#pragma unroll
            for (int e = 0; e < 8; ++e) gate[j][e] = siluf_(gate[j][e]);
        f32x4 wv[3][2], bv[2];
#pragma unroll
        for (int k = 0; k < 3; ++k) { wv[k][0] = *(const f32x4*)(fw + (size_t)k * DUP + DFF + v * 8); wv[k][1] = *(const f32x4*)(fw + (size_t)k * DUP + DFF + v * 8 + 4); }
        bv[0] = *(const f32x4*)(fb + DFF + v * 8); bv[1] = *(const f32x4*)(fb + DFF + v * 8 + 4);
        ffn_half(L_UP, L_state_ffn, wv, bv, l, m0, t0, sample, b, DFF + v * 8, val);
#pragma unroll
        for (int j = 0; j < 8; ++j) { float a[8];
#pragma unroll
            for (int e = 0; e < 8; ++e) a[e] = gate[j][e] * val[j][e];
            *(u32x4*)(L_ACT + (size_t)(m0 + j) * DFF + v * 8) = pack8(a); }
    }
    const int gw = C.bid * NWAVES + C.wave, NGW = C.G * NWAVES, lane = C.lane;
    for (int it = gw; it < (NBATCH + DB) * 2; it += NGW) {
        if (it < NBATCH * 2) { const int b = it / 2, i = it - b * 2;
            row_bf16_to_f32(L_UP + (size_t)(b * LP + LP - 2 + i) * DUP, L_out + O_PFFN + ((size_t)(l * NBATCH + b) * 2 + i) * DUP, DUP, lane);
        } else { const int k = it - NBATCH * 2, b = k / 2, i = k - b * 2;
            row_bf16_to_f32(L_UP + (size_t)(MPROMPT + b * DS + 6 + i) * DUP, L_out + O_SFFN + ((size_t)(l * DB + b) * 2 + i) * DUP, DUP, lane); }
    }
}

__device__ __forceinline__ void final_norm(const Ctx& C_) {
    const Ctx C = get_ids(C_.wave);
    KP kp = kparams(); unsigned char* ws = kp->ws; (void)ws;
    const float* const L_final_norm_w = kp->in[25];
    float* const L_X = (float*)(ws + WS_X);
    float* const L_RSS = (float*)(ws + WS_RSS);
    float* const L_out = kp->out;
    const int gw = C.bid * NWAVES + C.wave, NGW = C.G * NWAVES, lane = C.lane;
    for (int m = gw; m < MREAL; m += NGW) {
        float* dst;
        if (m < MPROMPT) { const int b = m / LP, t = m - b * LP; if (t < NMETA) continue; dst = L_out + O_YP + ((size_t)b * SEQ + (t - NMETA)) * DM; }
        else dst = L_out + O_YS + (size_t)(m - MPROMPT) * DM;
        const f32x4* p = (const f32x4*)(L_RSS + (size_t)m * 16); const f32x4 a = p[0], b4 = p[1], c = p[2], d = p[3];
        const float s = ((a.x + a.y) + (a.z + a.w)) + ((b4.x + b4.y) + (b4.z + b4.w)) + ((c.x + c.y) + (c.z + c.w)) + ((d.x + d.y) + (d.z + d.w));
        const float rstd = rsqrtf(s * (1.0f / 1024.0f) + EPS);
#pragma unroll
        for (int j = 0; j < 4; ++j) { const f32x4 x = ((const f32x4*)(L_X + (size_t)m * DM))[lane + 64 * j], w = ((const f32x4*)L_final_norm_w)[lane + 64 * j];
            ((f32x4*)dst)[lane + 64 * j] = x * rstd * w; }
    }
}

__global__ void __launch_bounds__(NTHREADS, 2) hybrid_fwd(Params P) {
    extern __shared__ __attribute__((aligned(16))) unsigned char lds_raw[];
    LAS unsigned char* lds = (LAS unsigned char*)lds_raw;
    Ctx C;
    {
        const int t0 = threadIdx.x;
        C.tid = t0; C.lane = t0 & 63; C.wave = __builtin_amdgcn_readfirstlane(t0 >> 6); C.G = gridDim.x; C.bid = blockIdx.x;
        if (t0 < 4) ((LAS unsigned*)(lds + LDS_ST_OFF))[t0] = 0u;
        if (t0 == 0) { KP kp0 = kparams(); (void)xb_add((unsigned*)(kp0->ws + WS_CTL) + XB_XCNT(xb_xcc_id()), 1u); }
        __syncthreads();
        cg::this_grid().sync();
    }
#define LG_(x) ({ int v_ = (x); asm volatile("" : "+s"(v_)); v_; })
#define GRID_SYNC() do { KP kpb_ = kparams(); grid_barrier(kpb_->ws, lds, C.wave); } while (0)
    prologue(C, lds);
    GRID_SYNC();

    for (int l = 0; l < DEPTH; ++l) {
        { KP kp = kparams(); unsigned char* ws = kp->ws; pg8::StaticOrder S;
          pg8::Gemm g{WSP(bf16_t, WS_XB), WSP(bf16_t, WS_W1T) + (size_t)l * NPROJ * 1024, 1024, 1024, 1024, 0}; S.init(MP, NPROJ, LG_(C.G), LG_(C.bid));
          pg8::EpiScale E{WSP(bf16_t, WS_PROJ), NPROJ, WSP(float, WS_RSS), WSP(float, WS_DT), PC_DT / 256};
          pg8::gemm_phase(lds, C.wave, g, S, E); }
        GRID_SYNC();
        conv_pass(C, l);
        mixer_elementwise(C, l);
        GRID_SYNC();
        ssd_phase(C, lds, l);
        ssd_sample(C, lds, l);
        __syncthreads();
        { KP kp = kparams(); unsigned char* ws = kp->ws; pg8::StaticOrder S;
          pg8::Gemm g{WSP(bf16_t, WS_DBUF), WSP(bf16_t, WS_PWT) + (size_t)l * 1024 * 256, 1024, 256, 256, 256}; S.init(MP, 1024, LG_(C.G), LG_(C.bid));
          pg8::EpiScale E{WSP(bf16_t, WS_POOLED), 1024, nullptr, nullptr, -1};
          pg8::gemm_phase(lds, C.wave, g, S, E); }
        GRID_SYNC();
        yn_normalize(C);
        { KP kp = kparams(); unsigned char* ws = kp->ws; pg8::StaticOrder S;
          pg8::Gemm g{WSP(bf16_t, WS_POOLED), WSP(bf16_t, WS_WPOT) + (size_t)l * 1024 * 1024, 1024, 1024, 1024, 0}; S.init(pg8::MTAIL0, 1024, LG_(C.G), LG_(C.bid));
          pg8::EpiGate<0> E{WSP(bf16_t, WS_MERGED), 1024, WSP(bf16_t, WS_PROJ) + PC_GA, NPROJ};
          pg8::gemm_phase(lds, C.wave, g, S, E); pg8::gemm_tail(lds, C.wave, g, E); }
        GRID_SYNC();
        { KP kp = kparams(); unsigned char* ws = kp->ws; pg8::StaticOrder S;
          pg8::Gemm g{WSP(bf16_t, WS_YN), WSP(bf16_t, WS_WSOT) + (size_t)l * 1024 * 2048, 2048, 2048, 2048, 0}; S.init(pg8::MTAIL0, 1024, LG_(C.G), LG_(C.bid));
          pg8::EpiGate<1> E{WSP(bf16_t, WS_MERGED), 1024, WSP(bf16_t, WS_PROJ) + PC_GB, NPROJ};
          pg8::gemm_phase(lds, C.wave, g, S, E); pg8::gemm_tail(lds, C.wave, g, E); }
        GRID_SYNC();
        { KP kp = kparams(); unsigned char* ws = kp->ws; pg8::StaticOrder S;
          pg8::Gemm g{WSP(bf16_t, WS_MERGED), WSP(bf16_t, WS_WOT) + (size_t)l * 1024 * 1024, 1024, 1024, 1024, 0}; S.init(pg8::MTAIL0, 1024, LG_(C.G), LG_(C.bid));
          pg8::EpiResid E{WSP(float, WS_X), WSP(bf16_t, WS_XB), WSP(float, WS_RSS)};
          pg8::gemm_phase(lds, C.wave, g, S, E); pg8::gemm_tail(lds, C.wave, g, E); }
        GRID_SYNC();
        { KP kp = kparams(); unsigned char* ws = kp->ws; pg8::StaticOrder S;
          pg8::Gemm g{WSP(bf16_t, WS_XB), WSP(bf16_t, WS_WUPT) + (size_t)l * DUP * 1024, 1024, 1024, 1024, 0}; S.init(MP, DUP, LG_(C.G), LG_(C.bid));
          pg8::EpiScale E{WSP(bf16_t, WS_UP), DUP, WSP(float, WS_RSS), nullptr, -1};
          pg8::gemm_phase(lds, C.wave, g, S, E); }
        GRID_SYNC();
        ffn_elementwise(C, l);
        GRID_SYNC();
        { KP kp = kparams(); unsigned char* ws = kp->ws; pg8::StaticOrder S;
          pg8::Gemm g{WSP(bf16_t, WS_ACT), WSP(bf16_t, WS_WDT) + (size_t)l * 1024 * DFF, DFF, DFF, DFF, 0}; S.init(pg8::MTAIL0, 1024, LG_(C.G), LG_(C.bid));
          pg8::EpiResid E{WSP(float, WS_X), WSP(bf16_t, WS_XB), WSP(float, WS_RSS)};
          pg8::gemm_phase(lds, C.wave, g, S, E); pg8::gemm_tail(lds, C.wave, g, E); }
        GRID_SYNC();
    }
    final_norm(C);
}

extern "C" void kernel_launch(void* const* d_in, const int* in_sizes, int n_in, void* d_out, int out_size, void* d_ws, size_t ws_size, hipStream_t stream) {
    static int grid_blocks = 0;
    if (grid_blocks == 0) {
        if (n_in != 26 || (size_t)out_size != O_END || ws_size < WS_END) {
            fprintf(stderr, "kernel_launch: unexpected shapes: n_in %d out %d (want %zu) ws %zu (want %zu)\n", n_in, out_size, (size_t)O_END, ws_size, (size_t)WS_END); grid_blocks = -1; return; }
        int dev = 0, cus = 0, per_cu = 0;
        hipGetDevice(&dev);
        hipDeviceGetAttribute(&cus, hipDeviceAttributeMultiprocessorCount, dev);
        if (hipFuncSetAttribute((const void*)hybrid_fwd, hipFuncAttributeMaxDynamicSharedMemorySize, LDS_BYTES) != hipSuccess) { fprintf(stderr, "kernel_launch: hipFuncSetAttribute failed\n"); grid_blocks = -1; return; }
        if (hipOccupancyMaxActiveBlocksPerMultiprocessor(&per_cu, (const void*)hybrid_fwd, NTHREADS, LDS_BYTES) != hipSuccess || per_cu < 1) { fprintf(stderr, "kernel_launch: occupancy query gave %d\n", per_cu); per_cu = 1; }
        (void)hipGetLastError();
        grid_blocks = cus * per_cu;
    }
    if (grid_blocks < 0) return;
    if (hipMemsetAsync((char*)d_ws + WS_CTL, 0, WS_CTL_BYTES, stream) != hipSuccess) { fprintf(stderr, "kernel_launch: memset of barrier words failed\n"); return; }
    Params p{};
    for (int i = 0; i < 26; ++i) p.in[i] = (const float*)d_in[i];
    p.out = (float*)d_out; p.ws = (unsigned char*)d_ws;
    void* args[] = {&p};
    hipError_t e = hipLaunchCooperativeKernel((const void*)hybrid_fwd, dim3(grid_blocks), dim3(NTHREADS), args, LDS_BYTES, stream);
    if (e != hipSuccess) fprintf(stderr, "cooperative launch failed: %s (grid %d)\n", hipGetErrorString(e), grid_blocks);
}
```

```cpp
#include <hip/hip_runtime.h>
#include <hip/hip_cooperative_groups.h>
#include <cstdio>
#include <cstdint>
namespace cg = cooperative_groups;

#define LAS __attribute__((address_space(3)))
typedef unsigned short bf16_t;
typedef short bf16x8 __attribute__((ext_vector_type(8)));
typedef float f32x4 __attribute__((ext_vector_type(4)));
typedef unsigned u32x4 __attribute__((ext_vector_type(4)));
typedef unsigned u32x2 __attribute__((ext_vector_type(2)));

constexpr int DM = 1024, NBATCH = 8, SEQ = 2048, NMETA = 16, LP = SEQ + NMETA, DEPTH = 4, DB = 128, DS = 8;
constexpr int MPROMPT = NBATCH * LP;
constexpr int MREAL = MPROMPT + DB * DS;
constexpr int MP = 17664;
constexpr int NH = 32, HD = 64, NG = 4, NST = 128, CONVD = 3072, DFF = 2816, DUP = 5632, DINNER = 2048;
constexpr int NPROJ = 8448;
constexpr int PC_U = 0, PC_Z = 1024, PC_XBC = 3072, PC_GA = 6144, PC_GB = 7168, PC_DT = 8192;
constexpr float EPS = 1e-6f;
constexpr int NTHREADS = 512, NWAVES = 8;
constexpr int LDS_BYTES = 147456;
constexpr int LDS_ST_OFF = LDS_BYTES - 16;

constexpr size_t al256(size_t x) { return (x + 255) & ~(size_t)255; }
constexpr size_t WS_W1T = 0;
constexpr size_t WS_PWT = WS_W1T + al256((size_t)DEPTH * NPROJ * 1024 * 2);
constexpr size_t WS_WPOT = WS_PWT + al256((size_t)DEPTH * 1024 * 256 * 2);
constexpr size_t WS_WSOT = WS_WPOT + al256((size_t)DEPTH * 1024 * 1024 * 2);
constexpr size_t WS_WOT = WS_WSOT + al256((size_t)DEPTH * 1024 * 2048 * 2);
constexpr size_t WS_WUPT = WS_WOT + al256((size_t)DEPTH * 1024 * 1024 * 2);
constexpr size_t WS_WDT = WS_WUPT + al256((size_t)DEPTH * DUP * 1024 * 2);
constexpr size_t WS_X = WS_WDT + al256((size_t)DEPTH * 1024 * DFF * 2);
constexpr size_t WS_XB = WS_X + al256((size_t)MP * 1024 * 4);
constexpr size_t WS_RSS = WS_XB + al256((size_t)MP * 1024 * 2);
constexpr size_t WS_PROJ = WS_RSS + al256((size_t)MP * 16 * 4);
constexpr size_t WS_DT = WS_PROJ + al256((size_t)MP * NPROJ * 2);
constexpr size_t WS_DBUF = WS_DT + al256((size_t)MP * 32 * 4);
constexpr size_t WS_POOLED = WS_DBUF + al256((size_t)MP * 1024 * 2);
constexpr size_t WS_YN = WS_POOLED + al256((size_t)MP * 1024 * 2);
constexpr size_t WS_SSQ = WS_YN + al256((size_t)MP * 2048 * 2);
constexpr size_t WS_MERGED = WS_SSQ + al256((size_t)MP * 32 * 4);
constexpr size_t WS_UP = WS_MERGED + al256((size_t)MP * 1024 * 2);
constexpr size_t WS_ACT = WS_UP + al256((size_t)MP * DUP * 2);
constexpr size_t WS_XBCC = WS_ACT + al256((size_t)MP * DFF * 2);
constexpr size_t WS_DTS = WS_XBCC + al256((size_t)MP * CONVD * 2);
constexpr size_t WS_CTL = WS_DTS + al256((size_t)MP * 32 * 4);
constexpr size_t WS_CTL_BYTES = 16384;
constexpr size_t WS_END = WS_CTL + WS_CTL_BYTES;

constexpr size_t O_YP = 0;
constexpr size_t O_YS = O_YP + (size_t)NBATCH * SEQ * DM;
constexpr size_t O_PPOOL = O_YS + (size_t)DB * DS * DM;
constexpr size_t O_PCONV = O_PPOOL + (size_t)DEPTH * NBATCH * 15 * 1024;
constexpr size_t O_PSSM = O_PCONV + (size_t)DEPTH * NBATCH * 3 * CONVD;
constexpr size_t O_PFFN = O_PSSM + (size_t)DEPTH * NBATCH * NH * HD * NST;
constexpr size_t O_SPOOL = O_PFFN + (size_t)DEPTH * NBATCH * 2 * DUP;
constexpr size_t O_SCONV = O_SPOOL + (size_t)DEPTH * DB * 15 * 1024;
constexpr size_t O_SSSM = O_SCONV + (size_t)DEPTH * DB * 3 * CONVD;
constexpr size_t O_SFFN = O_SSSM + (size_t)DEPTH * DB * NH * HD * NST;
constexpr size_t O_END = O_SFFN + (size_t)DEPTH * DB * 2 * DUP;

__device__ __forceinline__ unsigned cvt_pk_bf16(float lo, float hi) { unsigned r; asm("v_cvt_pk_bf16_f32 %0, %1, %2" : "=v"(r) : "v"(lo), "v"(hi)); return r; }
__device__ __forceinline__ unsigned f2bf(float f) { return cvt_pk_bf16(f, f) & 0xffffu; }
__device__ __forceinline__ unsigned pk2(float lo, float hi) { return cvt_pk_bf16(lo, hi); }
__device__ __forceinline__ float bflo(unsigned w) { return __builtin_bit_cast(float, w << 16); }
__device__ __forceinline__ float bfhi(unsigned w) { return __builtin_bit_cast(float, w & 0xffff0000u); }
__device__ __forceinline__ float bf1(bf16_t h) { return __builtin_bit_cast(float, ((unsigned)h) << 16); }
__device__ __forceinline__ float sigmoidf_(float x) { return __builtin_amdgcn_rcpf(1.0f + __expf(-x)); }
__device__ __forceinline__ float siluf_(float x) { return x * sigmoidf_(x); }
__device__ __forceinline__ void unpack8(const u32x4 w, float (&o)[8]) {
    o[0] = bflo(w.x); o[1] = bfhi(w.x); o[2] = bflo(w.y); o[3] = bfhi(w.y); o[4] = bflo(w.z); o[5] = bfhi(w.z); o[6] = bflo(w.w); o[7] = bfhi(w.w);
}
__device__ __forceinline__ u32x4 pack8(const float (&o)[8]) {
    u32x4 w; w.x = pk2(o[0], o[1]); w.y = pk2(o[2], o[3]); w.z = pk2(o[4], o[5]); w.w = pk2(o[6], o[7]); return w;
}
__device__ __forceinline__ float shx(float v, int m, int lane) { return __builtin_bit_cast(float, __builtin_amdgcn_ds_bpermute((lane ^ m) << 2, __builtin_bit_cast(int, v))); }
__device__ __forceinline__ float shup(float v, int d, int lane) { return __builtin_bit_cast(float, __builtin_amdgcn_ds_bpermute((lane - d) << 2, __builtin_bit_cast(int, v))); }
__device__ __forceinline__ float shidx(float v, int src) { return __builtin_bit_cast(float, __builtin_amdgcn_ds_bpermute(src << 2, __builtin_bit_cast(int, v))); }
__device__ __forceinline__ float wave_sum(float v) {
#pragma unroll
    for (int o = 1; o < 64; o <<= 1) v += __shfl_xor(v, o);
    return v;
}
__device__ __forceinline__ u32x4 pack8v(const f32x4 a, const f32x4 b) { u32x4 w; w.x = pk2(a.x, a.y); w.y = pk2(a.z, a.w); w.z = pk2(b.x, b.y); w.w = pk2(b.z, b.w); return w; }
#define LDS_WAIT() asm volatile("s_waitcnt lgkmcnt(0)" ::: "memory")
#define LBAR() do { asm volatile("s_waitcnt lgkmcnt(0)" ::: "memory"); __builtin_amdgcn_s_barrier(); asm volatile("" ::: "memory"); } while (0)

namespace pg8 {
constexpr int BM = 256, BK = 64, HALF = 128, HTB = HALF * BK * 2, STAGE_BYTES = 8 * HTB, NXCD = 8, WGM = 8;
__host__ __device__ __forceinline__ int lds_byte(int r, int c) { const int st = (r >> 4) * 2 + (c >> 5), rr = r & 15, cc = c & 31, ob = rr * 64 + cc * 2; return st * 1024 + (ob ^ (((ob >> 9) & 1) << 5)); }
__host__ __device__ __forceinline__ void stage_rc(int b, int& R, int& C) { const int st = b / 1024, sb = b % 1024, swz = sb ^ (((sb >> 9) & 1) << 5); R = (st >> 1) * 16 + swz / 64; C = (st & 1) * 32 + (swz % 64) / 2; }
__host__ __device__ __forceinline__ int perm32(int rho) { const int n = rho >> 4, i = rho & 15; return 8 * (i >> 2) + 4 * n + (i & 3); }

struct Unit { int pm, pn; };
struct Gemm { const bf16_t* A; const bf16_t* Bt; int lda, ldb, K, a_pn_off; };

struct StaticOrder {
    int nM, nN, nwg, G, c;
    __device__ void init(int M, int N, int G_, int c_) { nM = M / BM; nN = N / BM; nwg = nM * nN; G = G_; c = c_; }
    __device__ bool next(int i, Unit& u) const {
        const long L = (long)i * G + c; if (L >= nwg) return false;
        int wgid = (int)L; { const int q = nwg / NXCD, r = nwg % NXCD, xcd = wgid % NXCD, off = wgid / NXCD; wgid = (xcd < r ? xcd * (q + 1) : r * (q + 1) + (xcd - r) * q) + off; }
        const int nig = WGM * nN, gid = wgid / nig, fm = gid * WGM, gsz = (nM - fm) < WGM ? (nM - fm) : WGM;
        u.pm = fm + ((wgid % nig) % gsz); u.pn = (wgid % nig) / gsz; return true;
    }
};


struct EpiScale {
    bf16_t* O; int ldc; const float* rss; float* dtf; int dt_pn;
    __device__ __forceinline__ void operator()(const f32x4 (&acc)[2][2][4][2], const Unit& u, int wr, int wc, int fr, int fq) const {
        const int row0 = u.pm * BM + wr * 64 + fr, col0 = u.pn * BM + wc * 32 + 8 * fq;
#pragma unroll
        for (int ai = 0; ai < 2; ++ai)
#pragma unroll
            for (int m = 0; m < 4; ++m) {
                const int row = row0 + ai * HALF + m * 16;
                float sc = 1.f;
                if (rss) { const f32x4* p = (const f32x4*)(rss + (size_t)row * 16); const f32x4 a = p[0], b = p[1], c = p[2], d = p[3];
                    const float s = ((a.x + a.y) + (a.z + a.w)) + ((b.x + b.y) + (b.z + b.w)) + ((c.x + c.y) + (c.z + c.w)) + ((d.x + d.y) + (d.z + d.w));
                    sc = rsqrtf(s * (1.0f / 1024.0f) + EPS); }
                bf16_t* rowp = O + (size_t)row * ldc + col0;
#pragma unroll
                for (int bj = 0; bj < 2; ++bj) { const f32x4 v0 = acc[ai][bj][m][0] * sc, v1 = acc[ai][bj][m][1] * sc;
                    u32x4 w; w.x = cvt_pk_bf16(v0[0], v0[1]); w.y = cvt_pk_bf16(v0[2], v0[3]); w.z = cvt_pk_bf16(v1[0], v1[1]); w.w = cvt_pk_bf16(v1[2], v1[3]);
                    *(u32x4*)(rowp + bj * HALF) = w;
                    if (bj == 0 && dtf != nullptr && u.pn == dt_pn && wc == 0) { float* dp = dtf + (size_t)row * 32 + 8 * fq; *(f32x4*)dp = v0; *(f32x4*)(dp + 4) = v1; } }
            }
    }
};
template <int MODE> struct EpiGate {
    bf16_t* O; int ldc; const bf16_t* gate; int ldg;
    struct Pre { u32x2 gw, ow; };
    __device__ __forceinline__ Pre tail4_pre(int row, int col) const { Pre p; p.gw = *(const u32x2*)(gate + (size_t)row * ldg + col); p.ow = (u32x2){0u, 0u};
        if (MODE == 1) p.ow = *(const u32x2*)(O + (size_t)row * ldc + col); return p; }
    __device__ __forceinline__ void tail4(const f32x4 v, const Pre& pre, int row, int col, int l16) const {
        const u32x2 gw = pre.gw;
        float v0 = sigmoidf_(bflo(gw.x)) * v[0], v1 = sigmoidf_(bfhi(gw.x)) * v[1], v2 = sigmoidf_(bflo(gw.y)) * v[2], v3 = sigmoidf_(bfhi(gw.y)) * v[3];
        bf16_t* op = O + (size_t)row * ldc + col;
        if (MODE == 1) { const u32x2 ow = pre.ow; v0 += bflo(ow.x); v1 += bfhi(ow.x); v2 += bflo(ow.y); v3 += bfhi(ow.y); }
        u32x2 w; w.x = cvt_pk_bf16(v0, v1); w.y = cvt_pk_bf16(v2, v3);
        *(u32x2*)op = w;
    }
    __device__ __forceinline__ void operator()(const f32x4 (&acc)[2][2][4][2], const Unit& u, int wr, int wc, int fr, int fq) const {
        const int row0 = u.pm * BM + wr * 64 + fr, col0 = u.pn * BM + wc * 32 + 8 * fq;
#pragma unroll
        for (int ai = 0; ai < 2; ++ai) {
            u32x4 gwv[4][2], owv[4][2];
#pragma unroll
            for (int m = 0; m < 4; ++m)
#pragma unroll
                for (int bj = 0; bj < 2; ++bj) { const size_t row = (size_t)(row0 + ai * HALF + m * 16);
                    gwv[m][bj] = *(const u32x4*)(gate + row * ldg + col0 + bj * HALF);
                    if (MODE == 1) owv[m][bj] = *(const u32x4*)(O + row * ldc + col0 + bj * HALF); }
#pragma unroll
            for (int m = 0; m < 4; ++m) {
                bf16_t* rowp = O + (size_t)(row0 + ai * HALF + m * 16) * ldc + col0;
#pragma unroll
                for (int bj = 0; bj < 2; ++bj) {
                    float g[8]; unpack8(gwv[m][bj], g);
                    const f32x4 a0 = acc[ai][bj][m][0], a1 = acc[ai][bj][m][1];
                    float v[8];
                    v[0] = sigmoidf_(g[0]) * a0[0]; v[1] = sigmoidf_(g[1]) * a0[1]; v[2] = sigmoidf_(g[2]) * a0[2]; v[3] = sigmoidf_(g[3]) * a0[3];
                    v[4] = sigmoidf_(g[4]) * a1[0]; v[5] = sigmoidf_(g[5]) * a1[1]; v[6] = sigmoidf_(g[6]) * a1[2]; v[7] = sigmoidf_(g[7]) * a1[3];
                    if (MODE == 1) { float o[8]; unpack8(owv[m][bj], o);
#pragma unroll
                        for (int e = 0; e < 8; ++e) v[e] += o[e]; }
                    u32x4 w; w.x = cvt_pk_bf16(v[0], v[1]); w.y = cvt_pk_bf16(v[2], v[3]); w.z = cvt_pk_bf16(v[4], v[5]); w.w = cvt_pk_bf16(v[6], v[7]);
                    *(u32x4*)(rowp + bj * HALF) = w; }
            }
        }
    }
};
struct EpiResid {
    float* X; bf16_t* XB; float* rss;
    struct Pre { f32x4 x; };
    __device__ __forceinline__ Pre tail4_pre(int row, int col) const { Pre p; p.x = *(const f32x4*)(X + (size_t)row * DM + col); return p; }
    __device__ __forceinline__ void tail4(const f32x4 v, const Pre& pre, int row, int col, int l16) const {
        float* xp = X + (size_t)row * DM + col;
        f32x4 x0 = pre.x; x0 += v; *(f32x4*)xp = x0;
        float ss = (x0[0] * x0[0] + x0[1] * x0[1]) + (x0[2] * x0[2] + x0[3] * x0[3]);
        u32x2 w; w.x = cvt_pk_bf16(x0[0], x0[1]); w.y = cvt_pk_bf16(x0[2], x0[3]);
        *(u32x2*)(XB + (size_t)row * DM + col) = w;
        ss += shx(ss, 1, l16); ss += shx(ss, 2, l16); ss += shx(ss, 4, l16); ss += shx(ss, 8, l16);
        if ((l16 & 15) == 0) rss[(size_t)row * 16 + (col >> 6)] = ss;
    }
    __device__ __forceinline__ void operator()(const f32x4 (&acc)[2][2][4][2], const Unit& u, int wr, int wc, int fr, int fq) const {
        const int row0 = u.pm * BM + wr * 64 + fr, col0 = u.pn * BM + wc * 32 + 8 * fq;
#pragma unroll
        for (int ai = 0; ai < 2; ++ai)
#pragma unroll
            for (int mp = 0; mp < 2; ++mp) {
                f32x4 xv[2][2][2];
#pragma unroll
                for (int mm = 0; mm < 2; ++mm)
#pragma unroll
                    for (int bj = 0; bj < 2; ++bj) { const float* xp = X + (size_t)(row0 + ai * HALF + (2 * mp + mm) * 16) * DM + col0 + bj * HALF;
                        xv[mm][bj][0] = *(const f32x4*)xp; xv[mm][bj][1] = *(const f32x4*)(xp + 4); }
#pragma unroll
                for (int mm = 0; mm < 2; ++mm) {
                    const int m = 2 * mp + mm, row = row0 + ai * HALF + m * 16;
                    float* xp = X + (size_t)row * DM + col0; bf16_t* bp = XB + (size_t)row * DM + col0;
                    float ss = 0.f;
#pragma unroll
                    for (int bj = 0; bj < 2; ++bj) {
                        f32x4 x0 = xv[mm][bj][0], x1 = xv[mm][bj][1];
                        x0 += acc[ai][bj][m][0]; x1 += acc[ai][bj][m][1];
                        *(f32x4*)(xp + bj * HALF) = x0; *(f32x4*)(xp + bj * HALF + 4) = x1;
                        ss += (x0[0] * x0[0] + x0[1] * x0[1]) + (x0[2] * x0[2] + x0[3] * x0[3]) + (x1[0] * x1[0] + x1[1] * x1[1]) + (x1[2] * x1[2] + x1[3] * x1[3]);
                        u32x4 w; w.x = cvt_pk_bf16(x0[0], x0[1]); w.y = cvt_pk_bf16(x0[2], x0[3]); w.z = cvt_pk_bf16(x1[0], x1[1]); w.w = cvt_pk_bf16(x1[2], x1[3]);
                        *(u32x4*)(bp + bj * HALF) = w; }
                    ss += shx(ss, 16, fq * 16 + fr); ss += shx(ss, 32, fq * 16 + fr);
                    if (fq == 0) rss[(size_t)row * 16 + u.pn * 4 + wc] = ss;
                }
            }
    }
};

template <class Epi>
__device__ __forceinline__ void gemm_phase(LAS unsigned char* lds_in, int wave_in, const Gemm g, const StaticOrder& S, const Epi& E) {
    int lane = (int)__builtin_amdgcn_mbcnt_hi(~0u, __builtin_amdgcn_mbcnt_lo(~0u, 0u)); asm volatile("" : "+v"(lane));
    int wid = wave_in; asm volatile("" : "+s"(wid));
    const int tid = wid * 64 + lane;
    LAS unsigned char* lds = lds_in; asm volatile("" : "+s"(lds));
    const int wr = wid >> 2, wc = wid & 3, fr = lane & 15, fq = lane >> 4;
    const int K = g.K, nt = K / BK;
    unsigned voffA[2], voffB[2];
#pragma unroll
    for (int i = 0; i < 2; ++i) { int R, C; stage_rc(tid * 16 + i * 8192, R, C); const int Rb = (R & ~31) + perm32(R & 31);
        voffA[i] = (unsigned)(R * g.lda + C) * 2u; voffB[i] = (unsigned)(Rb * g.ldb + C) * 2u; }
    const size_t kstep = (size_t)(BK * 2);
    const size_t hstepA = (size_t)HALF * g.lda * 2, hstepB = (size_t)HALF * g.ldb * 2;
    const size_t tstepA = 2 * hstepA, tstepB = 2 * hstepB;
    const unsigned ldsw = (unsigned)wid * 1024u;
    const int aoff = lds_byte(wr * 64 + fr, fq * 8), boff = lds_byte(wc * 32 + fr, fq * 8);
#define PG8_SA(b, h) (((b) * 2 + (h)) * HTB)
#define PG8_SB(b, h) ((4 + (b) * 2 + (h)) * HTB)
#define PG8_STAGE(bufoff, gbase, voff) do { _Pragma("unroll") for (int _i = 0; _i < 2; ++_i) \
        __builtin_amdgcn_global_load_lds((const unsigned*)((const char*)(gbase) + (voff)[_i]), (LAS unsigned*)(lds + (bufoff) + ldsw + _i * 8192), 16, 0, 0); } while (0)
#define PG8_LDA(dst, b, h) do { _Pragma("unroll") for (int m = 0; m < 4; ++m) _Pragma("unroll") for (int k = 0; k < 2; ++k) dst[m][k] = *(const LAS bf16x8*)(lds + PG8_SA(b, h) + aoff + m * 2048 + k * 1024); } while (0)
#define PG8_LDB(dst, b, h) do { _Pragma("unroll") for (int n = 0; n < 2; ++n) _Pragma("unroll") for (int k = 0; k < 2; ++k) dst[n][k] = *(const LAS bf16x8*)(lds + PG8_SB(b, h) + boff + n * 2048 + k * 1024); } while (0)
#define PG8_MMA(ai, bj, At, Bt) do { __builtin_amdgcn_s_setprio(1); _Pragma("unroll") for (int m = 0; m < 4; ++m) _Pragma("unroll") for (int n = 0; n < 2; ++n) _Pragma("unroll") for (int k = 0; k < 2; ++k) \
        acc[ai][bj][m][n] = __builtin_amdgcn_mfma_f32_16x16x32_bf16(Bt[n][k], At[m][k], acc[ai][bj][m][n], 0, 0, 0); __builtin_amdgcn_s_setprio(0); } while (0)
#define PG8_WAIT_V(n) asm volatile("s_waitcnt vmcnt(" #n ")" ::: "memory")
#define PG8_WAIT_L(n) asm volatile("s_waitcnt lgkmcnt(" #n ")" ::: "memory")
#define PG8_BAR __builtin_amdgcn_s_barrier()
#define PG8_SCHED __builtin_amdgcn_sched_barrier(0)
    Unit cur, nxt; int ui = 0;
    if (!S.next(0, cur)) return;
    f32x4 acc[2][2][4][2];
#pragma unroll
    for (int a = 0; a < 2; ++a)
#pragma unroll
        for (int b = 0; b < 2; ++b)
#pragma unroll
            for (int m = 0; m < 4; ++m)
#pragma unroll
                for (int n = 0; n < 2; ++n) acc[a][b][m][n] = (f32x4){0.f, 0.f, 0.f, 0.f};
    bf16x8 At[4][2], B0[2][2], B1[2][2];
    const char* cA = (const char*)g.A + (size_t)cur.pm * tstepA + (size_t)cur.pn * g.a_pn_off * 2; const char* cB = (const char*)g.Bt + (size_t)cur.pn * tstepB;
    PG8_STAGE(PG8_SB(0, 0), cB, voffB); PG8_STAGE(PG8_SB(0, 1), cB + hstepB, voffB); PG8_STAGE(PG8_SA(0, 0), cA, voffA); PG8_STAGE(PG8_SA(0, 1), cA + hstepA, voffA);
    if (wr == 1) PG8_BAR;
    PG8_WAIT_V(2); PG8_BAR;
    PG8_STAGE(PG8_SB(1, 0), cB + kstep, voffB); PG8_STAGE(PG8_SA(1, 0), cA + kstep, voffA); PG8_STAGE(PG8_SB(1, 1), cB + hstepB + kstep, voffB);
    PG8_WAIT_V(6); PG8_BAR;
    for (;;) {
        const bool has_next = S.next(ui + 1, nxt);
        const char* nA = has_next ? (const char*)g.A + (size_t)nxt.pm * tstepA + (size_t)nxt.pn * g.a_pn_off * 2 : cA; const char* nB = has_next ? (const char*)g.Bt + (size_t)nxt.pn * tstepB : cB;
        for (int t = 0; t < nt; t += 2) {
            const bool last = (t == nt - 2);
            const char* a1 = cA + (size_t)(t + 1) * kstep;
            const char* a2 = last ? nA : cA + (size_t)(t + 2) * kstep; const char* b2 = last ? nB : cB + (size_t)(t + 2) * kstep;
            const char* a3 = a2 + kstep; const char* b3 = b2 + kstep;
            PG8_LDB(B0, 0, 0); PG8_LDB(B1, 0, 1); PG8_SCHED; PG8_LDA(At, 0, 0); PG8_STAGE(PG8_SA(1, 1), a1 + hstepA, voffA);
            PG8_WAIT_V(8); PG8_WAIT_L(0); PG8_BAR; PG8_MMA(0, 0, At, B0); PG8_MMA(0, 1, At, B1); PG8_BAR; PG8_SCHED;
            PG8_LDA(At, 0, 1); PG8_STAGE(PG8_SB(0, 0), b2, voffB); PG8_STAGE(PG8_SB(0, 1), b2 + hstepB, voffB); PG8_STAGE(PG8_SA(0, 0), a2, voffA);
            PG8_WAIT_V(8); PG8_WAIT_L(0); PG8_BAR; PG8_MMA(1, 0, At, B0); PG8_MMA(1, 1, At, B1); PG8_BAR; PG8_SCHED;
            PG8_LDB(B0, 1, 0); PG8_LDB(B1, 1, 1); PG8_SCHED; PG8_LDA(At, 1, 0); PG8_STAGE(PG8_SA(0, 1), a2 + hstepA, voffA);
            PG8_WAIT_V(8); PG8_WAIT_L(0); PG8_BAR; PG8_MMA(0, 0, At, B0); PG8_MMA(0, 1, At, B1); PG8_BAR; PG8_SCHED;
            PG8_LDA(At, 1, 1); PG8_STAGE(PG8_SB(1, 0), b3, voffB); PG8_STAGE(PG8_SB(1, 1), b3 + hstepB, voffB); PG8_STAGE(PG8_SA(1, 0), a3, voffA);
            PG8_WAIT_V(8); PG8_WAIT_L(0); PG8_BAR; PG8_MMA(1, 0, At, B0); PG8_MMA(1, 1, At, B1); PG8_BAR; PG8_SCHED;
        }
        if (wr == 0) PG8_BAR;
        E(acc, cur, wr, wc, fr, fq);
        if (!has_next) break;
#pragma unroll
        for (int a = 0; a < 2; ++a)
#pragma unroll
            for (int b = 0; b < 2; ++b)
#pragma unroll
                for (int m = 0; m < 4; ++m)
#pragma unroll
                    for (int n = 0; n < 2; ++n) acc[a][b][m][n] = (f32x4){0.f, 0.f, 0.f, 0.f};
        cur = nxt; cA = nA; cB = nB; ++ui;
        if (wr == 1) PG8_BAR;
    }
    PG8_WAIT_V(0);
    PG8_BAR;
#undef PG8_SA
#undef PG8_SB
#undef PG8_STAGE
#undef PG8_LDA
#undef PG8_LDB
#undef PG8_MMA
#undef PG8_WAIT_V
#undef PG8_WAIT_L
#undef PG8_BAR
#undef PG8_SCHED
}

constexpr int MTAIL0 = 16384;
template <class Epi>
__device__ __forceinline__ void gemm_tail(LAS unsigned char* lds_in, int wave_in, const Gemm g, const Epi& E) {
    int lane = (int)__builtin_amdgcn_mbcnt_hi(~0u, __builtin_amdgcn_mbcnt_lo(~0u, 0u)); asm volatile("" : "+v"(lane));
    int wid = wave_in; asm volatile("" : "+s"(wid));
    LAS unsigned char* lds = lds_in; asm volatile("" : "+s"(lds));
    int G = gridDim.x, bid = blockIdx.x; asm volatile("" : "+s"(G)); asm volatile("" : "+s"(bid));
    const int r = lane & 15, q = lane >> 4;
    constexpr int NRT = (MREAL - MTAIL0) / 32, NCT = 1024 / 64;
    const int klen = g.K / 8, kbeg = wid * klen;
    const int nx = (G % 8 == 0) ? 8 : 1, x = (nx == 8) ? (bid & 7) : 0, j = (nx == 8) ? (bid >> 3) : bid, nj = G / nx;
    const int ct_per = NCT / nx, ntile = NRT * ct_per;
    LAS float* red = (LAS float*)lds;
    const size_t a16 = (size_t)16 * g.lda, b16 = (size_t)16 * g.ldb;
    bf16x8 pa[4][2], pb[4][4];
#define TAIL_PTRS(tt_, rt_, ct_, row0_, col0_, ap_, bp_) const int rt_ = (tt_) % NRT, ct_ = x * ct_per + (tt_) / NRT, row0_ = MTAIL0 + 32 * rt_, col0_ = 64 * ct_; \
        const bf16_t* ap_ = g.A + (size_t)(row0_ + r) * g.lda + 8 * q + kbeg + (size_t)(col0_ >> 8) * g.a_pn_off; const bf16_t* bp_ = g.Bt + (size_t)(col0_ + r) * g.ldb + 8 * q + kbeg; (void)rt_; (void)ct_;
#define TAIL_PF(ap_, bp_) do { _Pragma("unroll") for (int s_ = 0; s_ < 4; ++s_) { _Pragma("unroll") for (int i = 0; i < 2; ++i) pa[s_][i] = *(const bf16x8*)((ap_) + i * a16 + 32 * s_); \
        _Pragma("unroll") for (int f = 0; f < 4; ++f) pb[s_][f] = *(const bf16x8*)((bp_) + f * b16 + 32 * s_); } } while (0)
    if (j < ntile) { TAIL_PTRS(j, rt0, ct0, row00, col00, ap0, bp0); (void)row00; TAIL_PF(ap0, bp0); }
    for (int tt = j; tt < ntile; tt += nj) {
        TAIL_PTRS(tt, rt, ct, row0, col0, ap, bp);
        const int rr = 4 * wid + (lane >> 4), cc = 4 * (lane & 15);
        const typename Epi::Pre pre = E.tail4_pre(row0 + rr, col0 + cc);
        f32x4 acc[2][4];
#pragma unroll
        for (int i = 0; i < 2; ++i)
#pragma unroll
            for (int f = 0; f < 4; ++f) acc[i][f] = (f32x4){0.f, 0.f, 0.f, 0.f};
#pragma unroll
        for (int s_ = 0; s_ < 4; ++s_)
#pragma unroll
            for (int i = 0; i < 2; ++i)
#pragma unroll
                for (int f = 0; f < 4; ++f) acc[i][f] = __builtin_amdgcn_mfma_f32_16x16x32_bf16(pb[s_][f], pa[s_][i], acc[i][f], 0, 0, 0);
#pragma unroll 4
        for (int k0 = 128; k0 < klen; k0 += 32) {
            bf16x8 a[2], b[4];
#pragma unroll
            for (int i = 0; i < 2; ++i) a[i] = *(const bf16x8*)(ap + i * a16 + k0);
#pragma unroll
            for (int f = 0; f < 4; ++f) b[f] = *(const bf16x8*)(bp + f * b16 + k0);
#pragma unroll
            for (int i = 0; i < 2; ++i)
#pragma unroll
                for (int f = 0; f < 4; ++f) acc[i][f] = __builtin_amdgcn_mfma_f32_16x16x32_bf16(b[f], a[i], acc[i][f], 0, 0, 0);
        }
        __builtin_amdgcn_sched_barrier(0);
        if (tt + nj < ntile) { TAIL_PTRS(tt + nj, rtn, ctn, row0n, col0n, apn, bpn); (void)row0n; TAIL_PF(apn, bpn); }
        __builtin_amdgcn_sched_barrier(0);
#pragma unroll
        for (int i = 0; i < 2; ++i)
#pragma unroll
            for (int f = 0; f < 4; ++f) *(LAS f32x4*)(red + wid * 2048 + (16 * i + r) * 64 + 16 * f + 4 * q) = acc[i][f];
        LBAR();
        {
            f32x4 v = (f32x4){0.f, 0.f, 0.f, 0.f};
#pragma unroll
            for (int w = 0; w < 8; ++w) v += *(const LAS f32x4*)(red + w * 2048 + rr * 64 + cc);
            E.tail4(v, pre, row0 + rr, col0 + cc, lane);
        }
        LBAR();
    }
#undef TAIL_PTRS
#undef TAIL_PF
}
}

struct Params { const float* in[26]; float* out; unsigned char* ws; };

typedef const Params __attribute__((address_space(4)))* KP;
__device__ __forceinline__ KP kparams() { KP p = (KP)__builtin_amdgcn_kernarg_segment_ptr(); asm volatile("" : "+s"(p)); return p; }
struct Ctx { int tid, lane, wave, G, bid; };
__device__ __forceinline__ Ctx get_ids(int wave_in) { Ctx I;
    int ln = (int)__builtin_amdgcn_mbcnt_hi(~0u, __builtin_amdgcn_mbcnt_lo(~0u, 0u)); asm volatile("" : "+v"(ln));
    int wv = wave_in; asm volatile("" : "+s"(wv));
    int gg = gridDim.x, bb = blockIdx.x; asm volatile("" : "+s"(gg)); asm volatile("" : "+s"(bb));
    I.lane = ln; I.wave = wv; I.tid = wv * 64 + ln; I.G = gg; I.bid = bb; return I; }

#define XB_TMO      128
#define XB_XCNT(j)  (256  + 64 * (j))
#define XB_XSUB(j)  (1280 + 64 * (j))
#define XB_XGEN(j)  (2304 + 64 * (j))
#define XB_TOP      3328
#define XB_TOPGEN   3392
#define XCD_BAR_WORDS 3456
#define XB_SPIN_CAP (1u << 20)
__device__ __forceinline__ unsigned xb_ld(unsigned* p)              { return __hip_atomic_load(p, __ATOMIC_RELAXED, __HIP_MEMORY_SCOPE_AGENT); }
__device__ __forceinline__ unsigned xb_add(unsigned* p, unsigned v) { return __hip_atomic_fetch_add(p, v, __ATOMIC_RELAXED, __HIP_MEMORY_SCOPE_AGENT); }
__device__ __forceinline__ unsigned xb_xcc_id() { return (unsigned)__builtin_amdgcn_s_getreg((3 << 11) | 20) & 0xFu; }
#define XB_SPIN(cond, bar) do { unsigned _sp = 0; while (cond) { __builtin_amdgcn_s_sleep(1); \
    if ((++_sp & 255u) == 0u) { if (xb_ld(&(bar)[XB_TMO])) break; if (_sp > XB_SPIN_CAP) { atomicAdd(&(bar)[XB_TMO], 1u); break; } } } } while (0)
__device__ __forceinline__ void xcd_barrier_complete(unsigned* bar, unsigned x, unsigned& nloc, unsigned& nx) {
    const unsigned G = gridDim.x;
    unsigned sum, cnt, mine, sp = 0u;
    for (;;) {
        sum = 0u; cnt = 0u; mine = 0u;
#pragma unroll
        for (unsigned j = 0; j < 16; ++j) { const unsigned c = xb_ld(&bar[XB_XCNT(j)]); sum += c; cnt += (c > 0u) ? 1u : 0u; mine = (j == x) ? c : mine; }
        if (sum == G) break;
        __builtin_amdgcn_s_sleep(1);
        if ((++sp & 255u) == 0u) { if (xb_ld(&bar[XB_TMO])) break; if (sp > XB_SPIN_CAP) { atomicAdd(&bar[XB_TMO], 1u); break; } }
    }
    nloc = mine > 0u ? mine : 1u; nx = cnt > 0u ? cnt : 1u;
}
__device__ __forceinline__ void grid_barrier(unsigned char* ws, LAS unsigned char* lds_in, int wave_in) {
    const Ctx C = get_ids(wave_in);
    unsigned* bar = (unsigned*)(ws + WS_CTL);
    volatile LAS unsigned* st = (volatile LAS unsigned*)(lds_in + LDS_ST_OFF);
    asm volatile("s_waitcnt vmcnt(0)" ::: "memory");
    __syncthreads();
    if (C.tid == 0) {
        __builtin_amdgcn_s_waitcnt(0);
        const unsigned x = xb_xcc_id();
        unsigned nloc = st[0], nx = st[1];
        if (nloc == 0u) { xcd_barrier_complete(bar, x, nloc, nx); st[0] = nloc; st[1] = nx; }
        const unsigned old = xb_add(&bar[XB_XSUB(x)], 1u);
        const unsigned gen = old / nloc;
        if (old + 1u == (gen + 1u) * nloc) {
            __builtin_amdgcn_fence(__ATOMIC_RELEASE, "agent");
            asm volatile("s_waitcnt vmcnt(0)" ::: "memory");
            const unsigned og = xb_add(&bar[XB_TOP], 1u);
            const unsigned tg = og / nx;
            if (og + 1u == (tg + 1u) * nx) xb_add(&bar[XB_TOPGEN], 1u);
            else XB_SPIN(xb_ld(&bar[XB_TOPGEN]) == tg, bar);
            __builtin_amdgcn_fence(__ATOMIC_ACQUIRE, "agent");
            xb_add(&bar[XB_XGEN(x)], 1u);
            asm volatile("s_waitcnt vmcnt(0)" ::: "memory");
        } else {
            XB_SPIN(xb_ld(&bar[XB_XGEN(x)]) == gen, bar);
            __builtin_amdgcn_fence(__ATOMIC_ACQUIRE, "agent");
            asm volatile("s_waitcnt vmcnt(0)" ::: "memory");
        }
    }
    __syncthreads();
}

#define IN_(i) (kp->in[i])
#define WSP(T, off) ((T*)(ws + (off)))

__device__ __forceinline__ void transpose_item(const float* W, int ldw, int col0, int k0, bf16_t* WT, int ldk, const float* ks, const float* ns, int ncol_valid, LAS float* scr, int lane) {
    const int c4 = (lane & 15) * 4, rsub = lane >> 4;
    const bool cv = c4 < ncol_valid;
    f32x4 nsv = (f32x4){1.f, 1.f, 1.f, 1.f}; if (ns && cv) nsv = *(const f32x4*)(ns + c4);
    f32x4 v[16];
#pragma unroll
    for (int i = 0; i < 16; ++i) v[i] = cv ? *(const f32x4*)(W + (size_t)(k0 + i * 4 + rsub) * ldw + col0 + c4) : (f32x4){0.f, 0.f, 0.f, 0.f};
#pragma unroll
    for (int i = 0; i < 16; ++i) { const int kk = i * 4 + rsub; f32x4 x = v[i] * nsv; if (ks) x = x * ks[k0 + kk];
        LAS float* d = scr + kk * 65 + c4; d[0] = x.x; d[1] = x.y; d[2] = x.z; d[3] = x.w; }
    LDS_WAIT(); asm volatile("" ::: "memory");
    const int c = lane & 7;
#pragma unroll
    for (int j = 0; j < 8; ++j) { const int n = (lane >> 3) + 8 * j; const LAS float* s = scr + (8 * c) * 65 + n;
        u32x4 o; o.x = pk2(s[0 * 65], s[1 * 65]); o.y = pk2(s[2 * 65], s[3 * 65]); o.z = pk2(s[4 * 65], s[5 * 65]); o.w = pk2(s[6 * 65], s[7 * 65]);
        *(u32x4*)(WT + (size_t)n * ldk + k0 + 8 * c) = o; }
    LDS_WAIT(); asm volatile("" ::: "memory");
}

__device__ __forceinline__ void prologue(const Ctx& C_, LAS unsigned char* lds) {
    const Ctx C = get_ids(C_.wave);
    KP kp = kparams(); unsigned char* ws = kp->ws; (void)ws;
    const float* const L_x_prompt = kp->in[0];
    const float* const L_x_sample = kp->in[1];
    const float* const L_meta = kp->in[6];
    const float* const L_norm1_w = kp->in[7];
    const float* const L_w_in = kp->in[8];
    const float* const L_pool_w = kp->in[9];
    const float* const L_pool_scale = kp->in[10];
    const float* const L_w_pool_out = kp->in[11];
    const float* const L_ssd_norm_w = kp->in[17];
    const float* const L_w_ssd_out = kp->in[18];
    const float* const L_w_o = kp->in[19];
    const float* const L_norm2_w = kp->in[20];
    const float* const L_w_up = kp->in[21];
    const float* const L_w_down = kp->in[24];
    bf16_t* const L_W1T = (bf16_t*)(ws + WS_W1T);
    bf16_t* const L_PWT = (bf16_t*)(ws + WS_PWT);
    bf16_t* const L_WPOT = (bf16_t*)(ws + WS_WPOT);
    bf16_t* const L_WSOT = (bf16_t*)(ws + WS_WSOT);
    bf16_t* const L_WOT = (bf16_t*)(ws + WS_WOT);
    bf16_t* const L_WUPT = (bf16_t*)(ws + WS_WUPT);
    bf16_t* const L_WDT = (bf16_t*)(ws + WS_WDT);
    bf16_t* const L_XB = (bf16_t*)(ws + WS_XB);
    float* const L_X = (float*)(ws + WS_X);
    float* const L_RSS = (float*)(ws + WS_RSS);
    LAS float* scr = (LAS float*)(lds + C.wave * 16640);
    const int gw = C.bid * NWAVES + C.wave, NGW = C.G * NWAVES, lane = C.lane;
    constexpr int NB1 = NPROJ / 64;
    constexpr int I_W1 = 16 * NB1, I_PW = 4 * 4 * 4, I_PO = 16 * 16, I_SO = 32 * 16, I_O = 16 * 16, I_UP = 16 * (DUP / 64), I_D = (DFF / 64) * 16;
    constexpr int I_LAYER = I_W1 + I_PW + I_PO + I_SO + I_O + I_UP + I_D;
    for (int it = gw; it < DEPTH * I_LAYER; it += NGW) {
        const int l = it / I_LAYER; int r = it - l * I_LAYER;
        if (r < I_W1) {
            const int nb = r % NB1, kb = r / NB1, n0 = nb * 64, k0 = kb * 64;
            bf16_t* dst = L_W1T + ((size_t)l * NPROJ + n0) * 1024;
            if (n0 >= PC_DT + 64) {
                const int c = lane & 7;
#pragma unroll
                for (int j = 0; j < 8; ++j) { const int n = (lane >> 3) + 8 * j; *(u32x4*)(dst + (size_t)n * 1024 + k0 + 8 * c) = (u32x4){0u, 0u, 0u, 0u}; }
            } else {
                int sc, nv = 64;
                if (n0 < PC_GA) sc = n0; else if (n0 < PC_GB) sc = 6176 + (n0 - PC_GA); else if (n0 < PC_DT) sc = 7200 + (n0 - PC_GB); else { sc = 6144; nv = 32; }
                transpose_item(L_w_in + (size_t)l * 1024 * 8224, 8224, sc, k0, dst, 1024, L_norm1_w + l * 1024, nullptr, nv, scr, lane);
            }
            continue;
        }
        r -= I_W1;
        if (r < I_PW) {
            const int g = r / 16, rr = r % 16, kb = rr / 4, nb = rr % 4;
            transpose_item(L_pool_w + ((size_t)(l * 4 + g) * 256) * 256, 256, nb * 64, kb * 64, L_PWT + ((size_t)l * 1024 + g * 256 + nb * 64) * 256, 256, nullptr, L_pool_scale + l * 1024 + g * 256 + nb * 64, 64, scr, lane);
            continue;
        }
        r -= I_PW;
        if (r < I_PO) { const int kb = r / 16, nb = r % 16;
            transpose_item(L_w_pool_out + (size_t)l * 1024 * 1024, 1024, nb * 64, kb * 64, L_WPOT + ((size_t)l * 1024 + nb * 64) * 1024, 1024, nullptr, nullptr, 64, scr, lane); continue; }
        r -= I_PO;
        if (r < I_SO) { const int kb = r / 16, nb = r % 16;
            transpose_item(L_w_ssd_out + (size_t)l * 2048 * 1024, 1024, nb * 64, kb * 64, L_WSOT + ((size_t)l * 1024 + nb * 64) * 2048, 2048, L_ssd_norm_w + l * 2048, nullptr, 64, scr, lane); continue; }
        r -= I_SO;
        if (r < I_O) { const int kb = r / 16, nb = r % 16;
            transpose_item(L_w_o + (size_t)l * 1024 * 1024, 1024, nb * 64, kb * 64, L_WOT + ((size_t)l * 1024 + nb * 64) * 1024, 1024, nullptr, nullptr, 64, scr, lane); continue; }
        r -= I_O;
        if (r < I_UP) { const int kb = r / (DUP / 64), nb = r % (DUP / 64);
            transpose_item(L_w_up + (size_t)l * 1024 * DUP, DUP, nb * 64, kb * 64, L_WUPT + ((size_t)l * DUP + nb * 64) * 1024, 1024, L_norm2_w + l * 1024, nullptr, 64, scr, lane); continue; }
        r -= I_UP;
        { const int kb = r / 16, nb = r % 16;
            transpose_item(L_w_down + (size_t)l * DFF * 1024, 1024, nb * 64, kb * 64, L_WDT + ((size_t)l * 1024 + nb * 64) * DFF, DFF, nullptr, nullptr, 64, scr, lane); }
    }
    for (int m = gw; m < MP; m += NGW) {
        const float* src = nullptr;
        if (m < MPROMPT) { const int b = m / LP, t = m - b * LP; src = (t < NMETA) ? L_meta + (size_t)t * DM : L_x_prompt + ((size_t)b * SEQ + (t - NMETA)) * DM; }
        else if (m < MREAL) src = L_x_sample + (size_t)(m - MPROMPT) * DM;
        float ss = 0.f;
#pragma unroll
        for (int j = 0; j < 4; ++j) {
            f32x4 v = src ? ((const f32x4*)src)[lane + 64 * j] : (f32x4){0.f, 0.f, 0.f, 0.f};
            ss += (v.x * v.x + v.y * v.y) + (v.z * v.z + v.w * v.w);
            ((f32x4*)(L_X + (size_t)m * DM))[lane + 64 * j] = v;
            u32x2 w; w.x = pk2(v.x, v.y); w.y = pk2(v.z, v.w);
            ((u32x2*)(L_XB + (size_t)m * DM))[lane + 64 * j] = w;
        }
        ss = wave_sum(ss);
        if (lane < 16) L_RSS[(size_t)m * 16 + lane] = (lane == 0) ? ss : 0.f;
    }
}

__device__ __forceinline__ void conv_pass(const Ctx& C_, int l) {
    const Ctx C = get_ids(C_.wave);
    KP kp = kparams(); unsigned char* ws = kp->ws;
    const float* const L_state_conv = kp->in[3];
    const float* const L_conv_w = kp->in[12];
    const float* const L_conv_b = kp->in[13];
    const float* const L_dt_bias = kp->in[14];
    const bf16_t* const L_PROJ = (const bf16_t*)(ws + WS_PROJ);
    bf16_t* const L_XBCC = (bf16_t*)(ws + WS_XBCC);
    const float* const L_DT = (const float*)(ws + WS_DT);
    float* const L_DTS = (float*)(ws + WS_DTS);
    const int gtid = C.bid * NTHREADS + C.tid, NT = C.G * NTHREADS;
    constexpr int NV = CONVD / 8, NSTRIP = MREAL / 8;
    const int NGRP = NT / NV;
    const int v = gtid % NV, sg = gtid / NV, ch = v * 8;
    if (sg < NGRP) {
        f32x4 cw[4][2], cbias[2];
#pragma unroll
        for (int k = 0; k < 4; ++k) { cw[k][0] = *(const f32x4*)(L_conv_w + ((size_t)l * 4 + k) * CONVD + ch); cw[k][1] = *(const f32x4*)(L_conv_w + ((size_t)l * 4 + k) * CONVD + ch + 4); }
        cbias[0] = *(const f32x4*)(L_conv_b + (size_t)l * CONVD + ch); cbias[1] = *(const f32x4*)(L_conv_b + (size_t)l * CONVD + ch + 4);
        u32x4 raw[11], nraw[11];
#define CONV_LOAD(dst_, strip_) do { const int m0_ = (strip_) * 8; const bool smp_ = m0_ >= MPROMPT; const int t0_ = smp_ ? 0 : (m0_ % LP); \
            const bf16_t* rb_ = L_PROJ + ((size_t)m0_ - 3) * NPROJ + PC_XBC + ch; \
            _Pragma("unroll") for (int i = 0; i < 11; ++i) dst_[i] = *(const u32x4*)(rb_ + (size_t)((t0_ + i - 3 >= 0) ? i : 3) * NPROJ); } while (0)
        int strip = sg;
        if (strip < NSTRIP) CONV_LOAD(raw, strip);
        for (; strip < NSTRIP; strip += NGRP) {
            const int m0 = strip * 8;
            const bool sample = m0 >= MPROMPT;
            const int t0 = sample ? 0 : (m0 % LP), b = sample ? (m0 - MPROMPT) / DS : 0;
            const bool more = strip + NGRP < NSTRIP;
            if (more) CONV_LOAD(nraw, strip + NGRP);
            if (t0 < 3) {
#pragma unroll
                for (int i = 0; i < 3; ++i) if (t0 + i - 3 < 0) {
                    u32x4 rv = (u32x4){0u, 0u, 0u, 0u};
                    if (sample) { const float* pp = L_state_conv + ((size_t)(l * DB + b) * 3 + i) * CONVD + ch; rv = pack8v(*(const f32x4*)pp, *(const f32x4*)(pp + 4)); }
                    raw[i] = rv; }
            }
            float oacc[4][8];
#pragma unroll
            for (int i = 0; i < 11; ++i) {
                float xv[8]; unpack8(raw[i], xv);
                if (i < 8) {
#pragma unroll
                    for (int e = 0; e < 8; ++e) oacc[i & 3][e] = 0.f;
                }
#pragma unroll
                for (int k = 0; k < 4; ++k) { const int j = i - k;
                    if (j >= 0 && j < 8) { float* o = oacc[j & 3];
                        o[0] += cw[k][0].x * xv[0]; o[1] += cw[k][0].y * xv[1]; o[2] += cw[k][0].z * xv[2]; o[3] += cw[k][0].w * xv[3];
                        o[4] += cw[k][1].x * xv[4]; o[5] += cw[k][1].y * xv[5]; o[6] += cw[k][1].z * xv[6]; o[7] += cw[k][1].w * xv[7]; } }
                if (i >= 3) {
                    const int j = i - 3; const float* oa = oacc[j & 3];
                    float o[8];
                    o[0] = siluf_(oa[0] + cbias[0].x); o[1] = siluf_(oa[1] + cbias[0].y); o[2] = siluf_(oa[2] + cbias[0].z); o[3] = siluf_(oa[3] + cbias[0].w);
                    o[4] = siluf_(oa[4] + cbias[1].x); o[5] = siluf_(oa[5] + cbias[1].y); o[6] = siluf_(oa[6] + cbias[1].z); o[7] = siluf_(oa[7] + cbias[1].w);
                    *(u32x4*)(L_XBCC + (size_t)(m0 + j) * CONVD + ch) = pack8(o);
                }
            }
            if (more) {
#pragma unroll
                for (int i = 0; i < 11; ++i) raw[i] = nraw[i];
            }
        }
#undef CONV_LOAD
    }
    for (int idx = gtid; idx < MREAL * NH; idx += NT) {
        const float rw = L_DT[idx] + L_dt_bias[l * NH + (idx & 31)];
        L_DTS[(size_t)(idx & 31) * MP + (idx >> 5)] = rw > 20.f ? rw : __logf(1.0f + __expf(rw));
    }
}

constexpr int LD128 = 136, LD64 = 72;
constexpr int S_C = 0, S_CS = 17408, S_B = 34816, S_BWT = 52224, S_XDT = 70656, S_XS = 79872, S_M = 89088, S_H = 98304, S_Z = 115712  , S_DTV = 124928, S_CUM = 125440, S_SSQ = 125952;

#define SSD_PREFETCH(r0_, ntok_, h_, xoff_, zoff_, boff_, c0n) do { \
    const int nqn_ = ((ntok_) - (c0n)) < 64 ? ((ntok_) - (c0n)) : 64; \
    const bf16_t* xb_ = L_XBCC + (size_t)((r0_) + (c0n)) * CONVD; \
    { unsigned z_ = 0u; asm volatile("" : "+v"(z_)); rx = (u32x4){z_, z_, z_, z_}; } zraw = rx; rB[0] = rx; rB[1] = rx; rC[0] = rx; rC[1] = rx;     \
    if (zt < nqn_) zraw = *(const u32x4*)(L_PROJ + (size_t)((r0_) + (c0n)) * NPROJ + (zoff_)); \
    if (zt < nqn_) rx = *(const u32x4*)(xb_ + (xoff_)); \
    _Pragma("unroll") for (int i_ = 0; i_ < 2; ++i_) if (bt + 32 * i_ < nqn_) { rB[i_] = *(const u32x4*)(xb_ + (boff_) + (size_t)i_ * 32 * CONVD); rC[i_] = *(const u32x4*)(xb_ + (boff_) + 512 + (size_t)i_ * 32 * CONVD); } \
    dtraw = (lane < nqn_) ? L_DTS[(size_t)(h_) * MP + (unsigned)((r0_) + (c0n) + lane)] : 0.f; \
} while (0)
#define SSD_UNIT(u_, smp_, b_, h_, r0_, ntok_, xoff_, zoff_, boff_) do { \
    smp_ = (u_) >= NBATCH * NH; const int k_ = smp_ ? (u_) - NBATCH * NH : (u_); b_ = k_ / NH; h_ = k_ - b_ * NH; \
    r0_ = smp_ ? MPROMPT + b_ * DS : b_ * LP; ntok_ = smp_ ? DS : LP; \
    xoff_ = (unsigned)zt * CONVD + h_ * 64 + zv * 8; zoff_ = (unsigned)zt * NPROJ + PC_Z + h_ * 64 + zv * 8; boff_ = (unsigned)bt * CONVD + 2048 + (h_ >> 3) * 128 + bv * 8; \
} while (0)

__device__ __forceinline__ void ssd_phase(const Ctx& C_, LAS unsigned char* lds_in, int l) {
    const Ctx C = get_ids(C_.wave);
    LAS unsigned char* lds = lds_in; asm volatile("" : "+s"(lds));
    KP kp = kparams(); unsigned char* ws = kp->ws;
    const float* const L_state_ssm = kp->in[4];
    float* const L_out = kp->out;
    const bf16_t* const L_PROJ = (const bf16_t*)(ws + WS_PROJ);
    const bf16_t* const L_XBCC = (const bf16_t*)(ws + WS_XBCC);
    bf16_t* const L_YN = (bf16_t*)(ws + WS_YN);
    const float* const L_DTS = (const float*)(ws + WS_DTS);
    float* const L_SSQ = (float*)(ws + WS_SSQ);
    const float* const L_a_log = kp->in[15] + l * NH; const float* const L_d_skip = kp->in[16] + l * NH;
    const int tid = C.tid, lane = C.lane, wave = C.wave, r = lane & 15, q = lane >> 4;
    LAS bf16_t* sC = (LAS bf16_t*)(lds + S_C); LAS bf16_t* sCs = (LAS bf16_t*)(lds + S_CS); LAS bf16_t* sB = (LAS bf16_t*)(lds + S_B);
    LAS bf16_t* sBwT = (LAS bf16_t*)(lds + S_BWT); LAS bf16_t* sXdT = (LAS bf16_t*)(lds + S_XDT); LAS bf16_t* sXs = (LAS bf16_t*)(lds + S_XS);
    LAS bf16_t* sM = (LAS bf16_t*)(lds + S_M); LAS bf16_t* sH = (LAS bf16_t*)(lds + S_H); LAS bf16_t* sZ = (LAS bf16_t*)(lds + S_Z);
    LAS float* scum = (LAS float*)(lds + S_CUM); LAS float* sssq = (LAS float*)(lds + S_SSQ);
    const int zt = tid >> 3, zv = tid & 7, bt = tid >> 4, bv = tid & 15;
    const int pjs = wave & 3, ni0 = (wave >> 2) * 4;
    const int NU = NBATCH * NH;
    int u = C.bid; if (u >= NU) return;
    bool sample; int b, h, r0, ntok; unsigned xoff, zoff, boff;
    SSD_UNIT(u, sample, b, h, r0, ntok, xoff, zoff, boff);
    u32x4 rx, zraw, rB[2], rC[2]; float dtraw = 0.f;
    SSD_PREFETCH(r0, ntok, h, xoff, zoff, boff, 0);
    if (tid < 64) sssq[tid] = 0.f;
  for (;;) {
    const float a_h = -__expf(L_a_log[h]), dsk = L_d_skip[h];
    f32x4 H[4];
    if (sample) { const float* h0 = L_state_ssm + ((size_t)(l * DB + b) * NH + h) * (HD * NST);
#pragma unroll
        for (int j = 0; j < 4; ++j) H[j] = *(const f32x4*)(h0 + (16 * pjs + r) * NST + 16 * (ni0 + j) + 4 * q);
    } else {
        float z_ = 0.f; asm volatile("" : "+v"(z_));
#pragma unroll
        for (int j = 0; j < 4; ++j) H[j] = (f32x4){z_, z_, z_, z_};
    }
    const int un = u + C.G; const bool has_next = un < NU;
    LBAR();

    int par = 0;
    for (int c0 = 0; c0 < ntok; c0 += 64, par ^= 1) {
        const int nq = (ntok - c0) < 64 ? (ntok - c0) : 64;
        const bool more = (c0 + 64) < ntok;
        const LAS float* cumc = scum;
        const float d = dtraw;
        float cs = d * a_h;
#pragma unroll
        for (int o_ = 1; o_ < 64; o_ <<= 1) { const float v_ = shup(cs, o_, lane); if (lane >= o_) cs += v_; }
        const float clast = shidx(cs, 63);
        if (wave == 7) scum[lane] = cs;
#define SWZ(row_, tok_) ((row_) * LD64 + (((((tok_) >> 3) ^ (((row_) >> 3) & 7)) << 3) | ((tok_) & 7)))
        {
            const float dz = shidx(d, zt), wcs0 = shidx(cs, bt), wcs1 = shidx(cs, bt + 32);
            float xv[8]; unpack8(rx, xv);
            *(LAS u32x4*)(sXs + zt * LD64 + zv * 8) = rx;
            *(LAS u32x4*)(sZ + zt * LD64 + zv * 8) = zraw;
#pragma unroll
            for (int e = 0; e < 8; ++e) sXdT[SWZ(zv * 8 + e, zt)] = (bf16_t)f2bf(xv[e] * dz);
#pragma unroll
            for (int i = 0; i < 2; ++i) {
                const int st = bt + 32 * i; const float csx = i == 0 ? wcs0 : wcs1;
                const float wb = __expf(clast - csx), wc = __expf(csx);
                float bvv[8]; unpack8(rB[i], bvv);
                *(LAS u32x4*)(sB + st * LD128 + bv * 8) = rB[i];
#pragma unroll
                for (int e = 0; e < 8; ++e) sBwT[SWZ(bv * 8 + e, st)] = (bf16_t)f2bf(bvv[e] * wb);
                float cvv[8]; unpack8(rC[i], cvv);
                *(LAS u32x4*)(sC + st * LD128 + bv * 8) = rC[i];
#pragma unroll
                for (int e = 0; e < 8; ++e) cvv[e] *= wc;
                *(LAS u32x4*)(sCs + st * LD128 + bv * 8) = pack8(cvv);
            }
        }
        __builtin_amdgcn_sched_barrier(0);
        if (more) { SSD_PREFETCH(r0, ntok, h, xoff, zoff, boff, c0 + 64); }
        else if (has_next) {
            bool sample_n; int b_n, h_n, r0_n, ntok_n; unsigned xoff_n, zoff_n, boff_n;
            SSD_UNIT(un, sample_n, b_n, h_n, r0_n, ntok_n, xoff_n, zoff_n, boff_n);
            SSD_PREFETCH(r0_n, ntok_n, h_n, xoff_n, zoff_n, boff_n, 0);
        }
        LBAR();
        {
            const int ti = wave >> 1, sj0 = (wave & 1) * 2;
            if (16 * ti < nq) {
                bf16x8 fa[4], fb[2][4];
#pragma unroll
                for (int kk = 0; kk < 4; ++kk) {
                    fa[kk] = *(const LAS bf16x8*)(sC + (16 * ti + r) * LD128 + kk * 32 + q * 8);
                    fb[0][kk] = *(const LAS bf16x8*)(sB + (16 * sj0 + r) * LD128 + kk * 32 + q * 8);
                    fb[1][kk] = *(const LAS bf16x8*)(sB + (16 * (sj0 + 1) + r) * LD128 + kk * 32 + q * 8);
                }
                const int t = 16 * ti + r; const float ctv = cumc[t];
                const f32x4 cs0 = *(const LAS f32x4*)(cumc + 16 * sj0 + 4 * q), cs1 = *(const LAS f32x4*)(cumc + 16 * (sj0 + 1) + 4 * q);
                __builtin_amdgcn_sched_barrier(0);
                f32x4 S0 = (f32x4){0.f, 0.f, 0.f, 0.f}, S1 = S0;
#pragma unroll
                for (int kk = 0; kk < 4; ++kk) { S0 = __builtin_amdgcn_mfma_f32_16x16x32_bf16(fb[0][kk], fa[kk], S0, 0, 0, 0); S1 = __builtin_amdgcn_mfma_f32_16x16x32_bf16(fb[1][kk], fa[kk], S1, 0, 0, 0); }
                {
                    float m0[4], m1[4];
#pragma unroll
                    for (int jj = 0; jj < 4; ++jj) {
                        const int s0 = 16 * sj0 + 4 * q + jj, s1 = s0 + 16;
                        m0[jj] = (s0 <= t) ? S0[jj] * __expf(fminf(ctv - cs0[jj], 0.f)) : 0.f;
                        m1[jj] = (s1 <= t) ? S1[jj] * __expf(fminf(ctv - cs1[jj], 0.f)) : 0.f;
                    }
                    u32x2 w0, w1; w0.x = pk2(m0[0], m0[1]); w0.y = pk2(m0[2], m0[3]); w1.x = pk2(m1[0], m1[1]); w1.y = pk2(m1[2], m1[3]);
                    *(LAS u32x2*)(sM + t * LD64 + 16 * sj0 + 4 * q) = w0; *(LAS u32x2*)(sM + t * LD64 + 16 * (sj0 + 1) + 4 * q) = w1;
                }
            }
        }
        if (c0 == 0) {
#pragma unroll
            for (int j = 0; j < 4; ++j) { u32x2 w; w.x = pk2(H[j][0], H[j][1]); w.y = pk2(H[j][2], H[j][3]); *(LAS u32x2*)(sH + (16 * pjs + r) * LD128 + 16 * (ni0 + j) + 4 * q) = w; }
        }
        LBAR();
        {
            const int ti = wave >> 1, pj0 = (wave & 1) * 2;
            const bool yv = 16 * ti < nq;
            bf16x8 sA[4][2], sBf[2];
            f32x4 Y[2];
            Y[0] = (f32x4){0.f, 0.f, 0.f, 0.f}; Y[1] = Y[0];
            if (yv) {
                {
                    bf16x8 aM[2], bX[2][2];
#pragma unroll
                    for (int kk = 0; kk < 2; ++kk) { aM[kk] = *(const LAS bf16x8*)(sM + (16 * ti + r) * LD64 + kk * 32 + q * 8);
                        bX[0][kk] = *(const LAS bf16x8*)(sXdT + SWZ(16 * pj0 + r, kk * 32 + q * 8)); bX[1][kk] = *(const LAS bf16x8*)(sXdT + SWZ(16 * (pj0 + 1) + r, kk * 32 + q * 8)); }
                    __builtin_amdgcn_sched_barrier(0);
#pragma unroll
                    for (int kk = 0; kk < 2; ++kk) { Y[0] = __builtin_amdgcn_mfma_f32_16x16x32_bf16(bX[0][kk], aM[kk], Y[0], 0, 0, 0); Y[1] = __builtin_amdgcn_mfma_f32_16x16x32_bf16(bX[1][kk], aM[kk], Y[1], 0, 0, 0); }
                }
                __builtin_amdgcn_sched_barrier(0);
                {
                    bf16x8 aC[4], bH[2][4];
#pragma unroll
                    for (int kk = 0; kk < 4; ++kk) { aC[kk] = *(const LAS bf16x8*)(sCs + (16 * ti + r) * LD128 + kk * 32 + q * 8);
                        bH[0][kk] = *(const LAS bf16x8*)(sH + (16 * pj0 + r) * LD128 + kk * 32 + q * 8); bH[1][kk] = *(const LAS bf16x8*)(sH + (16 * (pj0 + 1) + r) * LD128 + kk * 32 + q * 8); }
                    __builtin_amdgcn_sched_barrier(0);
#pragma unroll
                    for (int kk = 0; kk < 4; ++kk) { Y[0] = __builtin_amdgcn_mfma_f32_16x16x32_bf16(bH[0][kk], aC[kk], Y[0], 0, 0, 0); Y[1] = __builtin_amdgcn_mfma_f32_16x16x32_bf16(bH[1][kk], aC[kk], Y[1], 0, 0, 0); }
                }
            }
            __builtin_amdgcn_sched_barrier(0);
#pragma unroll
            for (int kk = 0; kk < 2; ++kk) { sBf[kk] = *(const LAS bf16x8*)(sXdT + SWZ(16 * pjs + r, kk * 32 + q * 8));
#pragma unroll
                for (int j = 0; j < 4; ++j) sA[j][kk] = *(const LAS bf16x8*)(sBwT + SWZ(16 * (ni0 + j) + r, kk * 32 + q * 8)); }
            __builtin_amdgcn_sched_barrier(0);
            {
                const float dec = __expf(clast);
#pragma unroll
                for (int j = 0; j < 4; ++j) H[j] = H[j] * dec;
#pragma unroll
                for (int kk = 0; kk < 2; ++kk)
#pragma unroll
                    for (int j = 0; j < 4; ++j) H[j] = __builtin_amdgcn_mfma_f32_16x16x32_bf16(sA[j][kk], sBf[kk], H[j], 0, 0, 0);
            }
            if (yv) {
                const int t = 16 * ti + r;
                float ss = 0.f;
#pragma unroll
                for (int j = 0; j < 2; ++j) {
                    const int p0 = 16 * (pj0 + j) + 4 * q;
                    const u32x2 xw = *(const LAS u32x2*)(sXs + t * LD64 + p0), zw = *(const LAS u32x2*)(sZ + t * LD64 + p0);
                    const float y0 = (Y[j][0] + dsk * bflo(xw.x)) * siluf_(bflo(zw.x)), y1 = (Y[j][1] + dsk * bfhi(xw.x)) * siluf_(bfhi(zw.x));
                    const float y2 = (Y[j][2] + dsk * bflo(xw.y)) * siluf_(bflo(zw.y)), y3 = (Y[j][3] + dsk * bfhi(xw.y)) * siluf_(bfhi(zw.y));
                    ss += (y0 * y0 + y1 * y1) + (y2 * y2 + y3 * y3);
                    u32x2 w; w.x = pk2(y0, y1); w.y = pk2(y2, y3);
                    *(LAS u32x2*)(sZ + t * LD64 + p0) = w;
                }
                ss += shx(ss, 16, lane); ss += shx(ss, 32, lane);
                if (q == 0 && t < nq) (void)__hip_atomic_fetch_add(sssq + t, ss, __ATOMIC_RELAXED, __HIP_MEMORY_SCOPE_WORKGROUP);
            }
        }
        LBAR();
#pragma unroll
        for (int j = 0; j < 4; ++j) { u32x2 w; w.x = pk2(H[j][0], H[j][1]); w.y = pk2(H[j][2], H[j][3]); *(LAS u32x2*)(sH + (16 * pjs + r) * LD128 + 16 * (ni0 + j) + 4 * q) = w; }
        if (zt < nq) *(u32x4*)(L_YN + (size_t)(r0 + c0 + zt) * DINNER + h * 64 + zv * 8) = *(const LAS u32x4*)(sZ + zt * LD64 + zv * 8);
        if (tid < 64) { if (tid < nq) L_SSQ[(size_t)(r0 + c0 + tid) * 32 + h] = sssq[tid]; sssq[tid] = 0.f; }
        __builtin_amdgcn_sched_barrier(0);
    }
    float* so = L_out + (sample ? O_SSSM + ((size_t)(l * DB + b) * NH + h) * (HD * NST) : O_PSSM + ((size_t)(l * NBATCH + b) * NH + h) * (HD * NST));
#pragma unroll
    for (int j = 0; j < 4; ++j) *(f32x4*)(so + (16 * pjs + r) * NST + 16 * (ni0 + j) + 4 * q) = H[j];
    if (!has_next) break;
    u = un; SSD_UNIT(u, sample, b, h, r0, ntok, xoff, zoff, boff);
  }
    LBAR();
}

constexpr int SMP_WAVE_LDS = 14592;
__device__ __forceinline__ void ssd_sample(const Ctx& C_, LAS unsigned char* lds_in, int l) {
    const Ctx C = get_ids(C_.wave);
    LAS unsigned char* lds = lds_in; asm volatile("" : "+s"(lds));
    KP kp = kparams(); unsigned char* ws = kp->ws;
    const float* const L_state_ssm = kp->in[4];
    float* const L_out = kp->out;
    const bf16_t* const L_PROJ = (const bf16_t*)(ws + WS_PROJ);
    const bf16_t* const L_XBCC = (const bf16_t*)(ws + WS_XBCC);
    bf16_t* const L_YN = (bf16_t*)(ws + WS_YN);
    const float* const L_DTS = (const float*)(ws + WS_DTS);
    float* const L_SSQ = (float*)(ws + WS_SSQ);
    const float* const L_a_log = kp->in[15] + l * NH; const float* const L_d_skip = kp->in[16] + l * NH;
    const int lane = C.lane, wave = C.wave, r = lane & 15, q = lane >> 4;
    LAS float* sBf = (LAS float*)(lds + wave * SMP_WAVE_LDS); LAS float* sCf = sBf + 1024; LAS float* sXf = sBf + 2048; LAS float* sZf = sBf + 2560; LAS float* sY2 = sBf + 3072;
    LAS float* sdt = sBf + 3584; LAS float* sdA = sBf + 3592;
    for (int k = C.bid * NWAVES + wave; k < DB * NH; k += C.G * NWAVES) {
        const int b = k / NH, h = k - b * NH, g = h >> 3, r0 = MPROMPT + b * DS;
        const float a_h = -__expf(L_a_log[h]), dsk = L_d_skip[h];
        int ln = lane; asm volatile("" : "+v"(ln));
#pragma unroll 1
        for (int i = 0; i < 5; ++i) {
            const int idx = ln + 64 * i, t = idx / 40, v = idx - t * 40;
            int ch; LAS float* dst;
            if (v < 8) { ch = h * 64 + v * 8; dst = sXf + t * 64 + v * 8; } else if (v < 24) { ch = 2048 + g * 128 + (v - 8) * 8; dst = sBf + t * 128 + (v - 8) * 8; } else { ch = 2560 + g * 128 + (v - 24) * 8; dst = sCf + t * 128 + (v - 24) * 8; }
            const u32x4 w = *(const u32x4*)(L_XBCC + (size_t)(r0 + t) * CONVD + ch); float o[8]; unpack8(w, o);
            *(LAS f32x4*)dst = (f32x4){o[0], o[1], o[2], o[3]}; *(LAS f32x4*)(dst + 4) = (f32x4){o[4], o[5], o[6], o[7]};
        }
        { const int t = ln >> 3, v = ln & 7;
            const u32x4 w = *(const u32x4*)(L_PROJ + (size_t)(r0 + t) * NPROJ + PC_Z + h * 64 + v * 8); float o[8]; unpack8(w, o);
            *(LAS f32x4*)(sZf + t * 64 + v * 8) = (f32x4){o[0], o[1], o[2], o[3]}; *(LAS f32x4*)(sZf + t * 64 + v * 8 + 4) = (f32x4){o[4], o[5], o[6], o[7]}; }
        if (ln < 8) { const float dtv = L_DTS[(size_t)h * MP + r0 + ln]; sdt[ln] = dtv; sdA[ln] = __expf(dtv * a_h); }
        const float* h0 = L_state_ssm + ((size_t)(l * DB + b) * NH + h) * (HD * NST);
        f32x4 hs[4][4][2];
        unsigned hoff = (unsigned)(r * NST + 8 * q); asm volatile("" : "+v"(hoff));
#pragma unroll
        for (int pj = 0; pj < 4; ++pj)
#pragma unroll
            for (int kk = 0; kk < 4; ++kk) { const float* p = h0 + hoff + (16 * pj * NST + 32 * kk); hs[pj][kk][0] = *(const f32x4*)p; hs[pj][kk][1] = *(const f32x4*)(p + 4); }
        LDS_WAIT(); asm volatile("" ::: "memory");
#pragma unroll 1
        for (int t = 0; t < DS; ++t) {
            const float dt = sdt[t], dA = sdA[t];
            float xd[4], y[4];
#pragma unroll
            for (int pj = 0; pj < 4; ++pj) { xd[pj] = sXf[t * 64 + 16 * pj + r] * dt; y[pj] = 0.f; }
#pragma unroll
            for (int kk = 0; kk < 4; ++kk) {
                const f32x4 B0 = *(const LAS f32x4*)(sBf + t * 128 + 32 * kk + 8 * q), B1 = *(const LAS f32x4*)(sBf + t * 128 + 32 * kk + 8 * q + 4);
                const f32x4 C0 = *(const LAS f32x4*)(sCf + t * 128 + 32 * kk + 8 * q), C1 = *(const LAS f32x4*)(sCf + t * 128 + 32 * kk + 8 * q + 4);
#pragma unroll
                for (int pj = 0; pj < 4; ++pj) {
                    f32x4 h0v = hs[pj][kk][0] * dA + B0 * xd[pj], h1v = hs[pj][kk][1] * dA + B1 * xd[pj];
                    hs[pj][kk][0] = h0v; hs[pj][kk][1] = h1v;
                    const f32x4 m0 = C0 * h0v, m1 = C1 * h1v;
                    y[pj] += ((m0.x + m0.y) + (m0.z + m0.w)) + ((m1.x + m1.y) + (m1.z + m1.w));
                }
            }
#pragma unroll
            for (int pj = 0; pj < 4; ++pj) { y[pj] += shx(y[pj], 16, lane); y[pj] += shx(y[pj], 32, lane); }
            const float yv = q == 0 ? y[0] : (q == 1 ? y[1] : (q == 2 ? y[2] : y[3]));
            const float yg = (yv + dsk * sXf[t * 64 + lane]) * siluf_(sZf[t * 64 + lane]);
            L_YN[(size_t)(r0 + t) * DINNER + h * 64 + lane] = (bf16_t)f2bf(yg);
            sY2[t * 64 + lane] = yg * yg;
        }
        LDS_WAIT(); asm volatile("" ::: "memory");
        {
            const LAS float* p = sY2 + (lane >> 3) * 64 + (lane & 7) * 8;
            const f32x4 a = *(const LAS f32x4*)p, c = *(const LAS f32x4*)(p + 4);
            float ss = ((a.x + a.y) + (a.z + a.w)) + ((c.x + c.y) + (c.z + c.w));
            ss += shx(ss, 1, lane); ss += shx(ss, 2, lane); ss += shx(ss, 4, lane);
            if ((lane & 7) == 0) L_SSQ[(size_t)(r0 + (lane >> 3)) * 32 + h] = ss;
        }
        float* so = L_out + O_SSSM + ((size_t)(l * DB + b) * NH + h) * (HD * NST);
#pragma unroll
        for (int pj = 0; pj < 4; ++pj)
#pragma unroll
            for (int kk = 0; kk < 4; ++kk) { float* p = so + hoff + (16 * pj * NST + 32 * kk); *(f32x4*)p = hs[pj][kk][0]; *(f32x4*)(p + 4) = hs[pj][kk][1]; }
        LDS_WAIT(); asm volatile("" ::: "memory");
    }
}

__device__ __forceinline__ void row_bf16_to_f32(const bf16_t* src, float* dst, int ncol, int lane) {
    for (int v = lane; v < ncol / 8; v += 64) { const u32x4 w = *(const u32x4*)(src + v * 8); float o[8]; unpack8(w, o);
        *(f32x4*)(dst + v * 8) = (f32x4){o[0], o[1], o[2], o[3]}; *(f32x4*)(dst + v * 8 + 4) = (f32x4){o[4], o[5], o[6], o[7]}; }
}
__device__ __forceinline__ void row_f32_copy(const float* src, float* dst, int ncol, int lane) {
    for (int v = lane; v < ncol / 4; v += 64) *(f32x4*)(dst + v * 4) = *(const f32x4*)(src + v * 4);
}

template <int MAXW>
__device__ __forceinline__ void pool_load(const bf16_t* PROJ, const float* state_pool, int l, int m, bool sample, int b, int t, int ch, int win, u32x4 (&rw)[MAXW]) {
#pragma unroll
    for (int j = 0; j < MAXW; ++j) { const bool need = (j < win) && (t - j >= 0);
        const u32x4 rv = *(const u32x4*)(PROJ + (size_t)(m - (need ? j : 0)) * NPROJ + PC_U + ch);
        rw[j] = need ? rv : (u32x4){0u, 0u, 0u, 0u}; }
    if (sample && t < win - 1) {
#pragma unroll
        for (int j = 1; j < MAXW; ++j) if (j < win && t - j < 0) {
            const float* pp = state_pool + ((size_t)(l * DB + b) * 15 + (15 + t - j)) * 1024 + ch; rw[j] = pack8v(*(const f32x4*)pp, *(const f32x4*)(pp + 4)); }
    }
}
template <int MAXW>
__device__ __forceinline__ void pool_finish(bf16_t* DBUF, int m, bool sample, int t, int ch, int win, const u32x4 (&rw)[MAXW]) {
    float acc[8], u0[8];
    unpack8(rw[0], u0);
#pragma unroll
    for (int e = 0; e < 8; ++e) acc[e] = u0[e];
#pragma unroll
    for (int j = 1; j < MAXW; ++j) { float xv[8]; unpack8(rw[j], xv);
#pragma unroll
        for (int e = 0; e < 8; ++e) acc[e] += xv[e]; }
    const int cnt = sample ? win : ((t + 1) < win ? (t + 1) : win);
    const float inv = 1.0f / (float)cnt;
    float d[8];
#pragma unroll
    for (int e = 0; e < 8; ++e) d[e] = acc[e] * inv - u0[e];
    *(u32x4*)(DBUF + (size_t)m * 1024 + ch) = pack8(d);
}

__device__ __forceinline__ void mixer_elementwise(const Ctx& C_, int l) {
    const Ctx C = get_ids(C_.wave);
    KP kp = kparams(); unsigned char* ws = kp->ws;
    const float* const L_state_pool = kp->in[2];
    float* const L_out = kp->out;
    const bf16_t* const L_PROJ = (const bf16_t*)(ws + WS_PROJ);
    bf16_t* const L_DBUF = (bf16_t*)(ws + WS_DBUF);
    const int gw = C.bid * NWAVES + C.wave, NGW = C.G * NWAVES, lane = C.lane;
    const int chA = lane * 8, chB = (lane + 64) * 8, winA = 2 << (chA >> 8), winB = 2 << (chB >> 8);
#define POOL_ROW_LOAD(m_, A_, B_) do { const bool smp_ = (m_) >= MPROMPT; int b_, t_; if (smp_) { b_ = ((m_) - MPROMPT) / DS; t_ = ((m_) - MPROMPT) - b_ * DS; } else { b_ = (m_) / LP; t_ = (m_) - b_ * LP; } \
        pool_load<4>(L_PROJ, L_state_pool, l, (m_), smp_, b_, t_, chA, winA, A_); pool_load<16>(L_PROJ, L_state_pool, l, (m_), smp_, b_, t_, chB, winB, B_); } while (0)
    u32x4 rwA[4], rwB[16], nwA[4], nwB[16];
    int m = gw;
    if (m < MREAL) POOL_ROW_LOAD(m, rwA, rwB);
    for (; m < MREAL; m += NGW) {
        const bool sample = m >= MPROMPT;
        const int t = sample ? ((m - MPROMPT) % DS) : (m % LP);
        const bool more = m + NGW < MREAL;
        if (more) POOL_ROW_LOAD(m + NGW, nwA, nwB);
        pool_finish<4>(L_DBUF, m, sample, t, chA, winA, rwA);
        pool_finish<16>(L_DBUF, m, sample, t, chB, winB, rwB);
        if (more) {
#pragma unroll
            for (int j = 0; j < 4; ++j) rwA[j] = nwA[j];
#pragma unroll
            for (int j = 0; j < 16; ++j) rwB[j] = nwB[j];
        }
    }
#undef POOL_ROW_LOAD
    for (int it = gw; it < (NBATCH + DB) * 15; it += NGW) {
        if (it < NBATCH * 15) { const int b = it / 15, i = it - b * 15;
            row_bf16_to_f32(L_PROJ + (size_t)(b * LP + LP - 15 + i) * NPROJ + PC_U, L_out + O_PPOOL + ((size_t)(l * NBATCH + b) * 15 + i) * 1024, 1024, lane);
        } else { const int k = it - NBATCH * 15, b = k / 15, i = k - b * 15;
            float* dst = L_out + O_SPOOL + ((size_t)(l * DB + b) * 15 + i) * 1024;
            if (i < 7) row_f32_copy(L_state_pool + ((size_t)(l * DB + b) * 15 + 8 + i) * 1024, dst, 1024, lane);
            else row_bf16_to_f32(L_PROJ + (size_t)(MPROMPT + b * DS + (i - 7)) * NPROJ + PC_U, dst, 1024, lane); }
    }
    for (int it = gw; it < (NBATCH + DB) * 3; it += NGW) {
        if (it < NBATCH * 3) { const int b = it / 3, i = it - b * 3;
            row_bf16_to_f32(L_PROJ + (size_t)(b * LP + LP - 3 + i) * NPROJ + PC_XBC, L_out + O_PCONV + ((size_t)(l * NBATCH + b) * 3 + i) * CONVD, CONVD, lane);
        } else { const int k = it - NBATCH * 3, b = k / 3, i = k - b * 3;
            row_bf16_to_f32(L_PROJ + (size_t)(MPROMPT + b * DS + 5 + i) * NPROJ + PC_XBC, L_out + O_SCONV + ((size_t)(l * DB + b) * 3 + i) * CONVD, CONVD, lane); }
    }
}

__device__ __forceinline__ void yn_normalize(const Ctx& C_) {
    const Ctx C = get_ids(C_.wave);
    KP kp = kparams(); unsigned char* ws = kp->ws; (void)ws;
    bf16_t* const L_YN = (bf16_t*)(ws + WS_YN);
    float* const L_SSQ = (float*)(ws + WS_SSQ);
    const int gw = C.bid * NWAVES + C.wave, NGW = C.G * NWAVES, lane = C.lane;
    for (int m = gw; m < MREAL; m += NGW) {
        const f32x4* sp = (const f32x4*)(L_SSQ + (size_t)m * 32);
        float rs[4];
#pragma unroll
        for (int gi = 0; gi < 4; ++gi) { const f32x4 a = sp[2 * gi], b = sp[2 * gi + 1]; rs[gi] = rsqrtf((((a.x + a.y) + (a.z + a.w)) + ((b.x + b.y) + (b.z + b.w))) * (1.0f / 512.0f) + EPS); }
#pragma unroll
        for (int i = 0; i < 4; ++i) {
            const int v = lane + 64 * i;
            u32x4* p = (u32x4*)(L_YN + (size_t)m * DINNER + v * 8);
            float o[8]; unpack8(*p, o);
            const float s = rs[i];
#pragma unroll
            for (int e = 0; e < 8; ++e) o[e] *= s;
            *p = pack8(o);
        }
    }
}

__device__ __forceinline__ void ffn_half(const bf16_t* UP, const float* state_ffn, const f32x4 (&w)[3][2], const f32x4 (&bs)[2], int l, int m0, int t0, bool sample, int b, int col, float (&res)[8][8]) {
    u32x4 raw[10];
#pragma unroll
    for (int i = 0; i < 10; ++i) raw[i] = *(const u32x4*)(UP + (size_t)(m0 + ((t0 + i - 2 >= 0) ? i - 2 : 0)) * DUP + col);
    if (t0 < 2) {
#pragma unroll
        for (int i = 0; i < 2; ++i) if (t0 + i - 2 < 0) {
            u32x4 rv = (u32x4){0u, 0u, 0u, 0u};
            if (sample) { const float* pp = state_ffn + ((size_t)(l * DB + b) * 2 + i) * DUP + col; rv = pack8v(*(const f32x4*)pp, *(const f32x4*)(pp + 4)); }
            raw[i] = rv; }
    }
#pragma unroll
    for (int j = 0; j < 8; ++j) { res[j][0] = bs[0].x; res[j][1] = bs[0].y; res[j][2] = bs[0].z; res[j][3] = bs[0].w; res[j][4] = bs[1].x; res[j][5] = bs[1].y; res[j][6] = bs[1].z; res[j][7] = bs[1].w; }
#pragma unroll
    for (int i = 0; i < 10; ++i) {
        float xv[8]; unpack8(raw[i], xv);
#pragma unroll
        for (int k = 0; k < 3; ++k) { const int j = i - k;
            if (j >= 0 && j < 8) {
                res[j][0] += w[k][0].x * xv[0]; res[j][1] += w[k][0].y * xv[1]; res[j][2] += w[k][0].z * xv[2]; res[j][3] += w[k][0].w * xv[3];
                res[j][4] += w[k][1].x * xv[4]; res[j][5] += w[k][1].y * xv[5]; res[j][6] += w[k][1].z * xv[6]; res[j][7] += w[k][1].w * xv[7]; } }
    }
}

__device__ __forceinline__ void ffn_elementwise(const Ctx& C_, int l) {
    const Ctx C = get_ids(C_.wave);
    KP kp = kparams(); unsigned char* ws = kp->ws;
    const float* const L_state_ffn = kp->in[5];
    float* const L_out = kp->out;
    const bf16_t* const L_UP = (const bf16_t*)(ws + WS_UP);
    bf16_t* const L_ACT = (bf16_t*)(ws + WS_ACT);
    const float* fw = kp->in[22] + (size_t)l * 3 * DUP; const float* fb = kp->in[23] + (size_t)l * DUP;
    const int gtid = C.bid * NTHREADS + C.tid, NT = C.G * NTHREADS;
    constexpr int NV = DFF / 8, NSTRIP = MREAL / 8;
    const int NGRP = NT / NV, v = gtid % NV, sg = gtid / NV;
    f32x4 wg[3][2], bg[2];
    if (sg < NGRP) {
#pragma unroll
        for (int k = 0; k < 3; ++k) { wg[k][0] = *(const f32x4*)(fw + (size_t)k * DUP + v * 8); wg[k][1] = *(const f32x4*)(fw + (size_t)k * DUP + v * 8 + 4); }
        bg[0] = *(const f32x4*)(fb + v * 8); bg[1] = *(const f32x4*)(fb + v * 8 + 4);
    }
    for (int strip = sg; sg < NGRP && strip < NSTRIP; strip += NGRP) {
        const int m0 = strip * 8;
        const bool sample = m0 >= MPROMPT;
        const int t0 = sample ? 0 : (m0 % LP), b = sample ? (m0 - MPROMPT) / DS : 0;
        float gate[8][8], val[8][8];
        ffn_half(L_UP, L_state_ffn, wg, bg, l, m0, t0, sample, b, v * 8, gate);
#pragma unroll
        for (int j = 0; j < 8; ++j)
#pragma unroll
            for (int e = 0; e < 8; ++e) gate[j][e] = siluf_(gate[j][e]);
        f32x4 wv[3][2], bv[2];
#pragma unroll
        for (int k = 0; k < 3; ++k) { wv[k][0] = *(const f32x4*)(fw + (size_t)k * DUP + DFF + v * 8); wv[k][1] = *(const f32x4*)(fw + (size_t)k * DUP + DFF + v * 8 + 4); }
        bv[0] = *(const f32x4*)(fb + DFF + v * 8); bv[1] = *(const f32x4*)(fb + DFF + v * 8 + 4);
        ffn_half(L_UP, L_state_ffn, wv, bv, l, m0, t0, sample, b, DFF + v * 8, val);
#pragma unroll
        for (int j = 0; j < 8; ++j) { float a[8];
#pragma unroll
            for (int e = 0; e < 8; ++e) a[e] = gate[j][e] * val[j][e];
            *(u32x4*)(L_ACT + (size_t)(m0 + j) * DFF + v * 8) = pack8(a); }
    }
    const int gw = C.bid * NWAVES + C.wave, NGW = C.G * NWAVES, lane = C.lane;
    for (int it = gw; it < (NBATCH + DB) * 2; it += NGW) {
        if (it < NBATCH * 2) { const int b = it / 2, i = it - b * 2;
            row_bf16_to_f32(L_UP + (size_t)(b * LP + LP - 2 + i) * DUP, L_out + O_PFFN + ((size_t)(l * NBATCH + b) * 2 + i) * DUP, DUP, lane);
        } else { const int k = it - NBATCH * 2, b = k / 2, i = k - b * 2;
            row_bf16_to_f32(L_UP + (size_t)(MPROMPT + b * DS + 6 + i) * DUP, L_out + O_SFFN + ((size_t)(l * DB + b) * 2 + i) * DUP, DUP, lane); }
    }
}

__device__ __forceinline__ void final_norm(const Ctx& C_) {
    const Ctx C = get_ids(C_.wave);
    KP kp = kparams(); unsigned char* ws = kp->ws; (void)ws;
    const float* const L_final_norm_w = kp->in[25];
    float* const L_X = (float*)(ws + WS_X);
    float* const L_RSS = (float*)(ws + WS_RSS);
    float* const L_out = kp->out;
    const int gw = C.bid * NWAVES + C.wave, NGW = C.G * NWAVES, lane = C.lane;
    for (int m = gw; m < MREAL; m += NGW) {
        float* dst;
        if (m < MPROMPT) { const int b = m / LP, t = m - b * LP; if (t < NMETA) continue; dst = L_out + O_YP + ((size_t)b * SEQ + (t - NMETA)) * DM; }
        else dst = L_out + O_YS + (size_t)(m - MPROMPT) * DM;
        const f32x4* p = (const f32x4*)(L_RSS + (size_t)m * 16); const f32x4 a = p[0], b4 = p[1], c = p[2], d = p[3];
        const float s = ((a.x + a.y) + (a.z + a.w)) + ((b4.x + b4.y) + (b4.z + b4.w)) + ((c.x + c.y) + (c.z + c.w)) + ((d.x + d.y) + (d.z + d.w));
        const float rstd = rsqrtf(s * (1.0f / 1024.0f) + EPS);
#pragma unroll
        for (int j = 0; j < 4; ++j) { const f32x4 x = ((const f32x4*)(L_X + (size_t)m * DM))[lane + 64 * j], w = ((const f32x4*)L_final_norm_w)[lane + 64 * j];
            ((f32x4*)dst)[lane + 64 * j] = x * rstd * w; }
    }
}

__global__ void __launch_bounds__(NTHREADS, 2) hybrid_fwd(Params P) {
    extern __shared__ __attribute__((aligned(16))) unsigned char lds_raw[];
    LAS unsigned char* lds = (LAS unsigned char*)lds_raw;
    Ctx C;
    {
        const int t0 = threadIdx.x;
        C.tid = t0; C.lane = t0 & 63; C.wave = __builtin_amdgcn_readfirstlane(t0 >> 6); C.G = gridDim.x; C.bid = blockIdx.x;
        if (t0 < 4) ((LAS unsigned*)(lds + LDS_ST_OFF))[t0] = 0u;
        if (t0 == 0) { KP kp0 = kparams(); (void)xb_add((unsigned*)(kp0->ws + WS_CTL) + XB_XCNT(xb_xcc_id()), 1u); }
        __syncthreads();
        cg::this_grid().sync();
    }
#define LG_(x) ({ int v_ = (x); asm volatile("" : "+s"(v_)); v_; })
#define GRID_SYNC() do { KP kpb_ = kparams(); grid_barrier(kpb_->ws, lds, C.wave); } while (0)
    prologue(C, lds);
    GRID_SYNC();

    for (int l = 0; l < DEPTH; ++l) {
        { KP kp = kparams(); unsigned char* ws = kp->ws; pg8::StaticOrder S;
          pg8::Gemm g{WSP(bf16_t, WS_XB), WSP(bf16_t, WS_W1T) + (size_t)l * NPROJ * 1024, 1024, 1024, 1024, 0}; S.init(MP, NPROJ, LG_(C.G), LG_(C.bid));
          pg8::EpiScale E{WSP(bf16_t, WS_PROJ), NPROJ, WSP(float, WS_RSS), WSP(float, WS_DT), PC_DT / 256};
          pg8::gemm_phase(lds, C.wave, g, S, E); }
        GRID_SYNC();
        conv_pass(C, l);
        mixer_elementwise(C, l);
        GRID_SYNC();
        ssd_phase(C, lds, l);
        ssd_sample(C, lds, l);
        __syncthreads();
        { KP kp = kparams(); unsigned char* ws = kp->ws; pg8::StaticOrder S;
          pg8::Gemm g{WSP(bf16_t, WS_DBUF), WSP(bf16_t, WS_PWT) + (size_t)l * 1024 * 256, 1024, 256, 256, 256}; S.init(MP, 1024, LG_(C.G), LG_(C.bid));
          pg8::EpiScale E{WSP(bf16_t, WS_POOLED), 1024, nullptr, nullptr, -1};
          pg8::gemm_phase(lds, C.wave, g, S, E); }
        GRID_SYNC();
        yn_normalize(C);
        { KP kp = kparams(); unsigned char* ws = kp->ws; pg8::StaticOrder S;
          pg8::Gemm g{WSP(bf16_t, WS_POOLED), WSP(bf16_t, WS_WPOT) + (size_t)l * 1024 * 1024, 1024, 1024, 1024, 0}; S.init(pg8::MTAIL0, 1024, LG_(C.G), LG_(C.bid));
          pg8::EpiGate<0> E{WSP(bf16_t, WS_MERGED), 1024, WSP(bf16_t, WS_PROJ) + PC_GA, NPROJ};
          pg8::gemm_phase(lds, C.wave, g, S, E); pg8::gemm_tail(lds, C.wave, g, E); }
        GRID_SYNC();
        { KP kp = kparams(); unsigned char* ws = kp->ws; pg8::StaticOrder S;
          pg8::Gemm g{WSP(bf16_t, WS_YN), WSP(bf16_t, WS_WSOT) + (size_t)l * 1024 * 2048, 2048, 2048, 2048, 0}; S.init(pg8::MTAIL0, 1024, LG_(C.G), LG_(C.bid));
          pg8::EpiGate<1> E{WSP(bf16_t, WS_MERGED), 1024, WSP(bf16_t, WS_PROJ) + PC_GB, NPROJ};
          pg8::gemm_phase(lds, C.wave, g, S, E); pg8::gemm_tail(lds, C.wave, g, E); }
        GRID_SYNC();
        { KP kp = kparams(); unsigned char* ws = kp->ws; pg8::StaticOrder S;
          pg8::Gemm g{WSP(bf16_t, WS_MERGED), WSP(bf16_t, WS_WOT) + (size_t)l * 1024 * 1024, 1024, 1024, 1024, 0}; S.init(pg8::MTAIL0, 1024, LG_(C.G), LG_(C.bid));
          pg8::EpiResid E{WSP(float, WS_X), WSP(bf16_t, WS_XB), WSP(float, WS_RSS)};
          pg8::gemm_phase(lds, C.wave, g, S, E); pg8::gemm_tail(lds, C.wave, g, E); }
        GRID_SYNC();
        { KP kp = kparams(); unsigned char* ws = kp->ws; pg8::StaticOrder S;
          pg8::Gemm g{WSP(bf16_t, WS_XB), WSP(bf16_t, WS_WUPT) + (size_t)l * DUP * 1024, 1024, 1024, 1024, 0}; S.init(MP, DUP, LG_(C.G), LG_(C.bid));
          pg8::EpiScale E{WSP(bf16_t, WS_UP), DUP, WSP(float, WS_RSS), nullptr, -1};
          pg8::gemm_phase(lds, C.wave, g, S, E); }
        GRID_SYNC();
        ffn_elementwise(C, l);
        GRID_SYNC();
        { KP kp = kparams(); unsigned char* ws = kp->ws; pg8::StaticOrder S;
          pg8::Gemm g{WSP(bf16_t, WS_ACT), WSP(bf16_t, WS_WDT) + (size_t)l * 1024 * DFF, DFF, DFF, DFF, 0}; S.init(pg8::MTAIL0, 1024, LG_(C.G), LG_(C.bid));
          pg8::EpiResid E{WSP(float, WS_X), WSP(bf16_t, WS_XB), WSP(float, WS_RSS)};
          pg8::gemm_phase(lds, C.wave, g, S, E); pg8::gemm_tail(lds, C.wave, g, E); }
        GRID_SYNC();
    }
    final_norm(C);
}

extern "C" void kernel_launch(void* const* d_in, const int* in_sizes, int n_in, void* d_out, int out_size, void* d_ws, size_t ws_size, hipStream_t stream) {
    static int grid_blocks = 0;
    if (grid_blocks == 0) {
        if (n_in != 26 || (size_t)out_size != O_END || ws_size < WS_END) {
            fprintf(stderr, "kernel_launch: unexpected shapes: n_in %d out %d (want %zu) ws %zu (want %zu)\n", n_in, out_size, (size_t)O_END, ws_size, (size_t)WS_END); grid_blocks = -1; return; }
        int dev = 0, cus = 0, per_cu = 0;
        hipGetDevice(&dev);
        hipDeviceGetAttribute(&cus, hipDeviceAttributeMultiprocessorCount, dev);
        if (hipFuncSetAttribute((const void*)hybrid_fwd, hipFuncAttributeMaxDynamicSharedMemorySize, LDS_BYTES) != hipSuccess) { fprintf(stderr, "kernel_launch: hipFuncSetAttribute failed\n"); grid_blocks = -1; return; }
        if (hipOccupancyMaxActiveBlocksPerMultiprocessor(&per_cu, (const void*)hybrid_fwd, NTHREADS, LDS_BYTES) != hipSuccess || per_cu < 1) { fprintf(stderr, "kernel_launch: occupancy query gave %d\n", per_cu); per_cu = 1; }
        (void)hipGetLastError();
        grid_blocks = cus * per_cu;
    }
    if (grid_blocks < 0) return;
    if (hipMemsetAsync((char*)d_ws + WS_CTL, 0, WS_CTL_BYTES, stream) != hipSuccess) { fprintf(stderr, "kernel_launch: memset of barrier words failed\n"); return; }
    Params p{};
    for (int i = 0; i < 26; ++i) p.in[i] = (const float*)d_in[i];
    p.out = (float*)d_out; p.ws = (unsigned char*)d_ws;
    void* args[] = {&p};
    hipError_t e = hipLaunchCooperativeKernel((const void*)hybrid_fwd, dim3(grid_blocks), dim3(NTHREADS), args, LDS_BYTES, stream);
    if (e != hipSuccess) fprintf(stderr, "cooperative launch failed: %s (grid %d)\n", hipGetErrorString(e), grid_blocks);
}
```
